# Optimizing an MI355X kernel written in HIP

```python
import math
import jax
import jax.numpy as jnp
from jax import lax
import numpy as np

D_MODEL = 1024
BATCH = 1
SEQ = 16384
DEPTH = 2
DEC_BATCH = 16
DEC_SEQ = 64
PAST_LEN = 4096

CHUNK = 64
N_AB = (DEPTH + 1) // 2
N_CD = DEPTH // 2
RMS_EPS = 1e-6
LN_EPS = 1e-5

RET_HEADS = 4
RET_DK = 128
RET_DV = 128
RET_WIDTH = RET_HEADS * RET_DV
RET_THETA = 10000.0

RWKV_HEADS = 8
RWKV_HD = 64
RWKV_WIDTH = RWKV_HEADS * RWKV_HD
RWKV_W_LORA = 64
RWKV_A_LORA = 64
RWKV_G_LORA = 128
RWKV_PROJ = 3 * RWKV_WIDTH + RWKV_W_LORA + RWKV_A_LORA + RWKV_G_LORA
RWKV_LN_EPS = 64e-5

CONV_CH = 512
CONV_WIDTH = 31

ATT_HEADS = 8
ATT_KV_HEADS = 2
ATT_HD = 64
ATT_GROUP = ATT_HEADS // ATT_KV_HEADS
WINDOW = 128
ROT_DIM = ATT_HD // 4
ROPE_THETA = 500000.0
NEG_INF = -1e30

D_FF = -(-8 * D_MODEL // (3 * 256)) * 256

IN_AB = 2 * RET_HEADS * RET_DK + 2 * RET_WIDTH + RWKV_PROJ
MIX_AB = RET_WIDTH + RWKV_WIDTH
IN_CD = 2 * CONV_CH + (ATT_HEADS + 2 * ATT_KV_HEADS) * ATT_HD
MIX_CD = CONV_CH + ATT_HEADS * ATT_HD

kernel_name = 'hybrid_stream_ret_rwkv7_conformer_swa'


def rms_norm(x, g):
    xf = x.astype(jnp.float32)
    y = xf * lax.rsqrt(jnp.mean(xf * xf, axis=-1, keepdims=True) + RMS_EPS)
    return (y * g.astype(jnp.float32)).astype(x.dtype)


def layer_norm(x, g, b, eps):
    xf = x.astype(jnp.float32)
    xc = xf - jnp.mean(xf, axis=-1, keepdims=True)
    y = xc * lax.rsqrt(jnp.mean(xc * xc, axis=-1, keepdims=True) + eps)
    return (y * g.astype(jnp.float32) + b.astype(jnp.float32)).astype(x.dtype)


def head_norm(x, g, eps):
    xf = x.astype(jnp.float32)
    xc = xf - jnp.mean(xf, axis=-1, keepdims=True)
    y = xc * lax.rsqrt(jnp.mean(xc * xc, axis=-1, keepdims=True) + eps)
    y = y.reshape(x.shape[0], x.shape[1], -1) * g.astype(jnp.float32)
    return y.astype(x.dtype)


def rope(x, pos, rot_dim, theta):
    half = rot_dim // 2
    inv = jnp.exp(jnp.arange(half, dtype=jnp.float32) * (-2.0 * math.log(theta) / rot_dim))
    ang = pos.astype(jnp.float32)[:, None] * inv[None, :]
    cos = jnp.cos(ang)[:, None, :].astype(x.dtype)
    sin = jnp.sin(ang)[:, None, :].astype(x.dtype)
    x1 = x[..., :half]
    x2 = x[..., half:rot_dim]
    return jnp.concatenate([x1 * cos - x2 * sin, x1 * sin + x2 * cos, x[..., rot_dim:]], axis=-1)


def retention(q, k, v, r0):
    B, L, H, _ = q.shape
    C = min(CHUNK, L)
    n = L // C
    lg = jnp.log1p(-jnp.exp2(-5.0 - jnp.arange(H, dtype=jnp.float32)))
    idx = jnp.arange(C, dtype=jnp.float32)
    diff = idx[:, None] - idx[None, :]
    dmat = jnp.where(diff >= 0, jnp.exp(lg[:, None, None] * jnp.maximum(diff, 0.0)), 0.0).astype(v.dtype)
    q_dec = jnp.exp(lg[:, None] * (idx + 1.0)).astype(v.dtype)
    k_dec = jnp.exp(lg[:, None] * (C - 1.0 - idx)).astype(v.dtype)
    c_dec = jnp.exp(lg * C).astype(v.dtype)

    def blocks(t):
        return t.reshape(B, n, C, H, t.shape[-1]).transpose(1, 0, 3, 2, 4)

    def step(r, blk):
        qc, kc, vc = blk
        inner = jnp.einsum('bhqd,bhkd->bhqk', qc, kc) * dmat
        o = jnp.einsum('bhqk,bhke->bhqe', inner, vc) + jnp.einsum('bhqd,bhde->bhqe', qc, r) * q_dec[..., None]
        r = r * c_dec[:, None, None] + jnp.einsum('bhkd,bhke->bhde', kc * k_dec[..., None], vc)
        return r, o

    r_fin, o = lax.scan(step, r0, (blocks(q), blocks(k), blocks(v)))
    return o.transpose(1, 0, 3, 2, 4).reshape(B, L, H, -1), r_fin


def rwkv7_mix(p, prev, s0, mu, w0, w2, a0, a2, g2, k_k, k_a, r_k, ln_g, ln_b):
    B, L, _ = p.shape
    H, N, W = RWKV_HEADS, RWKV_HD, RWKV_WIDTH
    p_prev = jnp.concatenate([prev[:, None, :], p[:, :-1]], axis=1)
    xs = p + (p_prev - p) * mu
    o_w = 3 * W
    o_a = o_w + RWKV_W_LORA
    o_g = o_a + RWKV_A_LORA
    r, k, v = xs[..., :W], xs[..., W:2 * W], xs[..., 2 * W:o_w]
    w_log = -jax.nn.softplus(-(w0 + jnp.tanh(xs[..., o_w:o_a]) @ w2)) - 0.5
    decay = jnp.exp(-jnp.exp(w_log))
    a = jax.nn.sigmoid(a0 + xs[..., o_a:o_g] @ a2)
    g = jax.nn.sigmoid(xs[..., o_g:]) @ g2
    kkf = (k * k_k).reshape(B, L, H, N).astype(jnp.float32)
    kk = (kkf / jnp.maximum(jnp.sqrt(jnp.sum(kkf * kkf, axis=-1, keepdims=True)), 1e-12)).astype(p.dtype)
    k = k * (1.0 + (a - 1.0) * k_a)

    def heads(t):
        return t.reshape(B, L, H, N)

    def tmajor(t):
        return heads(t).transpose(1, 0, 2, 3)

    def step(S, inp):
        r_t, w_t, k_t, v_t, kk_t, a_t = inp
        sa = jnp.einsum('bhij,bhj->bhi', S, -kk_t)
        S = S * w_t[:, :, None, :] + sa[..., None] * (kk_t * a_t)[:, :, None, :] + v_t[..., None] * k_t[:, :, None, :]
        return S, jnp.einsum('bhij,bhj->bhi', S, r_t)

    s_fin, y = lax.scan(step, s0, (tmajor(r), tmajor(decay), tmajor(k), tmajor(v), kk.transpose(1, 0, 2, 3), tmajor(a)))
    y = head_norm(y.transpose(1, 0, 2, 3), ln_g, RWKV_LN_EPS) + ln_b
    bonus = jnp.sum(heads(r) * heads(k) * r_k, axis=-1, keepdims=True) * heads(v)
    y = (y + bonus.reshape(B, L, W)) * g
    return y, s_fin, p[:, -1]


def conv_mix(cu, buf, conv_w, conv_b, ln_g, ln_b):
    u = cu[..., :CONV_CH] * jax.nn.sigmoid(cu[..., CONV_CH:])
    up = jnp.concatenate([buf, u], axis=1)
    y = lax.conv_general_dilated(up, conv_w[:, None, :], window_strides=(1,), padding='VALID',
                                 dimension_numbers=('NWC', 'WIO', 'NWC'), feature_group_count=CONV_CH) + conv_b
    y = jax.nn.silu(layer_norm(y, ln_g, ln_b, LN_EPS))
    return y, up[:, up.shape[1] - (CONV_WIDTH - 1):]


def swa_attention(q, k, v, past_k, past_v, sink, has_past):
    B, L = q.shape[0], q.shape[1]
    P = past_k.shape[1]
    C = min(CHUNK, L)
    n = L // C
    kp = jnp.concatenate([past_k, k], axis=1)
    vp = jnp.concatenate([past_v, v], axis=1)
    idx = (jnp.arange(n) * C)[:, None] + jnp.arange(P + C)[None, :]
    kb = kp[:, idx]
    vb = vp[:, idx]
    qb = q.reshape(B, n, C, ATT_KV_HEADS, ATT_GROUP, ATT_HD)
    s = jnp.einsum('bnqkgd,bnskd->bnkgqs', qb, kb).astype(jnp.float32) * (ATT_HD ** -0.5)
    if not has_past:
        s = jnp.where((idx >= P)[None, :, None, None, None, :], s, NEG_INF)
    sk = sink.astype(jnp.float32).reshape(1, 1, ATT_KV_HEADS, ATT_GROUP, 1, 1)
    m = jnp.maximum(jnp.max(s, axis=-1, keepdims=True), sk)
    e = jnp.exp(s - m)
    pr = e / (jnp.sum(e, axis=-1, keepdims=True) + jnp.exp(sk - m))
    o = jnp.einsum('bnkgqs,bnskd->bnqkgd', pr.astype(v.dtype), vb)
    return o.reshape(B, L, ATT_HEADS * ATT_HD), kp[:, L:], vp[:, L:]


def _trunk(x, pos0, has_past, st_ret, st_wkv, st_shift, st_conv, st_k, st_v, prm):
    B, L, _ = x.shape
    pos = pos0 + jnp.arange(L, dtype=jnp.int32)
    new_ret, new_wkv, new_shift, new_conv, new_k, new_v = [], [], [], [], [], []
    for layer in range(DEPTH):
        i = layer // 2
        h = rms_norm(x, prm['norm_mix'][layer])
        if layer % 2 == 0:
            proj = h @ prm['w_in_ab'][i]
            qk = RET_HEADS * RET_DK
            o_v = 2 * qk
            o_gt = o_v + RET_WIDTH
            o_rw = o_gt + RET_WIDTH
            q = rope(proj[..., :qk].reshape(B, L, RET_HEADS, RET_DK), pos, RET_DK, RET_THETA)
            k = rope(proj[..., qk:o_v].reshape(B, L, RET_HEADS, RET_DK), pos, RET_DK, RET_THETA) * (RET_DK ** -0.5)
            v = proj[..., o_v:o_gt].reshape(B, L, RET_HEADS, RET_DV)
            o_ret, r_new = retention(q, k, v, st_ret[i])
            o_ret = jax.nn.silu(proj[..., o_gt:o_rw]) * head_norm(o_ret, prm['ret_gn_g'][i], LN_EPS)
            o_rwkv, s_new, sh_new = rwkv7_mix(proj[..., o_rw:], st_shift[i], st_wkv[i], prm['rwkv_mu'][i],
                                              prm['rwkv_w0'][i], prm['rwkv_w2'][i], prm['rwkv_a0'][i],
                                              prm['rwkv_a2'][i], prm['rwkv_g2'][i], prm['rwkv_kk'][i],
                                              prm['rwkv_ka'][i], prm['rwkv_rk'][i], prm['rwkv_ln_g'][i],
                                              prm['rwkv_ln_b'][i])
            x = x + jnp.concatenate([o_ret, o_rwkv], axis=-1) @ prm['w_out_ab'][i]
            new_ret.append(r_new)
            new_wkv.append(s_new)
            new_shift.append(sh_new)
        else:
            proj = h @ prm['w_in_cd'][i]
            o1 = 2 * CONV_CH
            o2 = o1 + ATT_HEADS * ATT_HD
            o3 = o2 + ATT_KV_HEADS * ATT_HD
            o_conv, c_new = conv_mix(proj[..., :o1], st_conv[i], prm['conv_w'][i], prm['conv_b'][i],
                                     prm['conv_ln_g'][i], prm['conv_ln_b'][i])
            q = rope(proj[..., o1:o2].reshape(B, L, ATT_HEADS, ATT_HD), pos, ROT_DIM, ROPE_THETA)
            k = rope(proj[..., o2:o3].reshape(B, L, ATT_KV_HEADS, ATT_HD), pos, ROT_DIM, ROPE_THETA)
            v = proj[..., o3:].reshape(B, L, ATT_KV_HEADS, ATT_HD)
            o_att, k_new, v_new = swa_attention(q, k, v, st_k[i], st_v[i], prm['attn_sink'][i], has_past)
            x = x + jnp.concatenate([o_conv, o_att], axis=-1) @ prm['w_out_cd'][i]
            new_conv.append(c_new)
            new_k.append(k_new)
            new_v.append(v_new)
        h = rms_norm(x, prm['norm_ffn'][layer])
        x = x + (jax.nn.silu(h @ prm['ffn_gate'][layer]) * (h @ prm['ffn_up'][layer])) @ prm['ffn_down'][layer]
    return (rms_norm(x, prm['norm_final']), jnp.stack(new_ret), jnp.stack(new_wkv), jnp.stack(new_shift),
            jnp.stack(new_conv), jnp.stack(new_k), jnp.stack(new_v))


def setup_inputs(seed: int = 0) -> dict:
    key = jax.random.key(seed)
    keys = jax.random.split(key, 40)
    counter = [0]

    def nk():
        counter[0] += 1
        return keys[counter[0] - 1]

    def nrm(shape, scale):
        return jax.random.normal(nk(), shape, jnp.float32) * scale

    def gain(shape):
        return 1.0 + nrm(shape, 0.01)

    p_rows = min(WINDOW, PAST_LEN)
    return {
        'x_prompt': nrm((BATCH, SEQ, D_MODEL), 1.0),
        'x_sample': nrm((DEC_BATCH, DEC_SEQ, D_MODEL), 1.0),
        'state_ret': nrm((N_AB, DEC_BATCH, RET_HEADS, RET_DK, RET_DV), 1.0),
        'state_wkv': nrm((N_AB, DEC_BATCH, RWKV_HEADS, RWKV_HD, RWKV_HD), 0.5),
        'state_shift': nrm((N_AB, DEC_BATCH, RWKV_PROJ), 1.0),
        'state_conv': nrm((N_CD, DEC_BATCH, CONV_WIDTH - 1, CONV_CH), 0.5),
        'cache_k': nrm((N_CD, DEC_BATCH, p_rows, ATT_KV_HEADS, ATT_HD), 1.0),
        'cache_v': nrm((N_CD, DEC_BATCH, p_rows, ATT_KV_HEADS, ATT_HD), 1.0),
        'norm_mix': gain((DEPTH, D_MODEL)),
        'norm_ffn': gain((DEPTH, D_MODEL)),
        'norm_final': gain((D_MODEL,)),
        'w_in_ab': nrm((N_AB, D_MODEL, IN_AB), D_MODEL ** -0.5),
        'w_out_ab': nrm((N_AB, MIX_AB, D_MODEL), MIX_AB ** -0.5),
        'ret_gn_g': gain((N_AB, RET_WIDTH)),
        'rwkv_mu': jax.random.uniform(nk(), (N_AB, RWKV_PROJ), jnp.float32, 0.0, 1.0),
        'rwkv_w0': jax.random.uniform(nk(), (N_AB, RWKV_WIDTH), jnp.float32, -6.0, -1.0),
        'rwkv_w2': nrm((N_AB, RWKV_W_LORA, RWKV_WIDTH), 0.1 * RWKV_W_LORA ** -0.5),
        'rwkv_a0': nrm((N_AB, RWKV_WIDTH), 0.1),
        'rwkv_a2': nrm((N_AB, RWKV_A_LORA, RWKV_WIDTH), 0.1 * RWKV_A_LORA ** -0.5),
        'rwkv_g2': nrm((N_AB, RWKV_G_LORA, RWKV_WIDTH), RWKV_G_LORA ** -0.5),
        'rwkv_kk': 0.85 + nrm((N_AB, RWKV_WIDTH), 0.01),
        'rwkv_ka': gain((N_AB, RWKV_WIDTH)),
        'rwkv_rk': nrm((N_AB, RWKV_HEADS, RWKV_HD), 0.1),
        'rwkv_ln_g': gain((N_AB, RWKV_WIDTH)),
        'rwkv_ln_b': nrm((N_AB, RWKV_WIDTH), 0.01),
        'w_in_cd': nrm((N_CD, D_MODEL, IN_CD), D_MODEL ** -0.5),
        'w_out_cd': nrm((N_CD, MIX_CD, D_MODEL), MIX_CD ** -0.5),
        'conv_w': nrm((N_CD, CONV_WIDTH, CONV_CH), CONV_WIDTH ** -0.5),
        'conv_b': nrm((N_CD, CONV_CH), 0.01),
        'conv_ln_g': gain((N_CD, CONV_CH)),
        'conv_ln_b': nrm((N_CD, CONV_CH), 0.01),
        'attn_sink': nrm((N_CD, ATT_HEADS), 0.5),
        'ffn_gate': nrm((DEPTH, D_MODEL, D_FF), D_MODEL ** -0.5),
        'ffn_up': nrm((DEPTH, D_MODEL, D_FF), D_MODEL ** -0.5),
        'ffn_down': nrm((DEPTH, D_FF, D_MODEL), D_FF ** -0.5),
    }


def reference(x_prompt, x_sample, state_ret, state_wkv, state_shift, state_conv, cache_k, cache_v,
              norm_mix, norm_ffn, norm_final, w_in_ab, w_out_ab, ret_gn_g, rwkv_mu, rwkv_w0, rwkv_w2,
              rwkv_a0, rwkv_a2, rwkv_g2, rwkv_kk, rwkv_ka, rwkv_rk, rwkv_ln_g, rwkv_ln_b, w_in_cd, w_out_cd,
              conv_w, conv_b, conv_ln_g, conv_ln_b, attn_sink, ffn_gate, ffn_up, ffn_down):
    prm = {
        'norm_mix': norm_mix, 'norm_ffn': norm_ffn, 'norm_final': norm_final,
        'w_in_ab': w_in_ab, 'w_out_ab': w_out_ab, 'ret_gn_g': ret_gn_g,
        'rwkv_mu': rwkv_mu, 'rwkv_w0': rwkv_w0, 'rwkv_w2': rwkv_w2, 'rwkv_a0': rwkv_a0, 'rwkv_a2': rwkv_a2,
        'rwkv_g2': rwkv_g2, 'rwkv_kk': rwkv_kk, 'rwkv_ka': rwkv_ka, 'rwkv_rk': rwkv_rk,
        'rwkv_ln_g': rwkv_ln_g, 'rwkv_ln_b': rwkv_ln_b,
        'w_in_cd': w_in_cd, 'w_out_cd': w_out_cd, 'conv_w': conv_w, 'conv_b': conv_b,
        'conv_ln_g': conv_ln_g, 'conv_ln_b': conv_ln_b, 'attn_sink': attn_sink,
        'ffn_gate': ffn_gate, 'ffn_up': ffn_up, 'ffn_down': ffn_down,
    }
    B = x_prompt.shape[0]
    dt = x_prompt.dtype
    kv_rows = cache_k.shape[2]
    z_ret = jnp.zeros((N_AB, B, RET_HEADS, RET_DK, RET_DV), dt)
    z_wkv = jnp.zeros((N_AB, B, RWKV_HEADS, RWKV_HD, RWKV_HD), dt)
    z_shift = jnp.zeros((N_AB, B, RWKV_PROJ), dt)
    z_conv = jnp.zeros((N_CD, B, CONV_WIDTH - 1, CONV_CH), dt)
    z_kv = jnp.zeros((N_CD, B, kv_rows, ATT_KV_HEADS, ATT_HD), dt)
    y_prompt, ret_p, wkv_p, shift_p, conv_p, k_p, v_p = _trunk(
        x_prompt, 0, False, z_ret, z_wkv, z_shift, z_conv, z_kv, z_kv, prm)
    y_sample, ret_s, wkv_s, shift_s, conv_s, k_s, v_s = _trunk(
        x_sample, PAST_LEN, True, state_ret, state_wkv, state_shift, state_conv, cache_k, cache_v, prm)
    return (y_prompt, y_sample, ret_p, wkv_p, shift_p, conv_p, k_p, v_p, ret_s, wkv_s, shift_s, conv_s, k_s, v_s)
```

```cpp
#include <hip/hip_runtime.h>
#include <cstdio>
#include <cstdint>
#include <cmath>

constexpr int D_MODEL = 1024, TP = 16384, NSAMP = 16, LS = 64, T_ALL = TP + NSAMP * LS;
constexpr int NCH = T_ALL / 64;
constexpr int N_AB = 3840, N_CD = 1792, D_FF = 2816, N_GU = 2 * D_FF;
constexpr int PAST_POS = 4096;
constexpr int RWKV_PROJ = 1792, RW_OFF = 2048;
constexpr float RMS_EPS = 1e-6f, LN_EPS = 1e-5f, RWKV_LN_EPS = 64e-5f;
namespace pg8 {
#define PG8_LAS __attribute__((address_space(3)))
typedef unsigned short bf16_t;
typedef short bf16x8 __attribute__((ext_vector_type(8)));
typedef float f32x4 __attribute__((ext_vector_type(4)));
typedef unsigned u32x4 __attribute__((ext_vector_type(4)));
constexpr int BM = 256, BK = 64, HALF = 128, HTB = HALF * BK * 2  , STAGE_BYTES = 8 * HTB, NXCD = 8, WGM = 8;

__host__ __device__ __forceinline__ int lds_byte(int r, int c) { const int st = (r >> 4) * 2 + (c >> 5), rr = r & 15, cc = c & 31, ob = rr * 64 + cc * 2; return st * 1024 + (ob ^ (((ob >> 9) & 1) << 5)); }
__host__ __device__ __forceinline__ void stage_rc(int b, int& R, int& C) { const int st = b / 1024, sb = b % 1024, swz = sb ^ (((sb >> 9) & 1) << 5); R = (st >> 1) * 16 + swz / 64; C = (st & 1) * 32 + (swz % 64) / 2; }
__host__ __device__ __forceinline__ int perm32(int rho) { const int n = rho >> 4, i = rho & 15; return 8 * (i >> 2) + 4 * n + (i & 3); }

struct Unit { int pm, pn; };
struct Gemm { const bf16_t* A; const bf16_t* Bt; int M, N, K; };

struct StaticOrder {
    int nM, nN, nwg, G, c;
    __host__ __device__ void init(int M, int N, int G_, int c_) { nM = M / BM; nN = N / BM; nwg = nM * nN; G = G_; c = c_; }
    __host__ __device__ bool next(int i, Unit& u) const {
        const long L = (long)i * G + c; if (L >= nwg) return false;
        int wgid = (int)L; { const int q = nwg / NXCD, r = nwg % NXCD, xcd = wgid % NXCD, off = wgid / NXCD; wgid = (xcd < r ? xcd * (q + 1) : r * (q + 1) + (xcd - r) * q) + off; }
        const int nig = WGM * nN, gid = wgid / nig, fm = gid * WGM, gsz = (nM - fm) < WGM ? (nM - fm) : WGM;
        u.pm = fm + ((wgid % nig) % gsz); u.pn = (wgid % nig) / gsz; return true;
    }
    __device__ __forceinline__ void a_ready(const Unit&) const {}
    __device__ __forceinline__ void done(const Unit&) const {}
};

__device__ __forceinline__ unsigned cvt_pk_bf16(float lo, float hi) { unsigned r; asm volatile("v_cvt_pk_bf16_f32 %0, %1, %2" : "=v"(r) : "v"(lo), "v"(hi)); return r; }
__device__ __forceinline__ float row_rstd(const float* SS, int row) {
    const f32x4* p = (const f32x4*)(SS + (size_t)row * 16);
    const f32x4 a = p[0], b = p[1], c = p[2], d = p[3];
    const float s = (((a[0] + a[1]) + (a[2] + a[3])) + ((b[0] + b[1]) + (b[2] + b[3]))) + (((c[0] + c[1]) + (c[2] + c[3])) + ((d[0] + d[1]) + (d[2] + d[3])));
    return 1.0f / sqrtf(s * (1.0f / 1024.0f) + 1e-6f);
}
struct EpiNormBf16 {
    static constexpr bool PERM = true, AFTER_DRAIN = false;
    bf16_t* O; int ldc; const float* SS;
    __device__ __forceinline__ void operator()(const f32x4 (&acc)[2][2][4][2], const Unit& u, int wr, int wc, int fr, int fq) const {
        const int row0 = u.pm * BM + wr * 64 + fr, col0 = u.pn * BM + wc * 32 + 8 * fq;
#pragma unroll
        for (int ai = 0; ai < 2; ++ai)
#pragma unroll
            for (int m = 0; m < 4; ++m) { const int row = row0 + ai * HALF + m * 16; const float rs = row_rstd(SS, row); bf16_t* rowp = O + (size_t)row * ldc + col0;
#pragma unroll
                for (int bj = 0; bj < 2; ++bj) { const f32x4 v0 = acc[ai][bj][m][0] * rs, v1 = acc[ai][bj][m][1] * rs;
                    u32x4 w; w.x = cvt_pk_bf16(v0[0], v0[1]); w.y = cvt_pk_bf16(v0[2], v0[3]); w.z = cvt_pk_bf16(v1[0], v1[1]); w.w = cvt_pk_bf16(v1[2], v1[3]);
                    *(u32x4*)(rowp + bj * HALF) = w; } }
    }
};
struct EpiResid {
    static constexpr bool PERM = true, AFTER_DRAIN = false;
    const float* res_lo; const float* res_hi; int split;
    float* X; bf16_t* XB; float* SS;
    __device__ __forceinline__ void operator()(const f32x4 (&acc)[2][2][4][2], const Unit& u, int wr, int wc, int fr, int fq) const {
        const int row0 = u.pm * BM + wr * 64 + fr, col0 = u.pn * BM + wc * 32 + 8 * fq;
#pragma unroll
        for (int ai = 0; ai < 2; ++ai)
#pragma unroll
            for (int m = 0; m < 4; ++m) { const int row = row0 + ai * HALF + m * 16;
                const float* rp = (row < split ? res_lo + (size_t)row * 1024 : res_hi + (size_t)(row - split) * 1024) + col0;
                float* xp = X + (size_t)row * 1024 + col0; bf16_t* bp = XB + (size_t)row * 1024 + col0; float ssq = 0.f;
#pragma unroll
                for (int bj = 0; bj < 2; ++bj) { const f32x4 r0 = *(const f32x4*)(rp + bj * HALF), r1 = *(const f32x4*)(rp + bj * HALF + 4);
                    const f32x4 v0 = acc[ai][bj][m][0] + r0, v1 = acc[ai][bj][m][1] + r1;
                    *(f32x4*)(xp + bj * HALF) = v0; *(f32x4*)(xp + bj * HALF + 4) = v1;
                    u32x4 w; w.x = cvt_pk_bf16(v0[0], v0[1]); w.y = cvt_pk_bf16(v0[2], v0[3]); w.z = cvt_pk_bf16(v1[0], v1[1]); w.w = cvt_pk_bf16(v1[2], v1[3]);
                    *(u32x4*)(bp + bj * HALF) = w;
                    ssq += ((v0[0] * v0[0] + v0[1] * v0[1]) + (v0[2] * v0[2] + v0[3] * v0[3])) + ((v1[0] * v1[0] + v1[1] * v1[1]) + (v1[2] * v1[2] + v1[3] * v1[3])); }
                ssq += __shfl_xor(ssq, 16); ssq += __shfl_xor(ssq, 32);
                if (fq == 0) SS[(size_t)row * 16 + u.pn * 4 + wc] = ssq; }
    }
};
struct EpiSwiGLU {
    static constexpr bool PERM = true, AFTER_DRAIN = false;
    bf16_t* O; int ldc; const float* SS;
    __device__ __forceinline__ void operator()(const f32x4 (&acc)[2][2][4][2], const Unit& u, int wr, int wc, int fr, int fq) const {
        const int row0 = u.pm * BM + wr * 64 + fr, col0 = u.pn * HALF + wc * 32 + 8 * fq;
#pragma unroll
        for (int ai = 0; ai < 2; ++ai)
#pragma unroll
            for (int m = 0; m < 4; ++m) { const int row = row0 + ai * HALF + m * 16; const float rs = row_rstd(SS, row);
                float o[8];
#pragma unroll
                for (int n = 0; n < 2; ++n)
#pragma unroll
                    for (int e = 0; e < 4; ++e) { const float g = acc[ai][0][m][n][e] * rs, up = acc[ai][1][m][n][e] * rs; o[4 * n + e] = g / (1.0f + __expf(-g)) * up; }
                u32x4 w; w.x = cvt_pk_bf16(o[0], o[1]); w.y = cvt_pk_bf16(o[2], o[3]); w.z = cvt_pk_bf16(o[4], o[5]); w.w = cvt_pk_bf16(o[6], o[7]);
                *(u32x4*)(O + (size_t)row * ldc + col0) = w; }
    }
};
template <class Epi, class Sched, bool ALIGN_EPI = false, bool SP2 = false>
__device__ __forceinline__ void gemm_phase(PG8_LAS unsigned char* lds, const Gemm g, const Sched& S, const Epi& E) {
    const int tid = threadIdx.x, wid = __builtin_amdgcn_readfirstlane(tid >> 6), lane = tid & 63, wr = wid >> 2, wc = wid & 3, fr = lane & 15, fq = lane >> 4;
    const int K = g.K, nt = K / BK;
    unsigned voffA[2], voffB[2];
#pragma unroll
    for (int i = 0; i < 2; ++i) { int R, C; stage_rc(tid * 16 + i * 8192, R, C); const int Rb = Epi::PERM ? ((R & ~31) + perm32(R & 31)) : R;
        voffA[i] = (unsigned)(R * K + C) * 2u; voffB[i] = (unsigned)(Rb * K + C) * 2u; }
    const size_t kstep = (size_t)(BK * 2);
    const size_t hstep = (size_t)HALF * K * 2;
    const size_t tstep = 2 * hstep;
    const unsigned ldsw = (unsigned)wid * 1024u;
    const int aoff = lds_byte(wr * 64 + fr, fq * 8), boff = lds_byte(wc * 32 + fr, fq * 8);
#define PG8_SA(b, h) (((b) * 2 + (h)) * HTB)
#define PG8_SB(b, h) ((4 + (b) * 2 + (h)) * HTB)
#define PG8_STAGE(bufoff, gbase, voff) do { _Pragma("unroll") for (int _i = 0; _i < 2; ++_i) \
        __builtin_amdgcn_global_load_lds((const unsigned*)((const char*)(gbase) + (voff)[_i]), (PG8_LAS unsigned*)(lds + (bufoff) + ldsw + _i * 8192), 16, 0, 0); } while (0)
#define PG8_LDA(dst, b, h) do { _Pragma("unroll") for (int m = 0; m < 4; ++m) _Pragma("unroll") for (int k = 0; k < 2; ++k) dst[m][k] = *(const PG8_LAS bf16x8*)(lds + PG8_SA(b, h) + aoff + m * 2048 + k * 1024); } while (0)
#define PG8_LDB(dst, b, h) do { _Pragma("unroll") for (int n = 0; n < 2; ++n) _Pragma("unroll") for (int k = 0; k < 2; ++k) dst[n][k] = *(const PG8_LAS bf16x8*)(lds + PG8_SB(b, h) + boff + n * 2048 + k * 1024); } while (0)
#define PG8_MMA(ai, bj, At, Bt) do { __builtin_amdgcn_s_setprio(1); _Pragma("unroll") for (int m = 0; m < 4; ++m) _Pragma("unroll") for (int n = 0; n < 2; ++n) _Pragma("unroll") for (int k = 0; k < 2; ++k) \
        acc[ai][bj][m][n] = __builtin_amdgcn_mfma_f32_16x16x32_bf16(Bt[n][k], At[m][k], acc[ai][bj][m][n], 0, 0, 0); __builtin_amdgcn_s_setprio(0); } while (0)
#define PG8_WAIT_V(n) asm volatile("s_waitcnt vmcnt(" #n ")" ::: "memory")
#define PG8_WAIT_L(n) asm volatile("s_waitcnt lgkmcnt(" #n ")" ::: "memory")
#define PG8_BAR __builtin_amdgcn_s_barrier()
#define PG8_SCHED __builtin_amdgcn_sched_barrier(0)
    Unit cur, nxt; int ui = 0;
    if (!S.next(0, cur)) return;
    f32x4 acc[2][2][4][2];
#pragma unroll
    for (int a = 0; a < 2; ++a)
#pragma unroll
        for (int b = 0; b < 2; ++b)
#pragma unroll
            for (int m = 0; m < 4; ++m)
#pragma unroll
                for (int n = 0; n < 2; ++n) acc[a][b][m][n] = (f32x4){0.f, 0.f, 0.f, 0.f};
    bf16x8 At[4][2], B0[2][2], B1[2][2];
    const char* cA = (const char*)g.A + (size_t)cur.pm * tstep; const char* cB = (const char*)g.Bt + (size_t)cur.pn * tstep;
    S.a_ready(cur);
    if constexpr (SP2) {
        PG8_STAGE(PG8_SB(0, 0), cB, voffB); PG8_STAGE(PG8_SB(0, 1), cB + hstep, voffB); PG8_STAGE(PG8_SA(0, 0), cA, voffA); PG8_STAGE(PG8_SA(0, 1), cA + hstep, voffA);
        if (wr == 1) PG8_BAR;
        PG8_WAIT_V(2); PG8_BAR;
        PG8_STAGE(PG8_SB(1, 0), cB + kstep, voffB); PG8_STAGE(PG8_SA(1, 0), cA + kstep, voffA); PG8_STAGE(PG8_SB(1, 1), cB + hstep + kstep, voffB);
        PG8_WAIT_V(6); PG8_BAR;
    } else {
        PG8_STAGE(PG8_SB(0, 0), cB, voffB); PG8_STAGE(PG8_SA(0, 0), cA, voffA); PG8_STAGE(PG8_SB(0, 1), cB + hstep, voffB); PG8_STAGE(PG8_SA(0, 1), cA + hstep, voffA);
        if (wr == 1) PG8_BAR;
        PG8_WAIT_V(4); PG8_BAR;
        PG8_STAGE(PG8_SB(1, 0), cB + kstep, voffB); PG8_STAGE(PG8_SA(1, 0), cA + kstep, voffA); PG8_STAGE(PG8_SB(1, 1), cB + hstep + kstep, voffB);
        PG8_WAIT_V(6); PG8_BAR;
    }
    for (;;) {
        const bool has_next = S.next(ui + 1, nxt);
        const char* nA = has_next ? (const char*)g.A + (size_t)nxt.pm * tstep : cA; const char* nB = has_next ? (const char*)g.Bt + (size_t)nxt.pn * tstep : cB;
        for (int t = 0; t < nt; t += 2) {
            const bool last = (t == nt - 2);
            const char* a1 = cA + (size_t)(t + 1) * kstep;
            const char* a2 = last ? nA : cA + (size_t)(t + 2) * kstep; const char* b2 = last ? nB : cB + (size_t)(t + 2) * kstep;
            const char* a3 = a2 + kstep; const char* b3 = b2 + kstep;
            if (last && has_next) S.a_ready(nxt);
            if constexpr (SP2) {
            PG8_LDB(B0, 0, 0); PG8_LDB(B1, 0, 1); PG8_SCHED; PG8_LDA(At, 0, 0); PG8_STAGE(PG8_SA(1, 1), a1 + hstep, voffA);
            PG8_WAIT_V(8); PG8_WAIT_L(0); PG8_BAR; PG8_MMA(0, 0, At, B0); PG8_MMA(0, 1, At, B1); PG8_BAR; PG8_SCHED;
            PG8_LDA(At, 0, 1); PG8_STAGE(PG8_SB(0, 0), b2, voffB); PG8_STAGE(PG8_SB(0, 1), b2 + hstep, voffB); PG8_STAGE(PG8_SA(0, 0), a2, voffA);
            PG8_WAIT_V(8); PG8_WAIT_L(0); PG8_BAR; PG8_MMA(1, 0, At, B0); PG8_MMA(1, 1, At, B1); PG8_BAR; PG8_SCHED;
            PG8_LDB(B0, 1, 0); PG8_LDB(B1, 1, 1); PG8_SCHED; PG8_LDA(At, 1, 0); PG8_STAGE(PG8_SA(0, 1), a2 + hstep, voffA);
            PG8_WAIT_V(8); PG8_WAIT_L(0); PG8_BAR; PG8_MMA(0, 0, At, B0); PG8_MMA(0, 1, At, B1); PG8_BAR; PG8_SCHED;
            PG8_LDA(At, 1, 1); PG8_STAGE(PG8_SB(1, 0), b3, voffB); PG8_STAGE(PG8_SB(1, 1), b3 + hstep, voffB); PG8_STAGE(PG8_SA(1, 0), a3, voffA);
            PG8_WAIT_V(8); PG8_WAIT_L(0); PG8_BAR; PG8_MMA(1, 0, At, B0); PG8_MMA(1, 1, At, B1); PG8_BAR; PG8_SCHED;
            } else {
            PG8_LDB(B0, 0, 0); PG8_SCHED; PG8_LDA(At, 0, 0); PG8_STAGE(PG8_SA(1, 1), a1 + hstep, voffA);
            PG8_WAIT_L(8); PG8_BAR; PG8_WAIT_L(0); PG8_MMA(0, 0, At, B0); PG8_BAR; PG8_SCHED;
            PG8_LDB(B1, 0, 1); PG8_STAGE(PG8_SB(0, 0), b2, voffB);
            PG8_BAR; PG8_WAIT_L(0); PG8_MMA(0, 1, At, B1); PG8_BAR;
            PG8_LDA(At, 0, 1); PG8_STAGE(PG8_SA(0, 0), a2, voffA);
            PG8_BAR; PG8_WAIT_L(0); PG8_MMA(1, 0, At, B0); PG8_BAR; PG8_SCHED;
            PG8_STAGE(PG8_SB(0, 1), b2 + hstep, voffB);
            PG8_WAIT_V(6); PG8_BAR; PG8_MMA(1, 1, At, B1); PG8_BAR;
            PG8_LDB(B0, 1, 0); PG8_SCHED; PG8_LDA(At, 1, 0); PG8_STAGE(PG8_SA(0, 1), a2 + hstep, voffA);
            PG8_WAIT_L(8); PG8_BAR; PG8_WAIT_L(0); PG8_MMA(0, 0, At, B0); PG8_BAR; PG8_SCHED;
            PG8_LDB(B1, 1, 1); PG8_STAGE(PG8_SB(1, 0), b3, voffB);
            PG8_BAR; PG8_WAIT_L(0); PG8_MMA(0, 1, At, B1); PG8_BAR;
            PG8_LDA(At, 1, 1); PG8_STAGE(PG8_SA(1, 0), a3, voffA);
            PG8_BAR; PG8_WAIT_L(0); PG8_MMA(1, 0, At, B0); PG8_BAR; PG8_SCHED;
            PG8_STAGE(PG8_SB(1, 1), b3 + hstep, voffB);
            PG8_WAIT_V(6); PG8_BAR; PG8_MMA(1, 1, At, B1); PG8_BAR;
            }
        }
        if constexpr (ALIGN_EPI) { if (wr == 0) PG8_BAR; }
        if constexpr (!Epi::AFTER_DRAIN) { E(acc, cur, wr, wc, fr, fq); S.done(cur); }
        if (!has_next) break;
#pragma unroll
        for (int a = 0; a < 2; ++a)
#pragma unroll
            for (int b = 0; b < 2; ++b)
#pragma unroll
                for (int m = 0; m < 4; ++m)
#pragma unroll
                    for (int n = 0; n < 2; ++n) acc[a][b][m][n] = (f32x4){0.f, 0.f, 0.f, 0.f};
        cur = nxt; cA = nA; cB = nB; ++ui;
        if constexpr (ALIGN_EPI) { if (wr == 1) PG8_BAR; }
    }
    PG8_WAIT_V(0);
    if constexpr (!ALIGN_EPI) { if (wr == 0) PG8_BAR; }
    PG8_BAR;
    if constexpr (Epi::AFTER_DRAIN) { E.fused(acc, cur, wr, wc, fr, fq, lds, wid, lane); S.done(cur); }
#undef PG8_SA
#undef PG8_SB
#undef PG8_STAGE
#undef PG8_LDA
#undef PG8_LDB
#undef PG8_MMA
#undef PG8_WAIT_V
#undef PG8_WAIT_L
#undef PG8_BAR
#undef PG8_SCHED
}
}
#define GAS __attribute__((address_space(1)))
#define LAS __attribute__((address_space(3)))
typedef unsigned short bf16;
typedef unsigned v4u __attribute__((ext_vector_type(4)));
typedef float f32x4 __attribute__((ext_vector_type(4)));
typedef short bf16x8 __attribute__((ext_vector_type(8)));
typedef GAS unsigned gu32;
typedef GAS unsigned long long gu64;
#define RLX_AGENT __ATOMIC_RELAXED, __HIP_MEMORY_SCOPE_AGENT
#define LDS_WAIT() asm volatile("s_waitcnt lgkmcnt(0)" ::: "memory")
#define VM_WAIT() asm volatile("s_waitcnt vmcnt(0)" ::: "memory")
__device__ __forceinline__ unsigned long long rt() { return __builtin_amdgcn_s_memrealtime(); }
__device__ __forceinline__ unsigned f2bf(float f) { unsigned u = __builtin_bit_cast(unsigned, f); return (u + 0x7fffu + ((u >> 16) & 1u)) >> 16; }
__device__ __forceinline__ unsigned pk2(float lo, float hi) { return f2bf(lo) | (f2bf(hi) << 16); }
#define XB_TMO      128
#define XB_XCNT(j)  (256  + 64 * (j))
#define XB_XSUB(j)  (1280 + 64 * (j))
#define XB_XGEN(j)  (2304 + 64 * (j))
#define XB_TOP      3328
#define XB_TOPGEN   3392
#define XCD_BAR_WORDS 3456
#define XB_SPIN_CAP (1u << 18)

__device__ __forceinline__ unsigned xb_ld(unsigned* p)              { return __hip_atomic_load(p, __ATOMIC_RELAXED, __HIP_MEMORY_SCOPE_AGENT); }
__device__ __forceinline__ unsigned xb_add(unsigned* p, unsigned v) { return __hip_atomic_fetch_add(p, v, __ATOMIC_RELAXED, __HIP_MEMORY_SCOPE_AGENT); }
__device__ __forceinline__ unsigned xb_xcc_id() { return (unsigned)__builtin_amdgcn_s_getreg((3 << 11) | 20) & 0xFu; }
#define XB_SPIN(cond, bar) do { unsigned _sp = 0; while (cond) { __builtin_amdgcn_s_sleep(1); \
    if ((++_sp & 255u) == 0u) { if (xb_ld(&(bar)[XB_TMO])) break; if (_sp > XB_SPIN_CAP) { atomicAdd(&(bar)[XB_TMO], 1u); break; } } } } while (0)

struct XcdBarrier {
    unsigned* bar; unsigned x;
    volatile LAS unsigned* st;
};

__device__ __forceinline__ XcdBarrier xcd_barrier_post(unsigned* bar, volatile LAS unsigned* st) {
    XcdBarrier b; b.bar = bar; b.x = xb_xcc_id(); b.st = st;
    if (threadIdx.x == 0) (void)xb_add(&bar[XB_XCNT(b.x)], 1u);
    return b;
}
__device__ __forceinline__ void xcd_barrier_complete(unsigned* bar, unsigned x, unsigned& nloc, unsigned& nx) {
    const unsigned G = gridDim.x * gridDim.y * gridDim.z;
    unsigned sum, cnt, mine, sp = 0u;
    for (;;) {
        sum = 0u; cnt = 0u; mine = 0u;
#pragma unroll
        for (unsigned j = 0; j < 16; ++j) { const unsigned c = xb_ld(&bar[XB_XCNT(j)]); sum += c; cnt += (c > 0u) ? 1u : 0u; mine = (j == x) ? c : mine; }
        if (sum == G) break;
        __builtin_amdgcn_s_sleep(1);
        if ((++sp & 255u) == 0u) { if (xb_ld(&bar[XB_TMO])) break; if (sp > XB_SPIN_CAP) { atomicAdd(&bar[XB_TMO], 1u); break; } }
    }
    nloc = mine > 0u ? mine : 1u; nx = cnt > 0u ? cnt : 1u;
}

__device__ __forceinline__ void xcd_barrier(const XcdBarrier& b) {
    asm volatile("s_waitcnt vmcnt(0)" ::: "memory");
    __syncthreads();
    if (threadIdx.x == 0) {
        unsigned* bar = b.bar;
        __builtin_amdgcn_s_waitcnt(0);
        unsigned nloc = b.st[0], nx = b.st[1];
        if (nloc == 0u) { xcd_barrier_complete(bar, b.x, nloc, nx); b.st[0] = nloc; b.st[1] = nx; }
        const unsigned old = xb_add(&bar[XB_XSUB(b.x)], 1u);
        const unsigned gen = old / nloc;
        if (old + 1u == (gen + 1u) * nloc) {
            __builtin_amdgcn_fence(__ATOMIC_RELEASE, "agent");
            asm volatile("s_waitcnt vmcnt(0)" ::: "memory");
            const unsigned og = xb_add(&bar[XB_TOP], 1u);
            const unsigned tg = og / nx;
            if (og + 1u == (tg + 1u) * nx) xb_add(&bar[XB_TOPGEN], 1u);
            else XB_SPIN(xb_ld(&bar[XB_TOPGEN]) == tg, bar);
            __builtin_amdgcn_fence(__ATOMIC_ACQUIRE, "agent");
            xb_add(&bar[XB_XGEN(b.x)], 1u);
            asm volatile("s_waitcnt vmcnt(0)" ::: "memory");
        } else {
            XB_SPIN(xb_ld(&bar[XB_XGEN(b.x)]) == gen, bar);
            __builtin_amdgcn_fence(__ATOMIC_ACQUIRE, "agent");
            asm volatile("s_waitcnt vmcnt(0)" ::: "memory");
        }
    }
    __syncthreads();
}
#define DI __device__ __forceinline__
typedef LAS unsigned char* lptr;
typedef unsigned u32x2 __attribute__((ext_vector_type(2)));
typedef float f32x16 __attribute__((ext_vector_type(16)));
typedef float f32x2 __attribute__((ext_vector_type(2)));
DI float bf2f(unsigned h) { return __builtin_bit_cast(float, h << 16); }
DI void unpack8(const v4u w, float* o) {
    o[0] = bf2f(w.x & 0xffffu); o[1] = bf2f(w.x >> 16); o[2] = bf2f(w.y & 0xffffu); o[3] = bf2f(w.y >> 16);
    o[4] = bf2f(w.z & 0xffffu); o[5] = bf2f(w.z >> 16); o[6] = bf2f(w.w & 0xffffu); o[7] = bf2f(w.w >> 16);
}
DI v4u pack8(const float* o) { v4u w; w.x = pk2(o[0], o[1]); w.y = pk2(o[2], o[3]); w.z = pk2(o[4], o[5]); w.w = pk2(o[6], o[7]); return w; }
DI void ld8f(const float* p, float* o) { const f32x4 a = *(const f32x4*)p, b = *(const f32x4*)(p + 4); o[0] = a[0]; o[1] = a[1]; o[2] = a[2]; o[3] = a[3]; o[4] = b[0]; o[5] = b[1]; o[6] = b[2]; o[7] = b[3]; }
DI void st8f(float* p, const float* o) { *(f32x4*)p = (f32x4){o[0], o[1], o[2], o[3]}; *(f32x4*)(p + 4) = (f32x4){o[4], o[5], o[6], o[7]}; }
DI void ld8bf(const bf16* p, float* o) { unpack8(*(const v4u*)p, o); }
DI float sigmoidf_(float x) { return 1.0f / (1.0f + __expf(-x)); }

template <int K> DI void mma16(f32x4& acc, lptr A, int lda, lptr Bt, int ldb, int fr, int fq) {
#pragma unroll
    for (int k0 = 0; k0 < K; k0 += 32) {
        const bf16x8 a = *(const LAS bf16x8*)(A + fr * lda + (k0 + 8 * fq) * 2);
        const bf16x8 b = *(const LAS bf16x8*)(Bt + fr * ldb + (k0 + 8 * fq) * 2);
        acc = __builtin_amdgcn_mfma_f32_16x16x32_bf16(a, b, acc, 0, 0, 0);
    }
}
DI void st_rm(lptr M, int ld, int r0, int c0, const f32x4 v, int fr, int fq) {
#pragma unroll
    for (int i = 0; i < 4; ++i) *(LAS bf16*)(M + (r0 + 4 * fq + i) * ld + (c0 + fr) * 2) = (bf16)f2bf(v[i]);
}
DI void st_tr(lptr MT, int ld, int r0, int c0, const f32x4 v, int fr, int fq) {
    u32x2 w; w.x = pk2(v[0], v[1]); w.y = pk2(v[2], v[3]);
    *(LAS u32x2*)(MT + (c0 + fr) * ld + (r0 + 4 * fq) * 2) = w;
}
DI u32x2 pack4(const f32x4 v) { u32x2 w; w.x = pk2(v[0], v[1]); w.y = pk2(v[2], v[3]); return w; }
DI f32x4 unpack4(const u32x2 w) { return (f32x4){bf2f(w.x & 0xffffu), bf2f(w.x >> 16), bf2f(w.y & 0xffffu), bf2f(w.y >> 16)}; }
DI void g2l_64x64(lptr dst, const bf16* src, int tid) { const int r = tid >> 3, s = tid & 7; *(LAS v4u*)(dst + r * 144 + s * 16) = *(const v4u*)(src + r * 64 + s * 8); }
DI void l2g_64x64(bf16* dst, lptr src, int tid) { const int r = tid >> 3, s = tid & 7; *(v4u*)(dst + r * 64 + s * 8) = *(const LAS v4u*)(src + r * 144 + s * 16); }

struct Ctx {
    const float *x_prompt, *x_sample, *state_ret, *state_wkv, *state_shift, *state_conv, *cache_k, *cache_v;
    const float *norm_mix, *norm_ffn, *norm_final, *w_in_ab, *w_out_ab, *ret_gn_g, *rwkv_mu, *rwkv_w0, *rwkv_w2, *rwkv_a0, *rwkv_a2, *rwkv_g2, *rwkv_kk, *rwkv_ka, *rwkv_rk, *rwkv_ln_g, *rwkv_ln_b;
    const float *w_in_cd, *w_out_cd, *conv_w, *conv_b, *conv_ln_g, *conv_ln_b, *attn_sink, *ffn_gate, *ffn_up, *ffn_down;
    float *y, *ret_p, *wkv_p, *shift_p, *conv_p, *k_p, *v_p, *ret_s, *wkv_s, *shift_s, *conv_s, *k_s, *v_s;
    float* SS; double* ROPE; bf16 *W_INAB, *W_OUTAB, *W_INCD, *W_OUTCD, *W_GU, *W_DN; bf16 *XB, *MIX, *PROJ;
    unsigned char* RW_ITEM;
    bf16* RW_STATE;
    float* RET_G;
    unsigned char* RW_COMP;
    float* RW_ENT;
    float* RW_RK;
    int tid, lane, wave, vcu, G;
    lptr lds;
};
constexpr int RW_LD = 144, RW_SLOT = 9216;
constexpr int RW_LDF = 272;
DI lptr rw_slot(lptr lds, int i) { return lds + i * RW_SLOT; }

DI void rw_load_p(const Ctx& F, int c, int t, int col, float* p, float* pp) {
    ld8bf(F.PROJ + (size_t)(c * 64 + t) * N_AB + RW_OFF + col, p);
    if (t == 0 && c >= 256) ld8f(F.state_shift + (size_t)(c - 256) * RWKV_PROJ + col, pp);
    else if (t == 0 && c == 0) {
#pragma unroll
        for (int e = 0; e < 8; ++e) pp[e] = 0.f; }
    else ld8bf(F.PROJ + (size_t)(c * 64 + t - 1) * N_AB + RW_OFF + col, pp);
}
DI void rw_shift(const Ctx& F, int c, int t, int col, float* xs) {
    float p[8], pp[8], mu[8]; rw_load_p(F, c, t, col, p, pp); ld8f(F.rwkv_mu + col, mu);
#pragma unroll
    for (int e = 0; e < 8; ++e) xs[e] = p[e] + (pp[e] - p[e]) * mu[e];
}

DI void rwkv_p1_item(const Ctx& F, int c, int h) {
    const int tid = F.tid, lane = F.lane, w = F.wave, fr = lane & 15, fq = lane >> 4, tr = w >> 1, tc0 = 2 * (w & 1);
    const lptr L = F.lds;
    const int t = tid >> 3, s8 = tid & 7;
    const lptr TW = L, AL = L + 9216, SG = L + 18432, W2T = L + 35840, A2T = L + 45056, G2T = L + 54272;
    const lptr LG = L + 8 * RW_SLOT, A32 = LG + 17408;
    LAS float* GAMC = (LAS float*)(L + 14 * RW_SLOT);
    {
        float xs[8], o[8];
        rw_shift(F, c, t, 1536 + 8 * s8, xs);
#pragma unroll
        for (int e = 0; e < 8; ++e) o[e] = tanhf(xs[e]);
        *(LAS v4u*)(TW + t * RW_LD + s8 * 16) = pack8(o);
        rw_shift(F, c, t, 1600 + 8 * s8, xs);
        *(LAS v4u*)(AL + t * RW_LD + s8 * 16) = pack8(xs);
#pragma unroll
        for (int q = 0; q < 2; ++q) { rw_shift(F, c, t, 1664 + 64 * q + 8 * s8, xs);
#pragma unroll
            for (int e = 0; e < 8; ++e) o[e] = sigmoidf_(xs[e]);
            *(LAS v4u*)(SG + t * 272 + (64 * q + 8 * s8) * 2) = pack8(o); }
        float v[8];
        ld8f(F.rwkv_w2 + (size_t)t * 512 + h * 64 + 8 * s8, v);
#pragma unroll
        for (int e = 0; e < 8; ++e) *(LAS bf16*)(W2T + (8 * s8 + e) * RW_LD + t * 2) = (bf16)f2bf(v[e]);
        ld8f(F.rwkv_a2 + (size_t)t * 512 + h * 64 + 8 * s8, v);
#pragma unroll
        for (int e = 0; e < 8; ++e) *(LAS bf16*)(A2T + (8 * s8 + e) * RW_LD + t * 2) = (bf16)f2bf(v[e]);
#pragma unroll
        for (int q = 0; q < 2; ++q) { ld8f(F.rwkv_g2 + (size_t)(t + 64 * q) * 512 + h * 64 + 8 * s8, v);
#pragma unroll
            for (int e = 0; e < 8; ++e) *(LAS bf16*)(G2T + (8 * s8 + e) * 272 + (t + 64 * q) * 2) = (bf16)f2bf(v[e]); }
    }
    __syncthreads();
    {
        f32x4 aw[2], aa[2], ag[2];
#pragma unroll
        for (int i = 0; i < 2; ++i) { aw[i] = (f32x4){0.f, 0.f, 0.f, 0.f}; aa[i] = aw[i]; ag[i] = aw[i];
            mma16<64>(aw[i], TW + 16 * tr * RW_LD, RW_LD, W2T + 16 * (tc0 + i) * RW_LD, RW_LD, fr, fq);
            mma16<64>(aa[i], AL + 16 * tr * RW_LD, RW_LD, A2T + 16 * (tc0 + i) * RW_LD, RW_LD, fr, fq);
            mma16<128>(ag[i], SG + 16 * tr * 272, 272, G2T + 16 * (tc0 + i) * 272, 272, fr, fq); }
        __syncthreads();
#pragma unroll
        for (int i = 0; i < 2; ++i) { const int j = 16 * (tc0 + i) + fr, hj = h * 64 + j; const float w0 = F.rwkv_w0[hj], a0 = F.rwkv_a0[hj];
#pragma unroll
            for (int r = 0; r < 4; ++r) { const int tt = 16 * tr + 4 * fq + r;
                const float z = -(w0 + aw[i][r]); const float sp = fmaxf(z, 0.f) + log1pf(__expf(-fabsf(z)));
                *(LAS float*)(LG + tt * RW_LDF + j * 4) = -__expf(-sp - 0.5f);
                *(LAS float*)(A32 + tt * RW_LDF + j * 4) = sigmoidf_(a0 + aa[i][r]);
                F.MIX[(size_t)(c * 64 + tt) * 1024 + 512 + hj] = (bf16)f2bf(ag[i][r]); } }
    }
    __syncthreads();
    if (w == 0) { float acc = 0.f;
#pragma unroll 8
        for (int tt = 0; tt < 64; ++tt) { acc += *(LAS float*)(LG + tt * RW_LDF + lane * 4); *(LAS float*)(LG + tt * RW_LDF + lane * 4) = acc; } }
    __syncthreads();
    {
        const int j0 = 8 * s8, hj0 = h * 64 + j0;
        float kk[8], k2[8], b[8];
        {   float xk[8], w8[8], a[8]; rw_shift(F, c, t, 512 + hj0, xk); ld8f(F.rwkv_kk + hj0, w8); float ss = 0.f;
#pragma unroll
            for (int e = 0; e < 8; ++e) { kk[e] = xk[e] * w8[e]; ss += kk[e] * kk[e]; }
            ss += __shfl_xor(ss, 1); ss += __shfl_xor(ss, 2); ss += __shfl_xor(ss, 4);
            const float inv = 1.0f / fmaxf(sqrtf(ss), 1e-12f);
            ld8f(F.rwkv_ka + hj0, w8);
#pragma unroll
            for (int e = 0; e < 8; ++e) { a[e] = *(LAS float*)(A32 + t * RW_LDF + (j0 + e) * 4); kk[e] *= inv; k2[e] = xk[e] * (1.0f + (a[e] - 1.0f) * w8[e]); b[e] = kk[e] * a[e]; } }
        asm volatile("" ::: "memory");
        float lg[8];
#pragma unroll
        for (int e = 0; e < 8; ++e) lg[e] = *(LAS float*)(LG + t * RW_LDF + (j0 + e) * 4);
        {   float xr[8], w8[8], o[8]; rw_shift(F, c, t, hj0, xr); ld8f(F.rwkv_rk + hj0, w8); float rks = 0.f;
#pragma unroll
            for (int e = 0; e < 8; ++e) { rks += xr[e] * k2[e] * w8[e]; o[e] = xr[e] * __expf(lg[e]); }
            rks += __shfl_xor(rks, 1); rks += __shfl_xor(rks, 2); rks += __shfl_xor(rks, 4);
            if (s8 == 0) F.RW_RK[(size_t)(c * 8 + h) * 64 + t] = rks;
            *(LAS v4u*)(rw_slot(L, 1) + t * RW_LD + s8 * 16) = pack8(o); }
        asm volatile("" ::: "memory");
        {   float o[8];
#pragma unroll
            for (int e = 0; e < 8; ++e) { const float lgm = t > 0 ? *(LAS float*)(LG + (t - 1) * RW_LDF + (j0 + e) * 4) : 0.f; o[e] = kk[e] * __expf(lgm); }
            *(LAS v4u*)(rw_slot(L, 0) + t * RW_LD + s8 * 16) = pack8(o);
#pragma unroll
            for (int e = 0; e < 8; ++e) *(LAS bf16*)(rw_slot(L, 4) + (j0 + e) * RW_LD + t * 2) = (bf16)f2bf(o[e]); }
        asm volatile("" ::: "memory");
        {   float o1[8], o2[8];
#pragma unroll
            for (int e = 0; e < 8; ++e) { const float ei = __expf(-lg[e]); o1[e] = b[e] * ei; o2[e] = k2[e] * ei; }
            *(LAS v4u*)(rw_slot(L, 2) + t * RW_LD + s8 * 16) = pack8(o1);
            *(LAS v4u*)(rw_slot(L, 3) + t * RW_LD + s8 * 16) = pack8(o2); }
        asm volatile("" ::: "memory");
        {
#pragma unroll
            for (int e = 0; e < 8; ++e) { const float lgc = *(LAS float*)(LG + 63 * RW_LDF + (j0 + e) * 4); const float ec = __expf(lgc - lg[e]);
                if (t == 63) GAMC[j0 + e] = __expf(lgc);
                *(LAS bf16*)(rw_slot(L, 5) + (j0 + e) * RW_LD + t * 2) = (bf16)f2bf(b[e] * ec);
                *(LAS bf16*)(rw_slot(L, 6) + (j0 + e) * RW_LD + t * 2) = (bf16)f2bf(k2[e] * ec); } }
        asm volatile("" ::: "memory");
        {   float xv[8]; rw_shift(F, c, t, 1024 + hj0, xv);
#pragma unroll
            for (int e = 0; e < 8; ++e) *(LAS bf16*)(rw_slot(L, 7) + (j0 + e) * RW_LD + t * 2) = (bf16)f2bf(xv[e]); }
    }
    __syncthreads();
    const lptr KG = rw_slot(L, 0), RG = rw_slot(L, 1), BI = rw_slot(L, 2), KI = rw_slot(L, 3), KGT = rw_slot(L, 4), BTT = rw_slot(L, 5), KTT = rw_slot(L, 6), VT = rw_slot(L, 7);
    const lptr BM = rw_slot(L, 8), PB = rw_slot(L, 9), PK = rw_slot(L, 10);
    const lptr XR0 = rw_slot(L, 11), XT0 = rw_slot(L, 12), PR0 = rw_slot(L, 13), XR1 = rw_slot(L, 0), XT1 = rw_slot(L, 2), PR1 = rw_slot(L, 3);
    f32x4 P[2];
    {
        f32x4 aA[2], aB[2], aPb[2], aPk[2];
#pragma unroll
        for (int i = 0; i < 2; ++i) { aA[i] = (f32x4){0.f, 0.f, 0.f, 0.f}; aB[i] = aA[i]; aPb[i] = aA[i]; aPk[i] = aA[i];
            mma16<64>(aA[i], KG + 16 * tr * RW_LD, RW_LD, BI + 16 * (tc0 + i) * RW_LD, RW_LD, fr, fq);
            mma16<64>(aB[i], KG + 16 * tr * RW_LD, RW_LD, KI + 16 * (tc0 + i) * RW_LD, RW_LD, fr, fq);
            mma16<64>(aPb[i], RG + 16 * tr * RW_LD, RW_LD, BI + 16 * (tc0 + i) * RW_LD, RW_LD, fr, fq);
            mma16<64>(aPk[i], RG + 16 * tr * RW_LD, RW_LD, KI + 16 * (tc0 + i) * RW_LD, RW_LD, fr, fq); }
        __syncthreads();
#pragma unroll
        for (int i = 0; i < 2; ++i) { const int s = 16 * (tc0 + i) + fr; f32x4 x, p1, bm, pb, pk;
#pragma unroll
            for (int r = 0; r < 4; ++r) { const int tt = 16 * tr + 4 * fq + r;
                x[r] = tt > s ? -aA[i][r] : 0.f; p1[r] = x[r] + (tt == s ? 1.f : 0.f); bm[r] = tt > s ? aB[i][r] : 0.f; pb[r] = tt >= s ? aPb[i][r] : 0.f; pk[r] = tt >= s ? aPk[i][r] : 0.f; }
            P[i] = p1;
            st_rm(XR0, RW_LD, 16 * tr, 16 * (tc0 + i), x, fr, fq); st_tr(XT0, RW_LD, 16 * tr, 16 * (tc0 + i), x, fr, fq);
            st_rm(PR0, RW_LD, 16 * tr, 16 * (tc0 + i), p1, fr, fq);
            st_rm(BM, RW_LD, 16 * tr, 16 * (tc0 + i), bm, fr, fq); st_rm(PB, RW_LD, 16 * tr, 16 * (tc0 + i), pb, fr, fq); st_rm(PK, RW_LD, 16 * tr, 16 * (tc0 + i), pk, fr, fq); }
    }
    __syncthreads();
#pragma unroll
    for (int st = 1; st <= 6; ++st) {
        const lptr XRc = (st & 1) ? XR0 : XR1, XTc = (st & 1) ? XT0 : XT1, XRn = (st & 1) ? XR1 : XR0, XTn = (st & 1) ? XT1 : XT0;
        const lptr PRc = (st & 1) ? PR1 : PR0, PRn = (st & 1) ? PR0 : PR1;
        f32x4 xn[2];
#pragma unroll
        for (int i = 0; i < 2; ++i) {
            if (st < 6) { xn[i] = (f32x4){0.f, 0.f, 0.f, 0.f}; mma16<64>(xn[i], XRc + 16 * tr * RW_LD, RW_LD, XTc + 16 * (tc0 + i) * RW_LD, RW_LD, fr, fq); }
            if (st > 1) mma16<64>(P[i], PRc + 16 * tr * RW_LD, RW_LD, XTc + 16 * (tc0 + i) * RW_LD, RW_LD, fr, fq);
        }
#pragma unroll
        for (int i = 0; i < 2; ++i) {
            if (st < 6) { st_rm(XRn, RW_LD, 16 * tr, 16 * (tc0 + i), xn[i], fr, fq); st_tr(XTn, RW_LD, 16 * tr, 16 * (tc0 + i), xn[i], fr, fq); }
            if (st > 1) st_rm(PRn, RW_LD, 16 * tr, 16 * (tc0 + i), P[i], fr, fq);
        }
        __syncthreads();
    }
    const lptr TR = PR1, WT = rw_slot(L, 11), BVT = rw_slot(L, 12), UVT = rw_slot(L, 0), MS = rw_slot(L, 2), QS = rw_slot(L, 4);
    {
#pragma unroll
        for (int i = 0; i < 2; ++i) { f32x4 aw = (f32x4){0.f, 0.f, 0.f, 0.f}, ab = aw;
            mma16<64>(aw, TR + 16 * tr * RW_LD, RW_LD, KGT + 16 * (tc0 + i) * RW_LD, RW_LD, fr, fq);
            mma16<64>(ab, BM + 16 * tr * RW_LD, RW_LD, VT + 16 * (tc0 + i) * RW_LD, RW_LD, fr, fq);
            st_tr(WT, RW_LD, 16 * tr, 16 * (tc0 + i), aw, fr, fq); st_tr(BVT, RW_LD, 16 * tr, 16 * (tc0 + i), ab, fr, fq); }
    }
    __syncthreads();
    {
#pragma unroll
        for (int i = 0; i < 2; ++i) { f32x4 au = (f32x4){0.f, 0.f, 0.f, 0.f};
            mma16<64>(au, TR + 16 * tr * RW_LD, RW_LD, BVT + 16 * (tc0 + i) * RW_LD, RW_LD, fr, fq);
            st_tr(UVT, RW_LD, 16 * tr, 16 * (tc0 + i), au, fr, fq); }
    }
    __syncthreads();
    unsigned char* item = F.RW_ITEM + (size_t)(c * 8 + h) * 32768;
    {
#pragma unroll
        for (int i = 0; i < 2; ++i) { const int cb = 16 * (tc0 + i);
            f32x4 am = (f32x4){0.f, 0.f, 0.f, 0.f};
            mma16<64>(am, WT + 16 * tr * RW_LD, RW_LD, BTT + cb * RW_LD, RW_LD, fr, fq);
            { const int j = cb + fr; const float gc = GAMC[j]; f32x4 mv;
#pragma unroll
                for (int r = 0; r < 4; ++r) { const int jp = 16 * tr + 4 * fq + r; mv[r] = (jp == j ? gc : 0.f) - am[r]; }
                st_tr(MS, RW_LD, 16 * tr, cb, mv, fr, fq); }
            f32x4 aq = (f32x4){0.f, 0.f, 0.f, 0.f};
            mma16<64>(aq, WT + 16 * tr * RW_LD, RW_LD, PB + cb * RW_LD, RW_LD, fr, fq);
            { const f32x4 rgv = unpack4(*(const LAS u32x2*)(RG + (cb + fr) * RW_LD + (16 * tr + 4 * fq) * 2)); const f32x4 qv = rgv - aq; st_tr(QS, RW_LD, 16 * tr, cb, qv, fr, fq); }
            f32x4 g1 = (f32x4){0.f, 0.f, 0.f, 0.f}, g2 = g1, y1 = g1, y2 = g1;
            mma16<64>(g1, KTT + 16 * tr * RW_LD, RW_LD, VT + cb * RW_LD, RW_LD, fr, fq);
            mma16<64>(g2, BTT + 16 * tr * RW_LD, RW_LD, UVT + cb * RW_LD, RW_LD, fr, fq);
            mma16<64>(y1, PK + 16 * tr * RW_LD, RW_LD, VT + cb * RW_LD, RW_LD, fr, fq);
            mma16<64>(y2, PB + 16 * tr * RW_LD, RW_LD, UVT + cb * RW_LD, RW_LD, fr, fq);
            *(u32x2*)(item + 16384 + ((w * 2 + i) * 64 + lane) * 8) = pack4(g1 - g2);
            *(u32x2*)(item + 24576 + ((w * 2 + i) * 64 + lane) * 8) = pack4(y1 - y2); }
    }
    __syncthreads();
    l2g_64x64((bf16*)item, MS, tid); l2g_64x64((bf16*)(item + 8192), QS, tid);
    if (h == 0 && c >= 255) { float* dst = c == 255 ? F.shift_p : F.shift_s + (size_t)(c - 256) * RWKV_PROJ; const bf16* src = F.PROJ + (size_t)(c * 64 + 63) * N_AB + RW_OFF;
        for (int col = tid; col < RWKV_PROJ; col += 512) dst[col] = bf2f(src[col]); }
    __syncthreads();
}

DI void rw_ld_frag_bf16(const unsigned char* p, int w, int lane, f32x4* a) { a[0] = unpack4(*(const u32x2*)(p + ((w * 2) * 64 + lane) * 8)); a[1] = unpack4(*(const u32x2*)(p + ((w * 2 + 1) * 64 + lane) * 8)); }

DI void rwkv_l1_item(const Ctx& F, int g, int h) {
    const int tid = F.tid, lane = F.lane, w = F.wave, fr = lane & 15, fq = lane >> 4, tr = w >> 1, tc0 = 2 * (w & 1);
    const lptr L = F.lds, MA = rw_slot(L, 0), MHT = rw_slot(L, 1), GHT = rw_slot(L, 2), OS = rw_slot(L, 3);
    const int c0 = g * 16;
    f32x4 am[2], ag[2];
    { const unsigned char* item = F.RW_ITEM + (size_t)(c0 * 8 + h) * 32768; const bf16* M = (const bf16*)item;
#pragma unroll
        for (int i = 0; i < 2; ++i)
#pragma unroll
            for (int r = 0; r < 4; ++r) am[i][r] = bf2f(M[(16 * tr + 4 * fq + r) * 64 + 16 * (tc0 + i) + fr]);
        rw_ld_frag_bf16(item + 16384, w, lane, ag); }
    for (int c = c0 + 1; c < c0 + 16; ++c) {
        const unsigned char* item = F.RW_ITEM + (size_t)(c * 8 + h) * 32768;
        g2l_64x64(MA, (const bf16*)item, tid);
#pragma unroll
        for (int i = 0; i < 2; ++i) { st_tr(MHT, RW_LD, 16 * tr, 16 * (tc0 + i), am[i], fr, fq); st_tr(GHT, RW_LD, 16 * tr, 16 * (tc0 + i), ag[i], fr, fq); }
        f32x4 gc[2]; rw_ld_frag_bf16(item + 16384, w, lane, gc);
        __syncthreads();
#pragma unroll
        for (int i = 0; i < 2; ++i) { am[i] = (f32x4){0.f, 0.f, 0.f, 0.f}; ag[i] = gc[i];
            mma16<64>(am[i], MA + 16 * tr * RW_LD, RW_LD, MHT + 16 * (tc0 + i) * RW_LD, RW_LD, fr, fq);
            mma16<64>(ag[i], MA + 16 * tr * RW_LD, RW_LD, GHT + 16 * (tc0 + i) * RW_LD, RW_LD, fr, fq); }
        __syncthreads();
    }
    unsigned char* comp = F.RW_COMP + (size_t)(h * 16 + g) * 24576;
#pragma unroll
    for (int i = 0; i < 2; ++i) { st_rm(OS, RW_LD, 16 * tr, 16 * (tc0 + i), am[i], fr, fq); *(f32x4*)(comp + 8192 + ((w * 2 + i) * 64 + lane) * 16) = ag[i]; }
    __syncthreads();
    l2g_64x64((bf16*)comp, OS, tid);
    __syncthreads();
}
DI void rwkv_l2_item(const Ctx& F, int h) {
    const int tid = F.tid, lane = F.lane, w = F.wave, fr = lane & 15, fq = lane >> 4, tr = w >> 1, tc0 = 2 * (w & 1);
    const lptr L = F.lds, MA = rw_slot(L, 0), EHT = rw_slot(L, 1);
    f32x4 e[2]; e[0] = (f32x4){0.f, 0.f, 0.f, 0.f}; e[1] = e[0];
    for (int g = 0; g < 16; ++g) {
        float* ent = F.RW_ENT + (size_t)(h * 16 + g) * 4096;
#pragma unroll
        for (int i = 0; i < 2; ++i) *(f32x4*)(ent + ((w * 2 + i) * 64 + lane) * 4) = e[i];
        if (g == 15) break;
        const unsigned char* comp = F.RW_COMP + (size_t)(h * 16 + g) * 24576;
        g2l_64x64(MA, (const bf16*)comp, tid);
#pragma unroll
        for (int i = 0; i < 2; ++i) st_tr(EHT, RW_LD, 16 * tr, 16 * (tc0 + i), e[i], fr, fq);
        f32x4 gh[2];
#pragma unroll
        for (int i = 0; i < 2; ++i) gh[i] = *(const f32x4*)(comp + 8192 + ((w * 2 + i) * 64 + lane) * 16);
        __syncthreads();
#pragma unroll
        for (int i = 0; i < 2; ++i) { e[i] = gh[i]; mma16<64>(e[i], MA + 16 * tr * RW_LD, RW_LD, EHT + 16 * (tc0 + i) * RW_LD, RW_LD, fr, fq); }
        __syncthreads();
    }
}
DI void rwkv_l3_item(const Ctx& F, int kind, int g, int h) {
    const int tid = F.tid, lane = F.lane, w = F.wave, fr = lane & 15, fq = lane >> 4, tr = w >> 1, tc0 = 2 * (w & 1);
    const lptr L = F.lds, MA = rw_slot(L, 0), SHT = rw_slot(L, 1);
    f32x4 s[2];
    int c0, nc;
    if (kind == 0) { c0 = g * 16; nc = 16; const float* ent = F.RW_ENT + (size_t)(h * 16 + g) * 4096;
#pragma unroll
        for (int i = 0; i < 2; ++i) s[i] = *(const f32x4*)(ent + ((w * 2 + i) * 64 + lane) * 4); }
    else { c0 = 256 + g; nc = 1; const float* S = F.state_wkv + (size_t)(g * 8 + h) * 4096;
#pragma unroll
        for (int i = 0; i < 2; ++i) s[i] = *(const f32x4*)(S + (16 * (tc0 + i) + fr) * 64 + 16 * tr + 4 * fq); }
    for (int c = c0; c < c0 + nc; ++c) {
        const unsigned char* item = F.RW_ITEM + (size_t)(c * 8 + h) * 32768;
        bf16* stg = F.RW_STATE + (size_t)(c * 8 + h) * 4096;
        g2l_64x64(MA, (const bf16*)item, tid);
#pragma unroll
        for (int i = 0; i < 2; ++i) { st_tr(SHT, RW_LD, 16 * tr, 16 * (tc0 + i), s[i], fr, fq);
            *(u32x2*)(stg + (16 * (tc0 + i) + fr) * 64 + 16 * tr + 4 * fq) = pack4(s[i]); }
        f32x4 gc[2]; rw_ld_frag_bf16(item + 16384, w, lane, gc);
        __syncthreads();
#pragma unroll
        for (int i = 0; i < 2; ++i) { s[i] = gc[i]; mma16<64>(s[i], MA + 16 * tr * RW_LD, RW_LD, SHT + 16 * (tc0 + i) * RW_LD, RW_LD, fr, fq); }
        __syncthreads();
    }
    if (kind == 1 || g == 15) { float* out = kind == 1 ? F.wkv_s + (size_t)(g * 8 + h) * 4096 : F.wkv_p + (size_t)h * 4096;
#pragma unroll
        for (int i = 0; i < 2; ++i) *(f32x4*)(out + (16 * (tc0 + i) + fr) * 64 + 16 * tr + 4 * fq) = s[i]; }
}
DI void rwkv_p3_item(const Ctx& F, int c, int h) {
    const int tid = F.tid, lane = F.lane, w = F.wave, fr = lane & 15, fq = lane >> 4, tr = w >> 1, tc0 = 2 * (w & 1);
    const lptr L = F.lds, QA = rw_slot(L, 0), SB = rw_slot(L, 1), YS = rw_slot(L, 2);
    const unsigned char* item = F.RW_ITEM + (size_t)(c * 8 + h) * 32768;
    g2l_64x64(QA, (const bf16*)(item + 8192), tid);
    g2l_64x64(SB, F.RW_STATE + (size_t)(c * 8 + h) * 4096, tid);
    f32x4 y[2]; rw_ld_frag_bf16(item + 24576, w, lane, y);
    __syncthreads();
#pragma unroll
    for (int i = 0; i < 2; ++i) { mma16<64>(y[i], QA + 16 * tr * RW_LD, RW_LD, SB + 16 * (tc0 + i) * RW_LD, RW_LD, fr, fq);
#pragma unroll
        for (int r = 0; r < 4; ++r) *(LAS float*)(YS + (16 * tr + 4 * fq + r) * RW_LDF + (16 * (tc0 + i) + fr) * 4) = y[i][r]; }
    __syncthreads();
    {
        const int t = tid >> 3, s8 = tid & 7, i0 = 8 * s8, hi0 = h * 64 + i0;
        float yv[8], s = 0.f;
#pragma unroll
        for (int e = 0; e < 8; ++e) { yv[e] = *(LAS float*)(YS + t * RW_LDF + (i0 + e) * 4); s += yv[e]; }
        s += __shfl_xor(s, 1); s += __shfl_xor(s, 2); s += __shfl_xor(s, 4);
        const float mean = s * (1.0f / 64.0f); float q = 0.f;
#pragma unroll
        for (int e = 0; e < 8; ++e) { yv[e] -= mean; q += yv[e] * yv[e]; }
        q += __shfl_xor(q, 1); q += __shfl_xor(q, 2); q += __shfl_xor(q, 4);
        const float rstd = 1.0f / sqrtf(q * (1.0f / 64.0f) + RWKV_LN_EPS);
        float xv[8], lg_[8], lb_[8], gt[8], o[8];
        rw_shift(F, c, t, 1024 + hi0, xv);
        ld8f(F.rwkv_ln_g + hi0, lg_); ld8f(F.rwkv_ln_b + hi0, lb_);
        bf16* mp = F.MIX + (size_t)(c * 64 + t) * 1024 + 512 + hi0;
        ld8bf(mp, gt);
        const float rk = F.RW_RK[(size_t)(c * 8 + h) * 64 + t];
#pragma unroll
        for (int e = 0; e < 8; ++e) o[e] = (yv[e] * rstd * lg_[e] + lb_[e] + rk * xv[e]) * gt[e];
        *(v4u*)mp = pack8(o);
    }
    __syncthreads();
}
constexpr int RT_G = 4, RT_NG = 256 / RT_G;
constexpr int RT_LDQ = 272;
constexpr int RT_LDT = 144;
constexpr int RT_LDR = 272;
constexpr int RT_OFF_Q = 0, RT_OFF_K = 17408, RT_OFF_KT = 34816, RT_OFF_VT = 53248, RT_OFF_RT = 71680, RT_OFF_P = 106496, RT_OFF_OS = 0;
DI float ret_lg(int h) { return log1pf(-exp2f(-5.0f - (float)h)); }
DI int crow32(int reg, int hh) { return (reg & 3) + 8 * (reg >> 2) + 4 * hh; }
template <int KS> DI void mma32(f32x16& acc, lptr A, int lda, lptr Bt, int ldb, int r32, int hh) {
#pragma unroll
    for (int s = 0; s < KS; ++s) {
        const bf16x8 a = *(const LAS bf16x8*)(A + r32 * lda + (16 * s + 8 * hh) * 2);
        const bf16x8 b = *(const LAS bf16x8*)(Bt + r32 * ldb + (16 * s + 8 * hh) * 2);
        acc = __builtin_amdgcn_mfma_f32_32x32x16_bf16(a, b, acc, 0, 0, 0);
    }
}
DI void rope_cs(double inv, int pos, float& cs, float& sn) {
    const double a = (double)pos * inv; const double k = rint(a * 0.15915494309189535); const float r = (float)(a - k * 6.283185307179586);
    cs = __cosf(r); sn = __sinf(r);
}
DI void ret_stage(const Ctx& F, int c, int h, bool need_qk) {
    const int tid = F.tid, t = tid >> 3, s8 = tid & 7; const lptr L = F.lds;
    const int pos = (c < 256 ? c * 64 : PAST_POS) + t;
    const bf16* row = F.PROJ + (size_t)(c * 64 + t) * N_AB;
    const float lg = ret_lg(h), qd = __expf(lg * (float)(t + 1)), kd = __expf(lg * (float)(63 - t));
    float cs[8], sn[8];
#pragma unroll
    for (int e = 0; e < 8; ++e) rope_cs(F.ROPE[8 * s8 + e], pos, cs[e], sn[e]);
    float x1[8], x2[8], o1[8], o2[8];
    ld8bf(row + 512 + h * 128 + 8 * s8, x1); ld8bf(row + 512 + h * 128 + 64 + 8 * s8, x2);
#pragma unroll
    for (int e = 0; e < 8; ++e) { o1[e] = (x1[e] * cs[e] - x2[e] * sn[e]) * 0.08838834764831845f; o2[e] = (x1[e] * sn[e] + x2[e] * cs[e]) * 0.08838834764831845f; }
    if (need_qk) { *(LAS v4u*)(L + RT_OFF_K + t * RT_LDQ + s8 * 16) = pack8(o1); *(LAS v4u*)(L + RT_OFF_K + t * RT_LDQ + 128 + s8 * 16) = pack8(o2); }
#pragma unroll
    for (int e = 0; e < 8; ++e) { *(LAS bf16*)(L + RT_OFF_KT + (8 * s8 + e) * RT_LDT + t * 2) = (bf16)f2bf(o1[e] * kd); *(LAS bf16*)(L + RT_OFF_KT + (64 + 8 * s8 + e) * RT_LDT + t * 2) = (bf16)f2bf(o2[e] * kd); }
    if (need_qk) {
        ld8bf(row + h * 128 + 8 * s8, x1); ld8bf(row + h * 128 + 64 + 8 * s8, x2);
#pragma unroll
        for (int e = 0; e < 8; ++e) { o1[e] = (x1[e] * cs[e] - x2[e] * sn[e]) * qd; o2[e] = (x1[e] * sn[e] + x2[e] * cs[e]) * qd; }
        *(LAS v4u*)(L + RT_OFF_Q + t * RT_LDQ + s8 * 16) = pack8(o1); *(LAS v4u*)(L + RT_OFF_Q + t * RT_LDQ + 128 + s8 * 16) = pack8(o2);
    }
    ld8bf(row + 1024 + h * 128 + 8 * s8, x1); ld8bf(row + 1024 + h * 128 + 64 + 8 * s8, x2);
#pragma unroll
    for (int e = 0; e < 8; ++e) { *(LAS bf16*)(L + RT_OFF_VT + (8 * s8 + e) * RT_LDT + t * 2) = (bf16)f2bf(x1[e]); *(LAS bf16*)(L + RT_OFF_VT + (64 + 8 * s8 + e) * RT_LDT + t * 2) = (bf16)f2bf(x2[e]); }
}
DI void ret_kv_update(lptr L, f32x16* r, float cdec, int w, int r32, int hh) {
#pragma unroll
    for (int i = 0; i < 2; ++i) { r[i] = r[i] * cdec; mma32<4>(r[i], L + RT_OFF_KT + 32 * (w >> 1) * RT_LDT, RT_LDT, L + RT_OFF_VT + 32 * (2 * (w & 1) + i) * RT_LDT, RT_LDT, r32, hh); }
}
DI void ret_ld_state(const float* S, f32x16* r, int w, int r32, int hh) {
#pragma unroll
    for (int i = 0; i < 2; ++i)
#pragma unroll
        for (int g = 0; g < 16; ++g) r[i][g] = S[(32 * (w >> 1) + crow32(g, hh)) * 128 + 32 * (2 * (w & 1) + i) + r32];
}
DI void ret_st_state(float* S, const f32x16* r, int w, int r32, int hh) {
#pragma unroll
    for (int i = 0; i < 2; ++i)
#pragma unroll
        for (int g = 0; g < 16; ++g) S[(32 * (w >> 1) + crow32(g, hh)) * 128 + 32 * (2 * (w & 1) + i) + r32] = r[i][g];
}
DI void ret_p1_item(const Ctx& F, int kind, int gi, int h) {
    const int lane = F.lane, w = F.wave, r32 = lane & 31, hh = lane >> 5;
    const float cdec = __expf(ret_lg(h) * 64.0f);
    f32x16 r[2];
    int c0, nc;
    if (kind == 0) { c0 = gi * RT_G; nc = RT_G;
#pragma unroll
        for (int i = 0; i < 2; ++i)
#pragma unroll
            for (int g = 0; g < 16; ++g) r[i][g] = 0.f; }
    else { c0 = 256 + gi; nc = 1; ret_ld_state(F.state_ret + (size_t)(gi * 4 + h) * 16384, r, w, r32, hh); }
    for (int c = c0; c < c0 + nc; ++c) {
        ret_stage(F, c, h, false);
        __syncthreads();
        ret_kv_update(F.lds, r, cdec, w, r32, hh);
        __syncthreads();
    }
    ret_st_state(kind == 0 ? F.RET_G + (size_t)(gi * 4 + h) * 16384 : F.ret_s + (size_t)(gi * 4 + h) * 16384, r, w, r32, hh);
}
DI void ret_scan(const Ctx& F, int vidx) {
    const int n = 4 * 16384;
    for (int e = vidx * 512 + F.tid; e < n; e += F.G * 512) {
        const int h = e >> 14; const float c4 = __expf(ret_lg(h) * 64.0f * (float)RT_G);
        float acc = 0.f;
#pragma unroll 4
        for (int g = 0; g < RT_NG; ++g) { float* p = F.RET_G + (size_t)g * 65536 + e; acc = acc * c4 + *p; *p = acc; }
        F.ret_p[e] = acc;
    }
}
DI void ret_p3_item(const Ctx& F, int kind, int gi, int h) {
    const int tid = F.tid, lane = F.lane, w = F.wave, r32 = lane & 31, hh = lane >> 5; const lptr L = F.lds;
    const float lg = ret_lg(h), cdec = __expf(lg * 64.0f);
    f32x16 r[2];
    int c0, nc;
    if (kind == 0) { c0 = gi * RT_G; nc = RT_G;
        if (gi == 0) {
#pragma unroll
            for (int i = 0; i < 2; ++i)
#pragma unroll
                for (int g = 0; g < 16; ++g) r[i][g] = 0.f; }
        else ret_ld_state(F.RET_G + (size_t)((gi - 1) * 4 + h) * 16384, r, w, r32, hh); }
    else { c0 = 256 + gi; nc = 1; ret_ld_state(F.state_ret + (size_t)(gi * 4 + h) * 16384, r, w, r32, hh); }
    for (int c = c0; c < c0 + nc; ++c) {
        ret_stage(F, c, h, true);
#pragma unroll
        for (int i = 0; i < 2; ++i)
#pragma unroll
            for (int g4 = 0; g4 < 4; ++g4) { u32x2 v; v.x = pk2(r[i][4 * g4], r[i][4 * g4 + 1]); v.y = pk2(r[i][4 * g4 + 2], r[i][4 * g4 + 3]);
                *(LAS u32x2*)(L + RT_OFF_RT + (32 * (2 * (w & 1) + i) + r32) * RT_LDR + (32 * (w >> 1) + 8 * g4 + 4 * hh) * 2) = v; }
        __syncthreads();
        if (w < 4) { const int tb = w & 1, kb = w >> 1;
            f32x16 s;
#pragma unroll
            for (int g = 0; g < 16; ++g) s[g] = 0.f;
            if (kb <= tb) mma32<8>(s, L + RT_OFF_Q + 32 * tb * RT_LDQ, RT_LDQ, L + RT_OFF_K + 32 * kb * RT_LDQ, RT_LDQ, r32, hh);
            const int tp = 32 * kb + r32; const float f = __expf(-lg * (float)(tp + 1));
#pragma unroll
            for (int g = 0; g < 16; ++g) { const int tq = 32 * tb + crow32(g, hh); const float pv = tq >= tp ? s[g] * f : 0.f;
                *(LAS bf16*)(L + RT_OFF_P + tq * 144 + tp * 2) = (bf16)f2bf(pv); } }
        __syncthreads();
        const int tb = w & 1, db = w >> 1;
        f32x16 o;
#pragma unroll
        for (int g = 0; g < 16; ++g) o[g] = 0.f;
        mma32<4>(o, L + RT_OFF_P + 32 * tb * 144, 144, L + RT_OFF_VT + 32 * db * RT_LDT, RT_LDT, r32, hh);
        mma32<8>(o, L + RT_OFF_Q + 32 * tb * RT_LDQ, RT_LDQ, L + RT_OFF_RT + 32 * db * RT_LDR, RT_LDR, r32, hh);
        ret_kv_update(L, r, cdec, w, r32, hh);
        __syncthreads();
#pragma unroll
        for (int g = 0; g < 16; ++g) *(LAS float*)(L + RT_OFF_OS + (32 * tb + crow32(g, hh)) * 528 + (32 * db + r32) * 4) = o[g];
        __syncthreads();
        {
            const int t = tid >> 3, s8 = tid & 7;
            float v[16], s = 0.f;
#pragma unroll
            for (int e = 0; e < 16; ++e) { v[e] = *(LAS float*)(L + RT_OFF_OS + t * 528 + (16 * s8 + e) * 4); s += v[e]; }
            s += __shfl_xor(s, 1); s += __shfl_xor(s, 2); s += __shfl_xor(s, 4);
            const float mean = s * (1.0f / 128.0f); float q = 0.f;
#pragma unroll
            for (int e = 0; e < 16; ++e) { v[e] -= mean; q += v[e] * v[e]; }
            q += __shfl_xor(q, 1); q += __shfl_xor(q, 2); q += __shfl_xor(q, 4);
            const float rstd = 1.0f / sqrtf(q * (1.0f / 128.0f) + LN_EPS);
            const bf16* gp = F.PROJ + (size_t)(c * 64 + t) * N_AB + 1536 + h * 128 + 16 * s8;
            bf16* op = F.MIX + (size_t)(c * 64 + t) * 1024 + h * 128 + 16 * s8;
#pragma unroll
            for (int q2 = 0; q2 < 2; ++q2) { float gt[8], gn[8], o8[8]; ld8bf(gp + 8 * q2, gt); ld8f(F.ret_gn_g + h * 128 + 16 * s8 + 8 * q2, gn);
#pragma unroll
                for (int e = 0; e < 8; ++e) o8[e] = gt[e] / (1.0f + __expf(-gt[e])) * (v[8 * q2 + e] * rstd * gn[e]);
                *(v4u*)(op + 8 * q2) = pack8(o8); }
        }
        __syncthreads();
    }
}
constexpr int CV_OFF_U = 0, CV_OFF_Y = 63488;
DI void conv_item(const Ctx& F, int it) {
    const int tid = F.tid; const lptr L = F.lds;
    const int c = it >> 1, half = it & 1;
    const int seq_t0 = c < 256 ? 0 : c * 64;
    const int ta = c * 64 + 32 * half;
    const int b = c - 256;
    for (int q = tid; q < 62 * 64; q += 512) { const int rr = q >> 6, cg = q & 63, row = ta - 30 + rr;
        float u[8];
        if (row >= seq_t0) { float a[8], g[8]; const bf16* p = F.PROJ + (size_t)row * N_CD + 8 * cg; ld8bf(p, a); ld8bf(p + 512, g);
#pragma unroll
            for (int e = 0; e < 8; ++e) u[e] = a[e] * sigmoidf_(g[e]); }
        else if (c >= 256) ld8f(F.state_conv + ((size_t)b * 30 + (30 + row - seq_t0)) * 512 + 8 * cg, u);
        else {
#pragma unroll
            for (int e = 0; e < 8; ++e) u[e] = 0.f; }
        *(LAS v4u*)(L + CV_OFF_U + rr * 1024 + cg * 16) = pack8(u);
        const int seq_last = c < 256 ? TP - 1 : c * 64 + 63;
        if (row > seq_last - 30 && row >= seq_t0 && ((c == 255 && half == 1) || (c >= 256 && half == 1))) {
            float* dst = (c < 256 ? F.conv_p : F.conv_s + (size_t)b * 30 * 512) + (size_t)(row - (seq_last - 29)) * 512 + 8 * cg; st8f(dst, u); }
    }
    __syncthreads();
    {
        const int ch = tid; float wgt[31];
#pragma unroll
        for (int k = 0; k < 31; ++k) wgt[k] = F.conv_w[k * 512 + ch];
        const float bias = F.conv_b[ch];
        float uv[62];
#pragma unroll
        for (int r = 0; r < 62; ++r) uv[r] = bf2f(*(LAS bf16*)(L + CV_OFF_U + r * 1024 + ch * 2));
#pragma unroll
        for (int t = 0; t < 32; ++t) { float acc = bias;
#pragma unroll
            for (int k = 0; k < 31; ++k) acc += wgt[k] * uv[t + k];
            *(LAS float*)(L + CV_OFF_Y + t * 2048 + ch * 4) = acc; }
    }
    __syncthreads();
    {
        const int t = tid >> 4, sub = tid & 15; f32x4 v[8]; float s = 0.f;
#pragma unroll
        for (int k = 0; k < 8; ++k) { v[k] = *(LAS f32x4*)(L + CV_OFF_Y + t * 2048 + (64 * k + 4 * sub) * 4); s += (v[k][0] + v[k][1]) + (v[k][2] + v[k][3]); }
        s += __shfl_xor(s, 1); s += __shfl_xor(s, 2); s += __shfl_xor(s, 4); s += __shfl_xor(s, 8);
        const float mean = s * (1.0f / 512.0f); float q = 0.f;
#pragma unroll
        for (int k = 0; k < 8; ++k) { v[k] = v[k] - mean; q += (v[k][0] * v[k][0] + v[k][1] * v[k][1]) + (v[k][2] * v[k][2] + v[k][3] * v[k][3]); }
        q += __shfl_xor(q, 1); q += __shfl_xor(q, 2); q += __shfl_xor(q, 4); q += __shfl_xor(q, 8);
        const float rstd = 1.0f / sqrtf(q * (1.0f / 512.0f) + LN_EPS);
        bf16* op = F.MIX + (size_t)(ta + t) * 1024;
#pragma unroll
        for (int k = 0; k < 8; ++k) { const int ch = 64 * k + 4 * sub; const f32x4 g = *(const f32x4*)(F.conv_ln_g + ch), bb = *(const f32x4*)(F.conv_ln_b + ch);
            f32x4 o;
#pragma unroll
            for (int e = 0; e < 4; ++e) { const float z = v[k][e] * rstd * g[e] + bb[e]; o[e] = z / (1.0f + __expf(-z)); }
            *(u32x2*)(op + ch) = pack4(o); }
    }
    __syncthreads();
}

constexpr int AT_OFF_K = 0, AT_OFF_VT = 27648, AT_LDK = 144, AT_LDV = 400;
DI void attn_item(const Ctx& F, int c, int kh) {
    const int tid = F.tid, lane = F.lane, w = F.wave, r32 = lane & 31, hh = lane >> 5; const lptr L = F.lds;
    const int b = c - 256;
    const int row0 = c * 64 - 128;
    const int kvalid0 = c >= 256 ? 0 : (c == 0 ? 128 : (c == 1 ? 64 : 0));
    const bool last = (c == 255) || (c >= 256);
    for (int q = tid; q < 192 * 8; q += 512) { const int key = q >> 3, s8 = q & 7;
        float kx[8], vx[8];
        if (c >= 256 && key < 128) { ld8f(F.cache_k + (((size_t)b * 128 + key) * 2 + kh) * 64 + 8 * s8, kx); ld8f(F.cache_v + (((size_t)b * 128 + key) * 2 + kh) * 64 + 8 * s8, vx); }
        else if (key < kvalid0) {
#pragma unroll
            for (int e = 0; e < 8; ++e) { kx[e] = 0.f; vx[e] = 0.f; } }
        else { const int row = c >= 256 ? c * 64 + (key - 128) : row0 + key; const bf16* p = F.PROJ + (size_t)row * N_CD;
            ld8bf(p + 1536 + kh * 64 + 8 * s8, kx); ld8bf(p + 1664 + kh * 64 + 8 * s8, vx);
            if (s8 < 2) {
                float px[8]; ld8bf(p + 1536 + kh * 64 + 8 * (s8 ^ 1), px);
                const int pos = c >= 256 ? PAST_POS + (key - 128) : row;
#pragma unroll
                for (int e = 0; e < 8; ++e) { float cs, sn; rope_cs(F.ROPE[64 + e], pos, cs, sn); kx[e] = s8 == 0 ? kx[e] * cs - px[e] * sn : px[e] * sn + kx[e] * cs; }
            } }
        *(LAS v4u*)(L + AT_OFF_K + key * AT_LDK + s8 * 16) = pack8(kx);
#pragma unroll
        for (int e = 0; e < 8; ++e) *(LAS bf16*)(L + AT_OFF_VT + (8 * s8 + e) * AT_LDV + key * 2) = (bf16)f2bf(vx[e]);
        if (last && key >= 64) { float* kd = (c == 255 ? F.k_p : F.k_s + (size_t)b * 16384) + ((size_t)(key - 64) * 2 + kh) * 64 + 8 * s8;
            float* vd = (c == 255 ? F.v_p : F.v_s + (size_t)b * 16384) + ((size_t)(key - 64) * 2 + kh) * 64 + 8 * s8; st8f(kd, kx); st8f(vd, vx); }
    }
    const int hq = 4 * kh + (w >> 1), qrow = c * 64 + 32 * (w & 1) + r32, qpos = (c >= 256 ? PAST_POS + 32 * (w & 1) + r32 : qrow);
    bf16x8 qf[4];
    { const bf16* qp = F.PROJ + (size_t)qrow * N_CD + 1024 + hq * 64;
#pragma unroll
        for (int s = 0; s < 4; ++s) { float x[8]; ld8bf(qp + 16 * s + 8 * hh, x);
            if (s == 0) { float px[8]; ld8bf(qp + 8 * (hh ^ 1), px);
#pragma unroll
                for (int e = 0; e < 8; ++e) { float cs, sn; rope_cs(F.ROPE[64 + e], qpos, cs, sn); x[e] = hh == 0 ? x[e] * cs - px[e] * sn : px[e] * sn + x[e] * cs; } }
            const v4u pk = pack8(x); qf[s] = __builtin_bit_cast(bf16x8, pk); } }
    __syncthreads();
    f32x16 x[6];
#pragma unroll
    for (int kb = 0; kb < 6; ++kb) {
#pragma unroll
        for (int g = 0; g < 16; ++g) x[kb][g] = 0.f;
#pragma unroll
        for (int s = 0; s < 4; ++s) { const bf16x8 a = *(const LAS bf16x8*)(L + AT_OFF_K + (32 * kb + r32) * AT_LDK + (16 * s + 8 * hh) * 2);
            x[kb] = __builtin_amdgcn_mfma_f32_32x32x16_bf16(a, qf[s], x[kb], 0, 0, 0); } }
    const float sink = F.attn_sink[hq];
    float m = sink;
#pragma unroll
    for (int kb = 0; kb < 6; ++kb)
#pragma unroll
        for (int g = 0; g < 16; ++g) { const int key = 32 * kb + crow32(g, hh); float sv = x[kb][g] * 0.125f; if (key < kvalid0) sv = -1e30f; x[kb][g] = sv; m = fmaxf(m, sv); }
    m = fmaxf(m, __shfl_xor(m, 32));
    float den = 0.f;
#pragma unroll
    for (int kb = 0; kb < 6; ++kb)
#pragma unroll
        for (int g = 0; g < 16; ++g) { const float e = __expf(x[kb][g] - m); x[kb][g] = e; den += e; }
    den += __shfl_xor(den, 32);
    den += __expf(sink - m);
    const float rden = 1.0f / den;
#pragma unroll
    for (int kb = 0; kb < 6; ++kb)
#pragma unroll
        for (int g = 0; g < 16; ++g) x[kb][g] *= rden;
    bf16* op = F.MIX + (size_t)(c * 64 + 32 * (w & 1)) * 1024 + 512 + hq * 64;
#pragma unroll
    for (int db = 0; db < 2; ++db) {
        f32x16 o;
#pragma unroll
        for (int g = 0; g < 16; ++g) o[g] = 0.f;
#pragma unroll
        for (int kb = 0; kb < 6; ++kb)
#pragma unroll
            for (int s = 0; s < 2; ++s) {
                float pv[8];
#pragma unroll
                for (int j = 0; j < 8; ++j) pv[j] = x[kb][8 * s + j];
                const v4u pk = pack8(pv); const bf16x8 pa = __builtin_bit_cast(bf16x8, pk);
                const lptr vp = L + AT_OFF_VT + (32 * db + r32) * AT_LDV + (32 * kb + 16 * s + 4 * hh) * 2;
                const u32x2 lo = *(const LAS u32x2*)vp, hi = *(const LAS u32x2*)(vp + 16);
                v4u bv; bv.x = lo.x; bv.y = lo.y; bv.z = hi.x; bv.w = hi.y;
                o = __builtin_amdgcn_mfma_f32_32x32x16_bf16(pa, __builtin_bit_cast(bf16x8, bv), o, 0, 0, 0); }
#pragma unroll
        for (int g = 0; g < 16; ++g) op[(size_t)crow32(g, hh) * 1024 + 32 * db + r32] = (bf16)f2bf(o[g]);
    }
    __syncthreads();
}
constexpr size_t MiB = 1u << 20;
constexpr size_t WS_CTL = 0, CTL_ZERO_BYTES = 64 * 1024;
constexpr size_t WS_ROPE = 1 * MiB, WS_SS = 2 * MiB;
constexpr size_t WS_W_INAB = 4 * MiB, WS_W_OUTAB = WS_W_INAB + (size_t)N_AB * 1024 * 2, WS_W_INCD = WS_W_OUTAB + 2 * MiB, WS_W_OUTCD = WS_W_INCD + (size_t)N_CD * 1024 * 2,
                 WS_W_GU = WS_W_OUTCD + 2 * MiB, WS_W_DN = WS_W_GU + 2 * (size_t)N_GU * 1024 * 2, WS_W_END = WS_W_DN + 2 * (size_t)D_FF * 1024 * 2;
constexpr size_t WS_XB = 52 * MiB, WS_MIX = 86 * MiB, WS_PROJ = 120 * MiB, WS_PROJ_END = WS_PROJ + (size_t)T_ALL * N_AB * 2;
constexpr size_t WS_COMP = WS_PROJ_END, WS_ENT = WS_COMP + 3 * MiB, WS_RK = WS_ENT + 2 * MiB, WS_END = WS_RK + 1 * MiB;
static_assert(WS_W_END <= WS_XB && WS_XB + (size_t)T_ALL * 1024 * 2 <= WS_MIX && WS_MIX + (size_t)T_ALL * 1024 * 2 <= WS_PROJ && WS_END <= 256 * MiB, "d_ws map");
static_assert((size_t)NCH * 8 * 4096 * 2 + (size_t)64 * 4 * 16384 * 4 <= (size_t)T_ALL * 1024 * 2, "rwkv states + retention group states fit the XB region");
static_assert(128 * 24576 <= 3 * MiB && 128 * 16384 <= 2 * MiB && NCH * 8 * 64 * 4 <= 1 * MiB, "scan scratch");
constexpr size_t O_Y = 0, O_RET_P = (size_t)T_ALL * 1024, O_WKV_P = O_RET_P + 65536, O_SHIFT_P = O_WKV_P + 32768, O_CONV_P = O_SHIFT_P + 1792, O_K_P = O_CONV_P + 15360, O_V_P = O_K_P + 16384,
                 O_RET_S = O_V_P + 16384, O_WKV_S = O_RET_S + 16 * 65536, O_SHIFT_S = O_WKV_S + 16 * 32768, O_CONV_S = O_SHIFT_S + 16 * 1792, O_K_S = O_CONV_S + 16 * 15360, O_V_S = O_K_S + 16 * 16384,
                 O_END = O_V_S + 16 * 16384;
static_assert(O_END == 20345600, "output size");
constexpr int RING_BYTES = 131072, MISC_OFF = RING_BYTES + 320, LDS_BYTES = 147456, NWAVES = 8;

DI float wave_sum(float v) {
#pragma unroll
    for (int o = 1; o < 64; o <<= 1) v += __shfl_xor(v, o);
    return v;
}
DI void p0_transpose_item(const float* W, int K, int N, bf16* WT, int k0, int n0, int dst_row0, const float* gk, LAS float* scr, int lane) {
#pragma unroll 8
    for (int i = 0; i < 32; ++i) { const int kk = 2 * i + (lane >> 5); float v = W[(size_t)(k0 + kk) * N + n0 + (lane & 31)]; if (gk) v *= gk[k0 + kk]; scr[kk * 33 + (lane & 31)] = v; }
    LDS_WAIT(); asm volatile("" ::: "memory");
    const int c = lane & 7;
#pragma unroll
    for (int j = 0; j < 4; ++j) { const int n = (lane >> 3) + 8 * j; const LAS float* s = scr + (8 * c) * 33 + n;
        v4u o; o.x = pk2(s[0 * 33], s[1 * 33]); o.y = pk2(s[2 * 33], s[3 * 33]); o.z = pk2(s[4 * 33], s[5 * 33]); o.w = pk2(s[6 * 33], s[7 * 33]);
        *(GAS v4u*)(WT + (size_t)(dst_row0 + n) * K + k0 + 8 * c) = o; }
    LDS_WAIT(); asm volatile("" ::: "memory");
}
DI void p0_prologue(const Ctx& F) {
    LAS float* scr = (LAS float*)(F.lds + F.wave * 16384);
    const int gw = F.vcu * NWAVES + F.wave, NGW = F.G * NWAVES, lane = F.lane;
    if (F.vcu == 0 && F.tid < 72) { const int j = F.tid < 64 ? F.tid : F.tid - 64;
        F.ROPE[F.tid] = F.tid < 64 ? exp((double)j * (-2.0 * log(10000.0) / 128.0)) : exp((double)j * (-2.0 * log(500000.0) / 16.0)); }
    constexpr int I_INAB = 16 * (N_AB / 32), I_SQ = 16 * 32, I_INCD = 16 * (N_CD / 32), I_GU = 16 * (D_FF / 32), I_DN = (D_FF / 64) * 32;
    constexpr int NITEMS = I_INAB + 2 * I_SQ + I_INCD + 4 * I_GU + 2 * I_DN;
    for (int it = gw; it < NITEMS; it += NGW) {
        int r = it;
        if (r < I_INAB) { const int nb = N_AB / 32; p0_transpose_item(F.w_in_ab, 1024, N_AB, F.W_INAB, 64 * (r / nb), 32 * (r % nb), 32 * (r % nb), F.norm_mix, scr, lane); continue; } r -= I_INAB;
        if (r < I_SQ) { p0_transpose_item(F.w_out_ab, 1024, 1024, F.W_OUTAB, 64 * (r / 32), 32 * (r % 32), 32 * (r % 32), nullptr, scr, lane); continue; } r -= I_SQ;
        if (r < I_INCD) { const int nb = N_CD / 32; p0_transpose_item(F.w_in_cd, 1024, N_CD, F.W_INCD, 64 * (r / nb), 32 * (r % nb), 32 * (r % nb), F.norm_mix + 1024, scr, lane); continue; } r -= I_INCD;
        if (r < I_SQ) { p0_transpose_item(F.w_out_cd, 1024, 1024, F.W_OUTCD, 64 * (r / 32), 32 * (r % 32), 32 * (r % 32), nullptr, scr, lane); continue; } r -= I_SQ;
        if (r < 4 * I_GU) { const int which = r / I_GU, l = which >> 1, up = which & 1, q = r % I_GU, nb = D_FF / 32, n0 = 32 * (q % nb);
            p0_transpose_item((up ? F.ffn_up : F.ffn_gate) + (size_t)l * 1024 * D_FF, 1024, D_FF, F.W_GU + (size_t)l * N_GU * 1024, 64 * (q / nb), n0, 256 * (n0 >> 7) + 128 * up + (n0 & 127), F.norm_ffn + l * 1024, scr, lane); continue; } r -= 4 * I_GU;
        { const int l = r / I_DN, q = r % I_DN; p0_transpose_item(F.ffn_down + (size_t)l * D_FF * 1024, D_FF, 1024, F.W_DN + (size_t)l * 1024 * D_FF, 64 * (q / 32), 32 * (q % 32), 32 * (q % 32), nullptr, scr, lane); }
    }
    for (int m = gw; m < T_ALL; m += NGW) {
        const float* xrow = m < TP ? F.x_prompt + (size_t)m * 1024 : F.x_sample + (size_t)(m - TP) * 1024;
        const GAS f32x4* xr = (const GAS f32x4*)xrow + lane; f32x4 v[4]; float s = 0.f;
#pragma unroll
        for (int j = 0; j < 4; ++j) { v[j] = xr[64 * j]; s += (v[j][0] * v[j][0] + v[j][1] * v[j][1]) + (v[j][2] * v[j][2] + v[j][3] * v[j][3]); }
        s = wave_sum(s);
        GAS unsigned long long* o8 = (GAS unsigned long long*)(F.XB + (size_t)m * 1024) + lane;
#pragma unroll
        for (int j = 0; j < 4; ++j) o8[64 * j] = (unsigned long long)pk2(v[j][0], v[j][1]) | ((unsigned long long)pk2(v[j][2], v[j][3]) << 32);
        if (lane < 16) F.SS[(size_t)m * 16 + lane] = lane == 0 ? s : 0.f;
    }
}
DI void final_norm(const Ctx& F) {
    const int gw = F.vcu * NWAVES + F.wave, NGW = F.G * NWAVES, lane = F.lane;
    for (int m = gw; m < T_ALL; m += NGW) {
        const float rs = pg8::row_rstd(F.SS, m);
        GAS f32x4* xr = (GAS f32x4*)(F.y + (size_t)m * 1024) + lane; const f32x4* gp = (const f32x4*)F.norm_final + lane;
#pragma unroll
        for (int j = 0; j < 4; ++j) { const f32x4 v = xr[64 * j], g = gp[64 * j]; xr[64 * j] = v * rs * g; }
    }
}

constexpr int N_PHASES = 16;
struct Args { const float* in[35]; float* out; unsigned char* ws; int ph_lo, ph_hi, li, pad; };
__global__ void __launch_bounds__(NWAVES * 64, 2) hybrid_fwd(Args args) {
    extern __shared__ __attribute__((aligned(16))) unsigned char lds_raw[];
    Ctx F;
    F.lds = (lptr)lds_raw;
    volatile LAS unsigned* MISC = (volatile LAS unsigned*)(F.lds + MISC_OFF);
    F.tid = threadIdx.x; F.lane = F.tid & 63; F.wave = __builtin_amdgcn_readfirstlane(F.tid >> 6);
    F.G = gridDim.x; { const int bx = blockIdx.x; F.vcu = (F.G % 8 == 0) ? (bx % 8) * (F.G / 8) + bx / 8 : bx; }
    unsigned char* ws = args.ws; float* out = args.out;
    F.x_prompt = args.in[0]; F.x_sample = args.in[1]; F.state_ret = args.in[2]; F.state_wkv = args.in[3]; F.state_shift = args.in[4]; F.state_conv = args.in[5]; F.cache_k = args.in[6]; F.cache_v = args.in[7];
    F.norm_mix = args.in[8]; F.norm_ffn = args.in[9]; F.norm_final = args.in[10]; F.w_in_ab = args.in[11]; F.w_out_ab = args.in[12]; F.ret_gn_g = args.in[13]; F.rwkv_mu = args.in[14]; F.rwkv_w0 = args.in[15];
    F.rwkv_w2 = args.in[16]; F.rwkv_a0 = args.in[17]; F.rwkv_a2 = args.in[18]; F.rwkv_g2 = args.in[19]; F.rwkv_kk = args.in[20]; F.rwkv_ka = args.in[21]; F.rwkv_rk = args.in[22]; F.rwkv_ln_g = args.in[23];
    F.rwkv_ln_b = args.in[24]; F.w_in_cd = args.in[25]; F.w_out_cd = args.in[26]; F.conv_w = args.in[27]; F.conv_b = args.in[28]; F.conv_ln_g = args.in[29]; F.conv_ln_b = args.in[30]; F.attn_sink = args.in[31];
    F.ffn_gate = args.in[32]; F.ffn_up = args.in[33]; F.ffn_down = args.in[34];
    F.y = out + O_Y; F.ret_p = out + O_RET_P; F.wkv_p = out + O_WKV_P; F.shift_p = out + O_SHIFT_P; F.conv_p = out + O_CONV_P; F.k_p = out + O_K_P; F.v_p = out + O_V_P;
    F.ret_s = out + O_RET_S; F.wkv_s = out + O_WKV_S; F.shift_s = out + O_SHIFT_S; F.conv_s = out + O_CONV_S; F.k_s = out + O_K_S; F.v_s = out + O_V_S;
    F.SS = (float*)(ws + WS_SS); F.ROPE = (double*)(ws + WS_ROPE);
    F.W_INAB = (bf16*)(ws + WS_W_INAB); F.W_OUTAB = (bf16*)(ws + WS_W_OUTAB); F.W_INCD = (bf16*)(ws + WS_W_INCD); F.W_OUTCD = (bf16*)(ws + WS_W_OUTCD); F.W_GU = (bf16*)(ws + WS_W_GU); F.W_DN = (bf16*)(ws + WS_W_DN);
    F.XB = (bf16*)(ws + WS_XB); F.MIX = (bf16*)(ws + WS_MIX); F.PROJ = (bf16*)(ws + WS_PROJ);
    F.RW_ITEM = (unsigned char*)out;
    F.RW_STATE = (bf16*)(ws + WS_XB); F.RET_G = (float*)(ws + WS_XB + (size_t)NCH * 8 * 4096 * 2);
    F.RW_COMP = ws + WS_COMP; F.RW_ENT = (float*)(ws + WS_ENT); F.RW_RK = (float*)(ws + WS_RK);

    for (int u = F.tid; u < (LDS_BYTES - RING_BYTES) / 4; u += NWAVES * 64) ((LAS unsigned*)(F.lds + RING_BYTES))[u] = 0u;
    __syncthreads();
    XcdBarrier bar = xcd_barrier_post((unsigned*)(ws + WS_CTL) + 1024 + args.li * XCD_BAR_WORDS, MISC + 8);
    const int lo = args.ph_lo, hi = args.ph_hi, G = F.G, vcu = F.vcu;
#ifndef PH_MASK
#define PH_MASK 0xFFFF
#endif
#define IN(k) (((PH_MASK >> (k)) & 1) && lo <= (k) && (k) < hi)
#define SEAM(k) do { if (IN(k) && IN((k) + 1)) xcd_barrier(bar); } while (0)
    typedef pg8::bf16_t gb;
    if (IN(0)) { p0_prologue(F); } SEAM(0);
    if (IN(1)) { pg8::Gemm g{(const gb*)F.XB, (const gb*)F.W_INAB, T_ALL, N_AB, 1024}; pg8::StaticOrder S; S.init(T_ALL, N_AB, G, (int)blockIdx.x);
        pg8::EpiNormBf16 E{(gb*)F.PROJ, N_AB, F.SS}; pg8::gemm_phase<pg8::EpiNormBf16, pg8::StaticOrder, true, true>(F.lds, g, S, E); } SEAM(1);
    if (IN(2)) {
        for (int it = vcu; it < 320; it += G) { if (it < 256) ret_p1_item(F, 0, it >> 2, it & 3); else ret_p1_item(F, 1, (it - 256) >> 2, it & 3); }
        for (int it = (vcu + G - (64 % G)) % G; it < NCH * 8; it += G) rwkv_p1_item(F, it >> 3, it & 7);
    } SEAM(2);
    if (IN(3)) { for (int it = vcu; it < 128; it += G) rwkv_l1_item(F, it & 15, it >> 4);
        ret_scan(F, (vcu + G - (128 % G)) % G); } SEAM(3);
    if (IN(4)) { for (int it = vcu; it < 8; it += G) rwkv_l2_item(F, it);
        for (int it = (vcu + G - (8 % G)) % G; it < 320; it += G) { if (it < 256) ret_p3_item(F, 0, it >> 2, it & 3); else ret_p3_item(F, 1, (it - 256) >> 2, it & 3); } } SEAM(4);
    if (IN(5)) { for (int it = vcu; it < 256; it += G) { if (it < 128) rwkv_l3_item(F, 0, it & 15, it >> 4); else rwkv_l3_item(F, 1, (it - 128) >> 3, it & 7); } } SEAM(5);
    if (IN(6)) { for (int it = vcu; it < NCH * 8; it += G) rwkv_p3_item(F, it >> 3, it & 7); } SEAM(6);
    if (IN(7)) { pg8::Gemm g{(const gb*)F.MIX, (const gb*)F.W_OUTAB, T_ALL, 1024, 1024}; pg8::StaticOrder S; S.init(T_ALL, 1024, G, (int)blockIdx.x);
        pg8::EpiResid E{F.x_prompt, F.x_sample, TP, F.y, (gb*)F.XB, F.SS}; pg8::gemm_phase<pg8::EpiResid, pg8::StaticOrder, true, true>(F.lds, g, S, E); } SEAM(7);
    if (IN(8)) { pg8::Gemm g{(const gb*)F.XB, (const gb*)F.W_GU, T_ALL, N_GU, 1024}; pg8::StaticOrder S; S.init(T_ALL, N_GU, G, (int)blockIdx.x);
        pg8::EpiSwiGLU E{(gb*)F.PROJ, D_FF, F.SS}; pg8::gemm_phase<pg8::EpiSwiGLU, pg8::StaticOrder, true, true>(F.lds, g, S, E); } SEAM(8);
    if (IN(9)) { pg8::Gemm g{(const gb*)F.PROJ, (const gb*)F.W_DN, T_ALL, 1024, D_FF}; pg8::StaticOrder S; S.init(T_ALL, 1024, G, (int)blockIdx.x);
        pg8::EpiResid E{F.y, F.y + (size_t)TP * 1024, TP, F.y, (gb*)F.XB, F.SS}; pg8::gemm_phase<pg8::EpiResid, pg8::StaticOrder, true, true>(F.lds, g, S, E); } SEAM(9);
    if (IN(10)) { pg8::Gemm g{(const gb*)F.XB, (const gb*)F.W_INCD, T_ALL, N_CD, 1024}; pg8::StaticOrder S; S.init(T_ALL, N_CD, G, (int)blockIdx.x);
        pg8::EpiNormBf16 E{(gb*)F.PROJ, N_CD, F.SS}; pg8::gemm_phase<pg8::EpiNormBf16, pg8::StaticOrder, true, true>(F.lds, g, S, E); } SEAM(10);
    if (IN(11)) {
        for (int it = vcu; it < 544; it += G) attn_item(F, it >> 1, it & 1);
        for (int it = (vcu + G - (32 % G)) % G; it < 544; it += G) conv_item(F, it);
    } SEAM(11);
    if (IN(12)) { pg8::Gemm g{(const gb*)F.MIX, (const gb*)F.W_OUTCD, T_ALL, 1024, 1024}; pg8::StaticOrder S; S.init(T_ALL, 1024, G, (int)blockIdx.x);
        pg8::EpiResid E{F.y, F.y + (size_t)TP * 1024, TP, F.y, (gb*)F.XB, F.SS}; pg8::gemm_phase<pg8::EpiResid, pg8::StaticOrder, true, true>(F.lds, g, S, E); } SEAM(12);
    if (IN(13)) { pg8::Gemm g{(const gb*)F.XB, (const gb*)(F.W_GU + (size_t)N_GU * 1024), T_ALL, N_GU, 1024}; pg8::StaticOrder S; S.init(T_ALL, N_GU, G, (int)blockIdx.x);
        pg8::EpiSwiGLU E{(gb*)F.PROJ, D_FF, F.SS}; pg8::gemm_phase<pg8::EpiSwiGLU, pg8::StaticOrder, true, true>(F.lds, g, S, E); } SEAM(13);
    if (IN(14)) { pg8::Gemm g{(const gb*)F.PROJ, (const gb*)(F.W_DN + (size_t)1024 * D_FF), T_ALL, 1024, D_FF}; pg8::StaticOrder S; S.init(T_ALL, 1024, G, (int)blockIdx.x);
        pg8::EpiResid E{F.y, F.y + (size_t)TP * 1024, TP, F.y, (gb*)F.XB, F.SS}; pg8::gemm_phase<pg8::EpiResid, pg8::StaticOrder, true, true>(F.lds, g, S, E); } SEAM(14);
    if (IN(15)) final_norm(F);
#undef IN
#undef SEAM
}

#ifndef MK_SPLIT
#define MK_SPLIT 0
#endif
extern "C" void kernel_launch(void* const* d_in, const int* in_sizes, int n_in, void* d_out, int out_size, void* d_ws, size_t ws_size, hipStream_t stream) {
    static int grid = 0;
    if (grid == 0) {
        if (n_in != 35 || out_size != (int)O_END || ws_size < WS_END) { fprintf(stderr, "kernel_launch: unexpected shapes: n_in %d out %d ws %zu\n", n_in, out_size, ws_size); grid = -1; return; }
        int dev = 0, cus = 0, per_cu = 0;
        if (hipGetDevice(&dev) != hipSuccess || hipDeviceGetAttribute(&cus, hipDeviceAttributeMultiprocessorCount, dev) != hipSuccess) { grid = -1; return; }
        if (hipFuncSetAttribute((const void*)hybrid_fwd, hipFuncAttributeMaxDynamicSharedMemorySize, LDS_BYTES) != hipSuccess) { fprintf(stderr, "kernel_launch: hipFuncSetAttribute failed\n"); grid = -1; return; }
        if (hipOccupancyMaxActiveBlocksPerMultiprocessor(&per_cu, (const void*)hybrid_fwd, NWAVES * 64, LDS_BYTES) != hipSuccess || per_cu < 1) { fprintf(stderr, "kernel_launch: occupancy query says %d blocks per CU; nothing launched\n", per_cu); (void)hipGetLastError(); grid = -1; return; }
        grid = cus;
    }
    if (grid < 0) return;
    (void)hipMemsetAsync((char*)d_ws + WS_CTL, 0, CTL_ZERO_BYTES, stream);
    Args a{};
    for (int i = 0; i < 35; ++i) a.in[i] = (const float*)d_in[i];
    a.out = (float*)d_out; a.ws = (unsigned char*)d_ws;
#if MK_SPLIT
    for (int p = 0; p < N_PHASES; ++p) { a.ph_lo = p; a.ph_hi = p + 1; a.li = 0; hipLaunchKernelGGL(hybrid_fwd, dim3(grid), dim3(NWAVES * 64), LDS_BYTES, stream, a); }
#else
    a.ph_lo = 0; a.ph_hi = N_PHASES; a.li = 0;
    hipLaunchKernelGGL(hybrid_fwd, dim3(grid), dim3(NWAVES * 64), LDS_BYTES, stream, a);
#endif
}
```

```cpp
#include <hip/hip_runtime.h>
#include <cstdio>
#include <cstdint>
#include <cmath>

constexpr int D_MODEL = 1024, TP = 16384, NSAMP = 16, LS = 64, T_ALL = TP + NSAMP * LS;
constexpr int NCH = T_ALL / 64;
constexpr int N_AB = 3840, N_CD = 1792, D_FF = 2816, N_GU = 2 * D_FF;
constexpr int PAST_POS = 4096;
constexpr int RWKV_PROJ = 1792, RW_OFF = 2048;
constexpr float RMS_EPS = 1e-6f, LN_EPS = 1e-5f, RWKV_LN_EPS = 64e-5f;
namespace pg8 {
#define PG8_LAS __attribute__((address_space(3)))
typedef unsigned short bf16_t;
typedef short bf16x8 __attribute__((ext_vector_type(8)));
typedef float f32x4 __attribute__((ext_vector_type(4)));
typedef unsigned u32x4 __attribute__((ext_vector_type(4)));
constexpr int BM = 256, BK = 64, HALF = 128, HTB = HALF * BK * 2  , STAGE_BYTES = 8 * HTB, NXCD = 8, WGM = 8;

__host__ __device__ __forceinline__ int lds_byte(int r, int c) { const int st = (r >> 4) * 2 + (c >> 5), rr = r & 15, cc = c & 31, ob = rr * 64 + cc * 2; return st * 1024 + (ob ^ (((ob >> 9) & 1) << 5)); }
__host__ __device__ __forceinline__ void stage_rc(int b, int& R, int& C) { const int st = b / 1024, sb = b % 1024, swz = sb ^ (((sb >> 9) & 1) << 5); R = (st >> 1) * 16 + swz / 64; C = (st & 1) * 32 + (swz % 64) / 2; }
__host__ __device__ __forceinline__ int perm32(int rho) { const int n = rho >> 4, i = rho & 15; return 8 * (i >> 2) + 4 * n + (i & 3); }

struct Unit { int pm, pn; };
struct Gemm { const bf16_t* A; const bf16_t* Bt; int M, N, K; };

struct StaticOrder {
    int nM, nN, nwg, G, c;
    __host__ __device__ void init(int M, int N, int G_, int c_) { nM = M / BM; nN = N / BM; nwg = nM * nN; G = G_; c = c_; }
    __host__ __device__ bool next(int i, Unit& u) const {
        const long L = (long)i * G + c; if (L >= nwg) return false;
        int wgid = (int)L; { const int q = nwg / NXCD, r = nwg % NXCD, xcd = wgid % NXCD, off = wgid / NXCD; wgid = (xcd < r ? xcd * (q + 1) : r * (q + 1) + (xcd - r) * q) + off; }
        const int nig = WGM * nN, gid = wgid / nig, fm = gid * WGM, gsz = (nM - fm) < WGM ? (nM - fm) : WGM;
        u.pm = fm + ((wgid % nig) % gsz); u.pn = (wgid % nig) / gsz; return true;
    }
    __device__ __forceinline__ void a_ready(const Unit&) const {}
    __device__ __forceinline__ void done(const Unit&) const {}
};

__device__ __forceinline__ unsigned cvt_pk_bf16(float lo, float hi) { unsigned r; asm volatile("v_cvt_pk_bf16_f32 %0, %1, %2" : "=v"(r) : "v"(lo), "v"(hi)); return r; }
__device__ __forceinline__ float row_rstd(const float* SS, int row) {
    const f32x4* p = (const f32x4*)(SS + (size_t)row * 16);
    const f32x4 a = p[0], b = p[1], c = p[2], d = p[3];
    const float s = (((a[0] + a[1]) + (a[2] + a[3])) + ((b[0] + b[1]) + (b[2] + b[3]))) + (((c[0] + c[1]) + (c[2] + c[3])) + ((d[0] + d[1]) + (d[2] + d[3])));
    return 1.0f / sqrtf(s * (1.0f / 1024.0f) + 1e-6f);
}
struct EpiNormBf16 {
    static constexpr bool PERM = true, AFTER_DRAIN = false;
    bf16_t* O; int ldc; const float* SS;
    __device__ __forceinline__ void operator()(const f32x4 (&acc)[2][2][4][2], const Unit& u, int wr, int wc, int fr, int fq) const {
        const int row0 = u.pm * BM + wr * 64 + fr, col0 = u.pn * BM + wc * 32 + 8 * fq;
#pragma unroll
        for (int ai = 0; ai < 2; ++ai)
#pragma unroll
            for (int m = 0; m < 4; ++m) { const int row = row0 + ai * HALF + m * 16; const float rs = row_rstd(SS, row); bf16_t* rowp = O + (size_t)row * ldc + col0;
#pragma unroll
                for (int bj = 0; bj < 2; ++bj) { const f32x4 v0 = acc[ai][bj][m][0] * rs, v1 = acc[ai][bj][m][1] * rs;
                    u32x4 w; w.x = cvt_pk_bf16(v0[0], v0[1]); w.y = cvt_pk_bf16(v0[2], v0[3]); w.z = cvt_pk_bf16(v1[0], v1[1]); w.w = cvt_pk_bf16(v1[2], v1[3]);
                    *(u32x4*)(rowp + bj * HALF) = w; } }
    }
};
template <int RES, bool OUT32> struct ResidOp {
    const float* res32; int res_row0;
    float* X; bf16_t* XB;
    __device__ __forceinline__ float operator()(int row, int col, f32x4 v0, f32x4 v1) const {
        if (RES == 0) { const float* rp = res32 + (size_t)(row - res_row0) * 1024 + col; v0 = v0 + *(const f32x4*)rp; v1 = v1 + *(const f32x4*)(rp + 4); }
        else { const u32x4 w = *(const u32x4*)(XB + (size_t)row * 1024 + col);
            v0 = v0 + (f32x4){__builtin_bit_cast(float, w.x << 16), __builtin_bit_cast(float, w.x & 0xffff0000u), __builtin_bit_cast(float, w.y << 16), __builtin_bit_cast(float, w.y & 0xffff0000u)};
            v1 = v1 + (f32x4){__builtin_bit_cast(float, w.z << 16), __builtin_bit_cast(float, w.z & 0xffff0000u), __builtin_bit_cast(float, w.w << 16), __builtin_bit_cast(float, w.w & 0xffff0000u)}; }
        if (OUT32) { float* xp = X + (size_t)row * 1024 + col; *(f32x4*)xp = v0; *(f32x4*)(xp + 4) = v1; }
        else { u32x4 w; w.x = cvt_pk_bf16(v0[0], v0[1]); w.y = cvt_pk_bf16(v0[2], v0[3]); w.z = cvt_pk_bf16(v1[0], v1[1]); w.w = cvt_pk_bf16(v1[2], v1[3]); *(u32x4*)(XB + (size_t)row * 1024 + col) = w; }
        return ((v0[0] * v0[0] + v0[1] * v0[1]) + (v0[2] * v0[2] + v0[3] * v0[3])) + ((v1[0] * v1[0] + v1[1] * v1[1]) + (v1[2] * v1[2] + v1[3] * v1[3]));
    }
};
template <int RES, bool OUT32> struct EpiResid {
    static constexpr bool PERM = true, AFTER_DRAIN = false;
    ResidOp<RES, OUT32> op; float* SS;
    __device__ __forceinline__ void operator()(const f32x4 (&acc)[2][2][4][2], const Unit& u, int wr, int wc, int fr, int fq) const {
        const int row0 = u.pm * BM + wr * 64 + fr, col0 = u.pn * BM + wc * 32 + 8 * fq;
#pragma unroll
        for (int ai = 0; ai < 2; ++ai)
#pragma unroll
            for (int m = 0; m < 4; ++m) { const int row = row0 + ai * HALF + m * 16; float ssq = 0.f;
#pragma unroll
                for (int bj = 0; bj < 2; ++bj) ssq += op(row, col0 + bj * HALF, acc[ai][bj][m][0], acc[ai][bj][m][1]);
                ssq += __shfl_xor(ssq, 16); ssq += __shfl_xor(ssq, 32);
                if (fq == 0) SS[(size_t)row * 16 + u.pn * 4 + wc] = ssq; }
    }
};
struct EpiSwiGLU {
    static constexpr bool PERM = true, AFTER_DRAIN = false;
    bf16_t* O; int ldc; const float* SS;
    __device__ __forceinline__ void operator()(const f32x4 (&acc)[2][2][4][2], const Unit& u, int wr, int wc, int fr, int fq) const {
        const int row0 = u.pm * BM + wr * 64 + fr, col0 = u.pn * HALF + wc * 32 + 8 * fq;
#pragma unroll
        for (int ai = 0; ai < 2; ++ai)
#pragma unroll
            for (int m = 0; m < 4; ++m) { const int row = row0 + ai * HALF + m * 16; const float rs = row_rstd(SS, row);
                float o[8];
#pragma unroll
                for (int n = 0; n < 2; ++n)
#pragma unroll
                    for (int e = 0; e < 4; ++e) { const float g = acc[ai][0][m][n][e] * rs, up = acc[ai][1][m][n][e] * rs; o[4 * n + e] = g / (1.0f + __expf(-g)) * up; }
                u32x4 w; w.x = cvt_pk_bf16(o[0], o[1]); w.y = cvt_pk_bf16(o[2], o[3]); w.z = cvt_pk_bf16(o[4], o[5]); w.w = cvt_pk_bf16(o[6], o[7]);
                *(u32x4*)(O + (size_t)row * ldc + col0) = w; }
    }
};
template <class Epi, class Sched, bool ALIGN_EPI = false, bool SP2 = false>
__device__ __forceinline__ void gemm_phase(PG8_LAS unsigned char* lds, const Gemm g, const Sched& S, const Epi& E) {
    const int tid = threadIdx.x, wid = __builtin_amdgcn_readfirstlane(tid >> 6), lane = tid & 63, wr = wid >> 2, wc = wid & 3, fr = lane & 15, fq = lane >> 4;
    const int K = g.K, nt = K / BK;
    unsigned voffA[2], voffB[2];
#pragma unroll
    for (int i = 0; i < 2; ++i) { int R, C; stage_rc(tid * 16 + i * 8192, R, C); const int Rb = Epi::PERM ? ((R & ~31) + perm32(R & 31)) : R;
        voffA[i] = (unsigned)(R * K + C) * 2u; voffB[i] = (unsigned)(Rb * K + C) * 2u; }
    const size_t kstep = (size_t)(BK * 2);
    const size_t hstep = (size_t)HALF * K * 2;
    const size_t tstep = 2 * hstep;
    const unsigned ldsw = (unsigned)wid * 1024u;
    const int aoff = lds_byte(wr * 64 + fr, fq * 8), boff = lds_byte(wc * 32 + fr, fq * 8);
#define PG8_SA(b, h) (((b) * 2 + (h)) * HTB)
#define PG8_SB(b, h) ((4 + (b) * 2 + (h)) * HTB)
#define PG8_STAGE(bufoff, gbase, voff) do { _Pragma("unroll") for (int _i = 0; _i < 2; ++_i) \
        __builtin_amdgcn_global_load_lds((const unsigned*)((const char*)(gbase) + (voff)[_i]), (PG8_LAS unsigned*)(lds + (bufoff) + ldsw + _i * 8192), 16, 0, 0); } while (0)
#define PG8_LDA(dst, b, h) do { _Pragma("unroll") for (int m = 0; m < 4; ++m) _Pragma("unroll") for (int k = 0; k < 2; ++k) dst[m][k] = *(const PG8_LAS bf16x8*)(lds + PG8_SA(b, h) + aoff + m * 2048 + k * 1024); } while (0)
#define PG8_LDB(dst, b, h) do { _Pragma("unroll") for (int n = 0; n < 2; ++n) _Pragma("unroll") for (int k = 0; k < 2; ++k) dst[n][k] = *(const PG8_LAS bf16x8*)(lds + PG8_SB(b, h) + boff + n * 2048 + k * 1024); } while (0)
#define PG8_MMA(ai, bj, At, Bt) do { __builtin_amdgcn_s_setprio(1); _Pragma("unroll") for (int m = 0; m < 4; ++m) _Pragma("unroll") for (int n = 0; n < 2; ++n) _Pragma("unroll") for (int k = 0; k < 2; ++k) \
        acc[ai][bj][m][n] = __builtin_amdgcn_mfma_f32_16x16x32_bf16(Bt[n][k], At[m][k], acc[ai][bj][m][n], 0, 0, 0); __builtin_amdgcn_s_setprio(0); } while (0)
#define PG8_WAIT_V(n) asm volatile("s_waitcnt vmcnt(" #n ")" ::: "memory")
#define PG8_WAIT_L(n) asm volatile("s_waitcnt lgkmcnt(" #n ")" ::: "memory")
#define PG8_BAR __builtin_amdgcn_s_barrier()
#define PG8_SCHED __builtin_amdgcn_sched_barrier(0)
    Unit cur, nxt; int ui = 0;
    if (!S.next(0, cur)) return;
    f32x4 acc[2][2][4][2];
#pragma unroll
    for (int a = 0; a < 2; ++a)
#pragma unroll
        for (int b = 0; b < 2; ++b)
#pragma unroll
            for (int m = 0; m < 4; ++m)
#pragma unroll
                for (int n = 0; n < 2; ++n) acc[a][b][m][n] = (f32x4){0.f, 0.f, 0.f, 0.f};
    bf16x8 At[4][2], B0[2][2], B1[2][2];
    const char* cA = (const char*)g.A + (size_t)cur.pm * tstep; const char* cB = (const char*)g.Bt + (size_t)cur.pn * tstep;
    S.a_ready(cur);
    if constexpr (SP2) {
        PG8_STAGE(PG8_SB(0, 0), cB, voffB); PG8_STAGE(PG8_SB(0, 1), cB + hstep, voffB); PG8_STAGE(PG8_SA(0, 0), cA, voffA); PG8_STAGE(PG8_SA(0, 1), cA + hstep, voffA);
        if (wr == 1) PG8_BAR;
        PG8_WAIT_V(2); PG8_BAR;
        PG8_STAGE(PG8_SB(1, 0), cB + kstep, voffB); PG8_STAGE(PG8_SA(1, 0), cA + kstep, voffA); PG8_STAGE(PG8_SB(1, 1), cB + hstep + kstep, voffB);
        PG8_WAIT_V(6); PG8_BAR;
    } else {
        PG8_STAGE(PG8_SB(0, 0), cB, voffB); PG8_STAGE(PG8_SA(0, 0), cA, voffA); PG8_STAGE(PG8_SB(0, 1), cB + hstep, voffB); PG8_STAGE(PG8_SA(0, 1), cA + hstep, voffA);
        if (wr == 1) PG8_BAR;
        PG8_WAIT_V(4); PG8_BAR;
        PG8_STAGE(PG8_SB(1, 0), cB + kstep, voffB); PG8_STAGE(PG8_SA(1, 0), cA + kstep, voffA); PG8_STAGE(PG8_SB(1, 1), cB + hstep + kstep, voffB);
        PG8_WAIT_V(6); PG8_BAR;
    }
    for (;;) {
        const bool has_next = S.next(ui + 1, nxt);
        const char* nA = has_next ? (const char*)g.A + (size_t)nxt.pm * tstep : cA; const char* nB = has_next ? (const char*)g.Bt + (size_t)nxt.pn * tstep : cB;
        for (int t = 0; t < nt; t += 2) {
            const bool last = (t == nt - 2);
            const char* a1 = cA + (size_t)(t + 1) * kstep;
            const char* a2 = last ? nA : cA + (size_t)(t + 2) * kstep; const char* b2 = last ? nB : cB + (size_t)(t + 2) * kstep;
            const char* a3 = a2 + kstep; const char* b3 = b2 + kstep;
            if (last && has_next) S.a_ready(nxt);
            if constexpr (SP2) {
            PG8_LDB(B0, 0, 0); PG8_LDB(B1, 0, 1); PG8_SCHED; PG8_LDA(At, 0, 0); PG8_STAGE(PG8_SA(1, 1), a1 + hstep, voffA);
            PG8_WAIT_V(8); PG8_WAIT_L(0); PG8_BAR; PG8_MMA(0, 0, At, B0); PG8_MMA(0, 1, At, B1); PG8_BAR; PG8_SCHED;
            PG8_LDA(At, 0, 1); PG8_STAGE(PG8_SB(0, 0), b2, voffB); PG8_STAGE(PG8_SB(0, 1), b2 + hstep, voffB); PG8_STAGE(PG8_SA(0, 0), a2, voffA);
            PG8_WAIT_V(8); PG8_WAIT_L(0); PG8_BAR; PG8_MMA(1, 0, At, B0); PG8_MMA(1, 1, At, B1); PG8_BAR; PG8_SCHED;
            PG8_LDB(B0, 1, 0); PG8_LDB(B1, 1, 1); PG8_SCHED; PG8_LDA(At, 1, 0); PG8_STAGE(PG8_SA(0, 1), a2 + hstep, voffA);
            PG8_WAIT_V(8); PG8_WAIT_L(0); PG8_BAR; PG8_MMA(0, 0, At, B0); PG8_MMA(0, 1, At, B1); PG8_BAR; PG8_SCHED;
            PG8_LDA(At, 1, 1); PG8_STAGE(PG8_SB(1, 0), b3, voffB); PG8_STAGE(PG8_SB(1, 1), b3 + hstep, voffB); PG8_STAGE(PG8_SA(1, 0), a3, voffA);
            PG8_WAIT_V(8); PG8_WAIT_L(0); PG8_BAR; PG8_MMA(1, 0, At, B0); PG8_MMA(1, 1, At, B1); PG8_BAR; PG8_SCHED;
            } else {
            PG8_LDB(B0, 0, 0); PG8_SCHED; PG8_LDA(At, 0, 0); PG8_STAGE(PG8_SA(1, 1), a1 + hstep, voffA);
            PG8_WAIT_L(8); PG8_BAR; PG8_WAIT_L(0); PG8_MMA(0, 0, At, B0); PG8_BAR; PG8_SCHED;
            PG8_LDB(B1, 0, 1); PG8_STAGE(PG8_SB(0, 0), b2, voffB);
            PG8_BAR; PG8_WAIT_L(0); PG8_MMA(0, 1, At, B1); PG8_BAR;
            PG8_LDA(At, 0, 1); PG8_STAGE(PG8_SA(0, 0), a2, voffA);
            PG8_BAR; PG8_WAIT_L(0); PG8_MMA(1, 0, At, B0); PG8_BAR; PG8_SCHED;
            PG8_STAGE(PG8_SB(0, 1), b2 + hstep, voffB);
            PG8_WAIT_V(6); PG8_BAR; PG8_MMA(1, 1, At, B1); PG8_BAR;
            PG8_LDB(B0, 1, 0); PG8_SCHED; PG8_LDA(At, 1, 0); PG8_STAGE(PG8_SA(0, 1), a2 + hstep, voffA);
            PG8_WAIT_L(8); PG8_BAR; PG8_WAIT_L(0); PG8_MMA(0, 0, At, B0); PG8_BAR; PG8_SCHED;
            PG8_LDB(B1, 1, 1); PG8_STAGE(PG8_SB(1, 0), b3, voffB);
            PG8_BAR; PG8_WAIT_L(0); PG8_MMA(0, 1, At, B1); PG8_BAR;
            PG8_LDA(At, 1, 1); PG8_STAGE(PG8_SA(1, 0), a3, voffA);
            PG8_BAR; PG8_WAIT_L(0); PG8_MMA(1, 0, At, B0); PG8_BAR; PG8_SCHED;
            PG8_STAGE(PG8_SB(1, 1), b3 + hstep, voffB);
            PG8_WAIT_V(6); PG8_BAR; PG8_MMA(1, 1, At, B1); PG8_BAR;
            }
        }
        if constexpr (ALIGN_EPI) { if (wr == 0) PG8_BAR; }
        if constexpr (!Epi::AFTER_DRAIN) { E(acc, cur, wr, wc, fr, fq); S.done(cur); }
        if (!has_next) break;
#pragma unroll
        for (int a = 0; a < 2; ++a)
#pragma unroll
            for (int b = 0; b < 2; ++b)
#pragma unroll
                for (int m = 0; m < 4; ++m)
#pragma unroll
                    for (int n = 0; n < 2; ++n) acc[a][b][m][n] = (f32x4){0.f, 0.f, 0.f, 0.f};
        cur = nxt; cA = nA; cB = nB; ++ui;
        if constexpr (ALIGN_EPI) { if (wr == 1) PG8_BAR; }
    }
    PG8_WAIT_V(0);
    if constexpr (!ALIGN_EPI) { if (wr == 0) PG8_BAR; }
    PG8_BAR;
    if constexpr (Epi::AFTER_DRAIN) { E.fused(acc, cur, wr, wc, fr, fq, lds, wid, lane); S.done(cur); }
#undef PG8_SA
#undef PG8_SB
#undef PG8_STAGE
#undef PG8_LDA
#undef PG8_LDB
#undef PG8_MMA
#undef PG8_WAIT_V
#undef PG8_WAIT_L
#undef PG8_BAR
#undef PG8_SCHED
}
}
#define GAS __attribute__((address_space(1)))
#define LAS __attribute__((address_space(3)))
typedef unsigned short bf16;
typedef unsigned v4u __attribute__((ext_vector_type(4)));
typedef float f32x4 __attribute__((ext_vector_type(4)));
typedef short bf16x8 __attribute__((ext_vector_type(8)));
typedef GAS unsigned gu32;
typedef GAS unsigned long long gu64;
#define RLX_AGENT __ATOMIC_RELAXED, __HIP_MEMORY_SCOPE_AGENT
#define LDS_WAIT() asm volatile("s_waitcnt lgkmcnt(0)" ::: "memory")
#define VM_WAIT() asm volatile("s_waitcnt vmcnt(0)" ::: "memory")
__device__ __forceinline__ unsigned long long rt() { return __builtin_amdgcn_s_memrealtime(); }
typedef float f32x2_cv __attribute__((ext_vector_type(2))); typedef __bf16 bf16x2_cv __attribute__((ext_vector_type(2)));
__device__ __forceinline__ unsigned pk2(float lo, float hi) { f32x2_cv v = {lo, hi}; bf16x2_cv b = __builtin_convertvector(v, bf16x2_cv); return __builtin_bit_cast(unsigned, b); }
__device__ __forceinline__ unsigned f2bf(float f) { return pk2(f, f) & 0xffffu; }
#define XB_TMO      128
#define XB_XCNT(j)  (256  + 64 * (j))
#define XB_XSUB(j)  (1280 + 64 * (j))
#define XB_XGEN(j)  (2304 + 64 * (j))
#define XB_TOP      3328
#define XB_TOPGEN   3392
#define XCD_BAR_WORDS 3456
#define XB_SPIN_CAP (1u << 18)

__device__ __forceinline__ unsigned xb_ld(unsigned* p)              { return __hip_atomic_load(p, __ATOMIC_RELAXED, __HIP_MEMORY_SCOPE_AGENT); }
__device__ __forceinline__ unsigned xb_add(unsigned* p, unsigned v) { return __hip_atomic_fetch_add(p, v, __ATOMIC_RELAXED, __HIP_MEMORY_SCOPE_AGENT); }
__device__ __forceinline__ unsigned xb_xcc_id() { return (unsigned)__builtin_amdgcn_s_getreg((3 << 11) | 20) & 0xFu; }
#define XB_SPIN(cond, bar) do { unsigned _sp = 0; while (cond) { __builtin_amdgcn_s_sleep(1); \
    if ((++_sp & 255u) == 0u) { if (xb_ld(&(bar)[XB_TMO])) break; if (_sp > XB_SPIN_CAP) { atomicAdd(&(bar)[XB_TMO], 1u); break; } } } } while (0)

struct XcdBarrier {
    unsigned* bar; unsigned x;
    volatile LAS unsigned* st;
};

__device__ __forceinline__ XcdBarrier xcd_barrier_post(unsigned* bar, volatile LAS unsigned* st) {
    XcdBarrier b; b.bar = bar; b.x = xb_xcc_id(); b.st = st;
    if (threadIdx.x == 0) (void)xb_add(&bar[XB_XCNT(b.x)], 1u);
    return b;
}
__device__ __forceinline__ void xcd_barrier_complete(unsigned* bar, unsigned x, unsigned& nloc, unsigned& nx) {
    const unsigned G = gridDim.x * gridDim.y * gridDim.z;
    unsigned sum, cnt, mine, sp = 0u;
    for (;;) {
        sum = 0u; cnt = 0u; mine = 0u;
#pragma unroll
        for (unsigned j = 0; j < 16; ++j) { const unsigned c = xb_ld(&bar[XB_XCNT(j)]); sum += c; cnt += (c > 0u) ? 1u : 0u; mine = (j == x) ? c : mine; }
        if (sum == G) break;
        __builtin_amdgcn_s_sleep(1);
        if ((++sp & 255u) == 0u) { if (xb_ld(&bar[XB_TMO])) break; if (sp > XB_SPIN_CAP) { atomicAdd(&bar[XB_TMO], 1u); break; } }
    }
    nloc = mine > 0u ? mine : 1u; nx = cnt > 0u ? cnt : 1u;
}

__device__ __forceinline__ void xcd_barrier(const XcdBarrier& b) {
    asm volatile("s_waitcnt vmcnt(0)" ::: "memory");
    __syncthreads();
    if (threadIdx.x == 0) {
        unsigned* bar = b.bar;
        __builtin_amdgcn_s_waitcnt(0);
        unsigned nloc = b.st[0], nx = b.st[1];
        if (nloc == 0u) { xcd_barrier_complete(bar, b.x, nloc, nx); b.st[0] = nloc; b.st[1] = nx; }
        const unsigned old = xb_add(&bar[XB_XSUB(b.x)], 1u);
        const unsigned gen = old / nloc;
        if (old + 1u == (gen + 1u) * nloc) {
            __builtin_amdgcn_fence(__ATOMIC_RELEASE, "agent");
            asm volatile("s_waitcnt vmcnt(0)" ::: "memory");
            const unsigned og = xb_add(&bar[XB_TOP], 1u);
            const unsigned tg = og / nx;
            if (og + 1u == (tg + 1u) * nx) xb_add(&bar[XB_TOPGEN], 1u);
            else XB_SPIN(xb_ld(&bar[XB_TOPGEN]) == tg, bar);
            __builtin_amdgcn_fence(__ATOMIC_ACQUIRE, "agent");
            xb_add(&bar[XB_XGEN(b.x)], 1u);
            asm volatile("s_waitcnt vmcnt(0)" ::: "memory");
        } else {
            XB_SPIN(xb_ld(&bar[XB_XGEN(b.x)]) == gen, bar);
            __builtin_amdgcn_fence(__ATOMIC_ACQUIRE, "agent");
            asm volatile("s_waitcnt vmcnt(0)" ::: "memory");
        }
    }
    __syncthreads();
}
constexpr size_t MiB = 1u << 20;
constexpr size_t WS_CTL = 0, CTL_ZERO_BYTES = 64 * 1024;
constexpr size_t WS_ROPE = 1 * MiB, WS_SS = 2 * MiB;
constexpr size_t WS_W_INAB = 4 * MiB, WS_W_OUTAB = WS_W_INAB + (size_t)N_AB * 1024 * 2, WS_W_INCD = WS_W_OUTAB + 2 * MiB, WS_W_OUTCD = WS_W_INCD + (size_t)N_CD * 1024 * 2,
                 WS_W_GU = WS_W_OUTCD + 2 * MiB, WS_W_DN = WS_W_GU + 2 * (size_t)N_GU * 1024 * 2, WS_W_END = WS_W_DN + 2 * (size_t)D_FF * 1024 * 2;
constexpr size_t WS_XB = 52 * MiB, WS_MIX = 86 * MiB, WS_PROJ = 120 * MiB, WS_PROJ_END = WS_PROJ + (size_t)T_ALL * N_AB * 2;
constexpr size_t WS_COMP = WS_PROJ_END, WS_ENT = WS_COMP + 3 * MiB, WS_RK = WS_ENT + 2 * MiB, WS_END = WS_RK + 1 * MiB;
static_assert(WS_W_END <= WS_XB && WS_XB + (size_t)T_ALL * 1024 * 2 <= WS_MIX && WS_MIX + (size_t)T_ALL * 1024 * 2 <= WS_PROJ && WS_END <= 256 * MiB, "d_ws map");
static_assert((size_t)NCH * 8 * 4096 * 2 + (size_t)64 * 4 * 16384 * 4 <= (size_t)T_ALL * 1024 * 2, "rwkv states + retention group states fit the XB region");
static_assert(128 * 24576 <= 3 * MiB && 128 * 16384 <= 2 * MiB && NCH * 8 * 64 * 4 <= 1 * MiB, "scan scratch");
constexpr size_t O_Y = 0, O_RET_P = (size_t)T_ALL * 1024, O_WKV_P = O_RET_P + 65536, O_SHIFT_P = O_WKV_P + 32768, O_CONV_P = O_SHIFT_P + 1792, O_K_P = O_CONV_P + 15360, O_V_P = O_K_P + 16384,
                 O_RET_S = O_V_P + 16384, O_WKV_S = O_RET_S + 16 * 65536, O_SHIFT_S = O_WKV_S + 16 * 32768, O_CONV_S = O_SHIFT_S + 16 * 1792, O_K_S = O_CONV_S + 16 * 15360, O_V_S = O_K_S + 16 * 16384,
                 O_END = O_V_S + 16 * 16384;
static_assert(O_END == 20345600, "output size");
constexpr int RING_BYTES = 131072, MISC_OFF = RING_BYTES + 320, LDS_BYTES = 147456, NWAVES = 8;

#define DI __device__ __forceinline__
typedef LAS unsigned char* lptr;
typedef unsigned u32x2 __attribute__((ext_vector_type(2)));
typedef float f32x16 __attribute__((ext_vector_type(16)));
typedef float f32x2 __attribute__((ext_vector_type(2)));
DI float bf2f(unsigned h) { return __builtin_bit_cast(float, h << 16); }
DI void unpack8(const v4u w, float* o) {
    o[0] = bf2f(w.x & 0xffffu); o[1] = bf2f(w.x >> 16); o[2] = bf2f(w.y & 0xffffu); o[3] = bf2f(w.y >> 16);
    o[4] = bf2f(w.z & 0xffffu); o[5] = bf2f(w.z >> 16); o[6] = bf2f(w.w & 0xffffu); o[7] = bf2f(w.w >> 16);
}
DI v4u pack8(const float* o) { v4u w; w.x = pk2(o[0], o[1]); w.y = pk2(o[2], o[3]); w.z = pk2(o[4], o[5]); w.w = pk2(o[6], o[7]); return w; }
DI void ld8f(const float* p, float* o) { const f32x4 a = *(const f32x4*)p, b = *(const f32x4*)(p + 4); o[0] = a[0]; o[1] = a[1]; o[2] = a[2]; o[3] = a[3]; o[4] = b[0]; o[5] = b[1]; o[6] = b[2]; o[7] = b[3]; }
DI void st8f(float* p, const float* o) { *(f32x4*)p = (f32x4){o[0], o[1], o[2], o[3]}; *(f32x4*)(p + 4) = (f32x4){o[4], o[5], o[6], o[7]}; }
DI void ld8bf(const bf16* p, float* o) { unpack8(*(const v4u*)p, o); }
DI float sigmoidf_(float x) { return 1.0f / (1.0f + __expf(-x)); }

template <int K> DI void mma16(f32x4& acc, lptr A, int lda, lptr Bt, int ldb, int fr, int fq) {
#pragma unroll
    for (int k0 = 0; k0 < K; k0 += 32) {
        const bf16x8 a = *(const LAS bf16x8*)(A + fr * lda + (k0 + 8 * fq) * 2);
        const bf16x8 b = *(const LAS bf16x8*)(Bt + fr * ldb + (k0 + 8 * fq) * 2);
        acc = __builtin_amdgcn_mfma_f32_16x16x32_bf16(a, b, acc, 0, 0, 0);
    }
}
DI void st_rm(lptr M, int ld, int r0, int c0, const f32x4 v, int fr, int fq) {
#pragma unroll
    for (int i = 0; i < 4; ++i) *(LAS bf16*)(M + (r0 + 4 * fq + i) * ld + (c0 + fr) * 2) = (bf16)f2bf(v[i]);
}
DI void st_tr(lptr MT, int ld, int r0, int c0, const f32x4 v, int fr, int fq) {
    u32x2 w; w.x = pk2(v[0], v[1]); w.y = pk2(v[2], v[3]);
    *(LAS u32x2*)(MT + (c0 + fr) * ld + (r0 + 4 * fq) * 2) = w;
}
DI u32x2 pack4(const f32x4 v) { u32x2 w; w.x = pk2(v[0], v[1]); w.y = pk2(v[2], v[3]); return w; }
DI f32x4 unpack4(const u32x2 w) { return (f32x4){bf2f(w.x & 0xffffu), bf2f(w.x >> 16), bf2f(w.y & 0xffffu), bf2f(w.y >> 16)}; }
DI void g2l_64x64(lptr dst, const bf16* src, int tid) { const int r = tid >> 3, s = tid & 7; *(LAS v4u*)(dst + r * 144 + s * 16) = *(const v4u*)(src + r * 64 + s * 8); }
DI void l2g_64x64(bf16* dst, lptr src, int tid) { const int r = tid >> 3, s = tid & 7; *(v4u*)(dst + r * 64 + s * 8) = *(const LAS v4u*)(src + r * 144 + s * 16); }

struct Ctx {
    float* out; unsigned char* ws;
    int tid, lane, wave, vcu, G;
    lptr lds;
    unsigned long long* pr;
};
#define CAS __attribute__((address_space(4)))
DI const float* in_ptr(const Ctx&, int i) { const CAS char* p = (const CAS char*)__builtin_amdgcn_kernarg_segment_ptr(); asm volatile("" : "+s"(p)); return *(const float* const CAS*)(p + 8 * i); }
#ifndef PROBE_SUB
#define PROBE_SUB -1
#endif
#define STAMP_BEGIN() unsigned long long st_last_ = (PROBE_SUB >= 0) ? __builtin_amdgcn_s_memrealtime() : 0ull
#define STAMP(k) do { if (PROBE_SUB >= 0) { const unsigned long long n_ = __builtin_amdgcn_s_memrealtime(); if ((k) == PROBE_SUB) *F.pr += n_ - st_last_; st_last_ = n_; } } while (0)

template <class RF> DI void gemm_small64(const Ctx& F, const bf16* A, const bf16* Bt, int K, int tile, const RF& rf, float* SS) {
    const int tid = F.tid, lane = F.lane, w = F.wave, fr = lane & 15, fq = lane >> 4; const lptr L = F.lds;
    const int row0 = TP + 64 * (tile >> 4), c0 = 64 * (tile & 15);
    const int kw = K >> 3, nst = kw >> 5;
    const bf16* ap = A + (size_t)(row0 + fr) * K + w * kw + 8 * fq; const bf16* bp = Bt + (size_t)(c0 + fr) * K + w * kw + 8 * fq;
    f32x4 acc[4][4];
#pragma unroll
    for (int m = 0; m < 4; ++m)
#pragma unroll
        for (int n = 0; n < 4; ++n) acc[m][n] = (f32x4){0.f, 0.f, 0.f, 0.f};
    bf16x8 a[4], b[4], an[4], bn[4];
#pragma unroll
    for (int i = 0; i < 4; ++i) { a[i] = *(const bf16x8*)(ap + (size_t)16 * i * K); b[i] = *(const bf16x8*)(bp + (size_t)16 * i * K); }
    for (int st = 0; st < nst; ++st) {
        const int kn = (st + 1 < nst) ? 32 * (st + 1) : 32 * st;
#pragma unroll
        for (int i = 0; i < 4; ++i) { an[i] = *(const bf16x8*)(ap + (size_t)16 * i * K + kn); bn[i] = *(const bf16x8*)(bp + (size_t)16 * i * K + kn); }
#pragma unroll
        for (int m = 0; m < 4; ++m)
#pragma unroll
            for (int n = 0; n < 4; ++n) acc[m][n] = __builtin_amdgcn_mfma_f32_16x16x32_bf16(b[n], a[m], acc[m][n], 0, 0, 0);
#pragma unroll
        for (int i = 0; i < 4; ++i) { a[i] = an[i]; b[i] = bn[i]; }
    }
#pragma unroll
    for (int m = 0; m < 4; ++m)
#pragma unroll
        for (int n = 0; n < 4; ++n) { const int row = 16 * m + fr, g4 = 4 * n + fq; *(LAS f32x4*)(L + w * 16384 + row * 256 + ((g4 ^ (row & 15)) << 4)) = acc[m][n]; }
    __syncthreads();
    {   const int row = tid >> 3, g = tid & 7; f32x4 v0 = (f32x4){0.f, 0.f, 0.f, 0.f}, v1 = v0;
#pragma unroll
        for (int ww = 0; ww < 8; ++ww) { v0 = v0 + *(const LAS f32x4*)(L + ww * 16384 + row * 256 + (((2 * g) ^ (row & 15)) << 4)); v1 = v1 + *(const LAS f32x4*)(L + ww * 16384 + row * 256 + (((2 * g + 1) ^ (row & 15)) << 4)); }
        float ssq = rf(row0 + row, c0 + 8 * g, v0, v1);
        ssq += __shfl_xor(ssq, 1); ssq += __shfl_xor(ssq, 2); ssq += __shfl_xor(ssq, 4);
        if (g == 0) SS[(size_t)(row0 + row) * 16 + (tile & 15)] = ssq; }
    __syncthreads();
}
constexpr int RW_LD = 144, RW_SLOT = 9216;
constexpr int RW_LDF = 272;
DI lptr rw_slot(lptr lds, int i) { return lds + i * RW_SLOT; }

DI void rw_load_p(const Ctx& F, int c, int t, int col, float* p, float* pp) {
    ld8bf(((bf16*)(F.ws + WS_PROJ)) + (size_t)(c * 64 + t) * N_AB + RW_OFF + col, p);
    if (t == 0 && c >= 256) ld8f(in_ptr(F, 4) + (size_t)(c - 256) * RWKV_PROJ + col, pp);
    else if (t == 0 && c == 0) {
#pragma unroll
        for (int e = 0; e < 8; ++e) pp[e] = 0.f; }
    else ld8bf(((bf16*)(F.ws + WS_PROJ)) + (size_t)(c * 64 + t - 1) * N_AB + RW_OFF + col, pp);
}
DI void rw_shift(const Ctx& F, int c, int t, int col, float* xs) {
    float p[8], pp[8], mu[8]; rw_load_p(F, c, t, col, p, pp); ld8f(in_ptr(F, 14) + col, mu);
#pragma unroll
    for (int e = 0; e < 8; ++e) xs[e] = p[e] + (pp[e] - p[e]) * mu[e];
}

DI void rwkv_p1_item(const Ctx& F, int c, int h) {
    const int tid = F.tid, lane = F.lane, w = F.wave, fr = lane & 15, fq = lane >> 4, tr = w >> 1, tc0 = 2 * (w & 1);
    const lptr L = F.lds;
    const int t = tid >> 3, s8 = tid & 7;
    const lptr TW = L, AL = L + 9216, SG = L + 18432, W2T = L + 35840, A2T = L + 45056, G2T = L + 54272;
    const lptr LG = L + 8 * RW_SLOT, A32 = LG + 17408;
    LAS float* GAMC = (LAS float*)(L + 14 * RW_SLOT);
    STAMP_BEGIN();
    {
        float xs[8], o[8];
        rw_shift(F, c, t, 1536 + 8 * s8, xs);
#pragma unroll
        for (int e = 0; e < 8; ++e) o[e] = tanhf(xs[e]);
        *(LAS v4u*)(TW + t * RW_LD + s8 * 16) = pack8(o);
        rw_shift(F, c, t, 1600 + 8 * s8, xs);
        *(LAS v4u*)(AL + t * RW_LD + s8 * 16) = pack8(xs);
#pragma unroll
        for (int q = 0; q < 2; ++q) { rw_shift(F, c, t, 1664 + 64 * q + 8 * s8, xs);
#pragma unroll
            for (int e = 0; e < 8; ++e) o[e] = sigmoidf_(xs[e]);
            *(LAS v4u*)(SG + t * 272 + (64 * q + 8 * s8) * 2) = pack8(o); }
        float v[8];
        ld8f(in_ptr(F, 16) + (size_t)t * 512 + h * 64 + 8 * s8, v);
#pragma unroll
        for (int e = 0; e < 8; ++e) *(LAS bf16*)(W2T + (8 * s8 + e) * RW_LD + t * 2) = (bf16)f2bf(v[e]);
        ld8f(in_ptr(F, 18) + (size_t)t * 512 + h * 64 + 8 * s8, v);
#pragma unroll
        for (int e = 0; e < 8; ++e) *(LAS bf16*)(A2T + (8 * s8 + e) * RW_LD + t * 2) = (bf16)f2bf(v[e]);
#pragma unroll
        for (int q = 0; q < 2; ++q) { ld8f(in_ptr(F, 19) + (size_t)(t + 64 * q) * 512 + h * 64 + 8 * s8, v);
#pragma unroll
            for (int e = 0; e < 8; ++e) *(LAS bf16*)(G2T + (8 * s8 + e) * 272 + (t + 64 * q) * 2) = (bf16)f2bf(v[e]); }
    }
    __syncthreads(); STAMP(0);
    {
        f32x4 aw[2], aa[2], ag[2];
#pragma unroll
        for (int i = 0; i < 2; ++i) { aw[i] = (f32x4){0.f, 0.f, 0.f, 0.f}; aa[i] = aw[i]; ag[i] = aw[i];
            mma16<64>(aw[i], TW + 16 * tr * RW_LD, RW_LD, W2T + 16 * (tc0 + i) * RW_LD, RW_LD, fr, fq);
            mma16<64>(aa[i], AL + 16 * tr * RW_LD, RW_LD, A2T + 16 * (tc0 + i) * RW_LD, RW_LD, fr, fq);
            mma16<128>(ag[i], SG + 16 * tr * 272, 272, G2T + 16 * (tc0 + i) * 272, 272, fr, fq); }
        __syncthreads();
#pragma unroll
        for (int i = 0; i < 2; ++i) { const int j = 16 * (tc0 + i) + fr, hj = h * 64 + j; const float w0 = in_ptr(F, 15)[hj], a0 = in_ptr(F, 17)[hj];
#pragma unroll
            for (int r = 0; r < 4; ++r) { const int tt = 16 * tr + 4 * fq + r;
                const float z = -(w0 + aw[i][r]); const float sp = fmaxf(z, 0.f) + log1pf(__expf(-fabsf(z)));
                *(LAS float*)(LG + tt * RW_LDF + j * 4) = -__expf(-sp - 0.5f);
                *(LAS float*)(A32 + tt * RW_LDF + j * 4) = sigmoidf_(a0 + aa[i][r]);
                ((bf16*)(F.ws + WS_MIX))[(size_t)(c * 64 + tt) * 1024 + 512 + hj] = (bf16)f2bf(ag[i][r]); } }
    }
    __syncthreads(); STAMP(1);
    if (w == 0) { float acc = 0.f;
#pragma unroll 8
        for (int tt = 0; tt < 64; ++tt) { acc += *(LAS float*)(LG + tt * RW_LDF + lane * 4); *(LAS float*)(LG + tt * RW_LDF + lane * 4) = acc; } }
    __syncthreads(); STAMP(2);
    {
        const int j0 = 8 * s8, hj0 = h * 64 + j0;
        float kk[8], k2[8], b[8];
        {   float xk[8], w8[8], a[8]; rw_shift(F, c, t, 512 + hj0, xk); ld8f(in_ptr(F, 20) + hj0, w8); float ss = 0.f;
#pragma unroll
            for (int e = 0; e < 8; ++e) { kk[e] = xk[e] * w8[e]; ss += kk[e] * kk[e]; }
            ss += __shfl_xor(ss, 1); ss += __shfl_xor(ss, 2); ss += __shfl_xor(ss, 4);
            const float inv = 1.0f / fmaxf(sqrtf(ss), 1e-12f);
            ld8f(in_ptr(F, 21) + hj0, w8);
#pragma unroll
            for (int e = 0; e < 8; ++e) { a[e] = *(LAS float*)(A32 + t * RW_LDF + (j0 + e) * 4); kk[e] *= inv; k2[e] = xk[e] * (1.0f + (a[e] - 1.0f) * w8[e]); b[e] = kk[e] * a[e]; } }
        asm volatile("" ::: "memory");
        float lg[8];
#pragma unroll
        for (int e = 0; e < 8; ++e) lg[e] = *(LAS float*)(LG + t * RW_LDF + (j0 + e) * 4);
        {   float xr[8], w8[8], o[8]; rw_shift(F, c, t, hj0, xr); ld8f(in_ptr(F, 22) + hj0, w8); float rks = 0.f;
#pragma unroll
            for (int e = 0; e < 8; ++e) { rks += xr[e] * k2[e] * w8[e]; o[e] = xr[e] * __expf(lg[e]); }
            rks += __shfl_xor(rks, 1); rks += __shfl_xor(rks, 2); rks += __shfl_xor(rks, 4);
            if (s8 == 0) ((float*)(F.ws + WS_RK))[(size_t)(c * 8 + h) * 64 + t] = rks;
            *(LAS v4u*)(rw_slot(L, 1) + t * RW_LD + s8 * 16) = pack8(o); }
        asm volatile("" ::: "memory");
        {   float o[8];
#pragma unroll
            for (int e = 0; e < 8; ++e) { const float lgm = t > 0 ? *(LAS float*)(LG + (t - 1) * RW_LDF + (j0 + e) * 4) : 0.f; o[e] = kk[e] * __expf(lgm); }
            *(LAS v4u*)(rw_slot(L, 0) + t * RW_LD + s8 * 16) = pack8(o);
#pragma unroll
            for (int e = 0; e < 8; ++e) *(LAS bf16*)(rw_slot(L, 4) + (j0 + e) * RW_LD + t * 2) = (bf16)f2bf(o[e]); }
        asm volatile("" ::: "memory");
        {   float o1[8], o2[8];
#pragma unroll
            for (int e = 0; e < 8; ++e) { const float ei = __expf(-lg[e]); o1[e] = b[e] * ei; o2[e] = k2[e] * ei; }
            *(LAS v4u*)(rw_slot(L, 2) + t * RW_LD + s8 * 16) = pack8(o1);
            *(LAS v4u*)(rw_slot(L, 3) + t * RW_LD + s8 * 16) = pack8(o2); }
        asm volatile("" ::: "memory");
        {
#pragma unroll
            for (int e = 0; e < 8; ++e) { const float lgc = *(LAS float*)(LG + 63 * RW_LDF + (j0 + e) * 4); const float ec = __expf(lgc - lg[e]);
                if (t == 63) GAMC[j0 + e] = __expf(lgc);
                *(LAS bf16*)(rw_slot(L, 5) + (j0 + e) * RW_LD + t * 2) = (bf16)f2bf(b[e] * ec);
                *(LAS bf16*)(rw_slot(L, 6) + (j0 + e) * RW_LD + t * 2) = (bf16)f2bf(k2[e] * ec); } }
        asm volatile("" ::: "memory");
        {   float xv[8]; rw_shift(F, c, t, 1024 + hj0, xv);
#pragma unroll
            for (int e = 0; e < 8; ++e) *(LAS bf16*)(rw_slot(L, 7) + (j0 + e) * RW_LD + t * 2) = (bf16)f2bf(xv[e]); }
    }
    __syncthreads(); STAMP(3);
    const lptr KG = rw_slot(L, 0), RG = rw_slot(L, 1), BI = rw_slot(L, 2), KI = rw_slot(L, 3), KGT = rw_slot(L, 4), BTT = rw_slot(L, 5), KTT = rw_slot(L, 6), VT = rw_slot(L, 7);
    const lptr BM = rw_slot(L, 8), PB = rw_slot(L, 9), PK = rw_slot(L, 10);
    const lptr XR0 = rw_slot(L, 11), XT0 = rw_slot(L, 12), PR0 = rw_slot(L, 13), XR1 = rw_slot(L, 0), XT1 = rw_slot(L, 2), PR1 = rw_slot(L, 3);
    f32x4 P[2];
    {
        f32x4 aA[2], aB[2], aPb[2], aPk[2];
#pragma unroll
        for (int i = 0; i < 2; ++i) { aA[i] = (f32x4){0.f, 0.f, 0.f, 0.f}; aB[i] = aA[i]; aPb[i] = aA[i]; aPk[i] = aA[i];
            mma16<64>(aA[i], KG + 16 * tr * RW_LD, RW_LD, BI + 16 * (tc0 + i) * RW_LD, RW_LD, fr, fq);
            mma16<64>(aB[i], KG + 16 * tr * RW_LD, RW_LD, KI + 16 * (tc0 + i) * RW_LD, RW_LD, fr, fq);
            mma16<64>(aPb[i], RG + 16 * tr * RW_LD, RW_LD, BI + 16 * (tc0 + i) * RW_LD, RW_LD, fr, fq);
            mma16<64>(aPk[i], RG + 16 * tr * RW_LD, RW_LD, KI + 16 * (tc0 + i) * RW_LD, RW_LD, fr, fq); }
        __syncthreads();
#pragma unroll
        for (int i = 0; i < 2; ++i) { const int s = 16 * (tc0 + i) + fr; f32x4 x, p1, bm, pb, pk;
#pragma unroll
            for (int r = 0; r < 4; ++r) { const int tt = 16 * tr + 4 * fq + r;
                x[r] = tt > s ? -aA[i][r] : 0.f; p1[r] = x[r] + (tt == s ? 1.f : 0.f); bm[r] = tt > s ? aB[i][r] : 0.f; pb[r] = tt >= s ? aPb[i][r] : 0.f; pk[r] = tt >= s ? aPk[i][r] : 0.f; }
            P[i] = p1;
            st_rm(XR0, RW_LD, 16 * tr, 16 * (tc0 + i), x, fr, fq); st_tr(XT0, RW_LD, 16 * tr, 16 * (tc0 + i), x, fr, fq);
            st_rm(PR0, RW_LD, 16 * tr, 16 * (tc0 + i), p1, fr, fq);
            st_rm(BM, RW_LD, 16 * tr, 16 * (tc0 + i), bm, fr, fq); st_rm(PB, RW_LD, 16 * tr, 16 * (tc0 + i), pb, fr, fq); st_rm(PK, RW_LD, 16 * tr, 16 * (tc0 + i), pk, fr, fq); }
    }
    __syncthreads(); STAMP(4);
#pragma unroll
    for (int st = 1; st <= 6; ++st) {
        const lptr XRc = (st & 1) ? XR0 : XR1, XTc = (st & 1) ? XT0 : XT1, XRn = (st & 1) ? XR1 : XR0, XTn = (st & 1) ? XT1 : XT0;
        const lptr PRc = (st & 1) ? PR1 : PR0, PRn = (st & 1) ? PR0 : PR1;
        f32x4 xn[2];
#pragma unroll
        for (int i = 0; i < 2; ++i) {
            if (st < 6) { xn[i] = (f32x4){0.f, 0.f, 0.f, 0.f}; mma16<64>(xn[i], XRc + 16 * tr * RW_LD, RW_LD, XTc + 16 * (tc0 + i) * RW_LD, RW_LD, fr, fq); }
            if (st > 1) mma16<64>(P[i], PRc + 16 * tr * RW_LD, RW_LD, XTc + 16 * (tc0 + i) * RW_LD, RW_LD, fr, fq);
        }
#pragma unroll
        for (int i = 0; i < 2; ++i) {
            if (st < 6) { st_rm(XRn, RW_LD, 16 * tr, 16 * (tc0 + i), xn[i], fr, fq); st_tr(XTn, RW_LD, 16 * tr, 16 * (tc0 + i), xn[i], fr, fq); }
            if (st > 1) st_rm(PRn, RW_LD, 16 * tr, 16 * (tc0 + i), P[i], fr, fq);
        }
        __syncthreads();
    }
    STAMP(5);
    const lptr TR = PR1, WT = rw_slot(L, 11), BVT = rw_slot(L, 12), UVT = rw_slot(L, 0), MS = rw_slot(L, 2), QS = rw_slot(L, 4);
    {
#pragma unroll
        for (int i = 0; i < 2; ++i) { f32x4 aw = (f32x4){0.f, 0.f, 0.f, 0.f}, ab = aw;
            mma16<64>(aw, TR + 16 * tr * RW_LD, RW_LD, KGT + 16 * (tc0 + i) * RW_LD, RW_LD, fr, fq);
            mma16<64>(ab, BM + 16 * tr * RW_LD, RW_LD, VT + 16 * (tc0 + i) * RW_LD, RW_LD, fr, fq);
            st_tr(WT, RW_LD, 16 * tr, 16 * (tc0 + i), aw, fr, fq); st_tr(BVT, RW_LD, 16 * tr, 16 * (tc0 + i), ab, fr, fq); }
    }
    __syncthreads();
    {
#pragma unroll
        for (int i = 0; i < 2; ++i) { f32x4 au = (f32x4){0.f, 0.f, 0.f, 0.f};
            mma16<64>(au, TR + 16 * tr * RW_LD, RW_LD, BVT + 16 * (tc0 + i) * RW_LD, RW_LD, fr, fq);
            st_tr(UVT, RW_LD, 16 * tr, 16 * (tc0 + i), au, fr, fq); }
    }
    __syncthreads();
    unsigned char* item = ((unsigned char*)F.out) + (size_t)(c * 8 + h) * 32768;
    {
#pragma unroll
        for (int i = 0; i < 2; ++i) { const int cb = 16 * (tc0 + i);
            f32x4 am = (f32x4){0.f, 0.f, 0.f, 0.f};
            mma16<64>(am, WT + 16 * tr * RW_LD, RW_LD, BTT + cb * RW_LD, RW_LD, fr, fq);
            { const int j = cb + fr; const float gc = GAMC[j]; f32x4 mv;
#pragma unroll
                for (int r = 0; r < 4; ++r) { const int jp = 16 * tr + 4 * fq + r; mv[r] = (jp == j ? gc : 0.f) - am[r]; }
                st_tr(MS, RW_LD, 16 * tr, cb, mv, fr, fq); }
            f32x4 aq = (f32x4){0.f, 0.f, 0.f, 0.f};
            mma16<64>(aq, WT + 16 * tr * RW_LD, RW_LD, PB + cb * RW_LD, RW_LD, fr, fq);
            { const f32x4 rgv = unpack4(*(const LAS u32x2*)(RG + (cb + fr) * RW_LD + (16 * tr + 4 * fq) * 2)); const f32x4 qv = rgv - aq; st_tr(QS, RW_LD, 16 * tr, cb, qv, fr, fq); }
            f32x4 g1 = (f32x4){0.f, 0.f, 0.f, 0.f}, g2 = g1, y1 = g1, y2 = g1;
            mma16<64>(g1, KTT + 16 * tr * RW_LD, RW_LD, VT + cb * RW_LD, RW_LD, fr, fq);
            mma16<64>(g2, BTT + 16 * tr * RW_LD, RW_LD, UVT + cb * RW_LD, RW_LD, fr, fq);
            mma16<64>(y1, PK + 16 * tr * RW_LD, RW_LD, VT + cb * RW_LD, RW_LD, fr, fq);
            mma16<64>(y2, PB + 16 * tr * RW_LD, RW_LD, UVT + cb * RW_LD, RW_LD, fr, fq);
            *(u32x2*)(item + 16384 + ((w * 2 + i) * 64 + lane) * 8) = pack4(g1 - g2);
            *(u32x2*)(item + 24576 + ((w * 2 + i) * 64 + lane) * 8) = pack4(y1 - y2); }
    }
    __syncthreads();
    l2g_64x64((bf16*)item, MS, tid); l2g_64x64((bf16*)(item + 8192), QS, tid);
    if (h == 0 && c >= 255) { float* dst = c == 255 ? (F.out + O_SHIFT_P) : (F.out + O_SHIFT_S) + (size_t)(c - 256) * RWKV_PROJ; const bf16* src = ((bf16*)(F.ws + WS_PROJ)) + (size_t)(c * 64 + 63) * N_AB + RW_OFF;
        for (int col = tid; col < RWKV_PROJ; col += 512) dst[col] = bf2f(src[col]); }
    __syncthreads(); STAMP(6);
}

DI void rw_ld_frag_bf16(const unsigned char* p, int w, int lane, f32x4* a) { a[0] = unpack4(*(const u32x2*)(p + ((w * 2) * 64 + lane) * 8)); a[1] = unpack4(*(const u32x2*)(p + ((w * 2 + 1) * 64 + lane) * 8)); }

DI void rwkv_l1_item(const Ctx& F, int g, int h) {
    const int tid = F.tid, lane = F.lane, w = F.wave, fr = lane & 15, fq = lane >> 4, tr = w >> 1, tc0 = 2 * (w & 1);
    const lptr L = F.lds, MA = rw_slot(L, 0), MHT = rw_slot(L, 1), GHT = rw_slot(L, 2), OS = rw_slot(L, 3);
    const int c0 = g * 16;
    f32x4 am[2], ag[2];
    { const unsigned char* item = ((unsigned char*)F.out) + (size_t)(c0 * 8 + h) * 32768; const bf16* M = (const bf16*)item;
#pragma unroll
        for (int i = 0; i < 2; ++i)
#pragma unroll
            for (int r = 0; r < 4; ++r) am[i][r] = bf2f(M[(16 * tr + 4 * fq + r) * 64 + 16 * (tc0 + i) + fr]);
        rw_ld_frag_bf16(item + 16384, w, lane, ag); }
    for (int c = c0 + 1; c < c0 + 16; ++c) {
        const unsigned char* item = ((unsigned char*)F.out) + (size_t)(c * 8 + h) * 32768;
        g2l_64x64(MA, (const bf16*)item, tid);
#pragma unroll
        for (int i = 0; i < 2; ++i) { st_tr(MHT, RW_LD, 16 * tr, 16 * (tc0 + i), am[i], fr, fq); st_tr(GHT, RW_LD, 16 * tr, 16 * (tc0 + i), ag[i], fr, fq); }
        f32x4 gc[2]; rw_ld_frag_bf16(item + 16384, w, lane, gc);
        __syncthreads();
#pragma unroll
        for (int i = 0; i < 2; ++i) { am[i] = (f32x4){0.f, 0.f, 0.f, 0.f}; ag[i] = gc[i];
            mma16<64>(am[i], MA + 16 * tr * RW_LD, RW_LD, MHT + 16 * (tc0 + i) * RW_LD, RW_LD, fr, fq);
            mma16<64>(ag[i], MA + 16 * tr * RW_LD, RW_LD, GHT + 16 * (tc0 + i) * RW_LD, RW_LD, fr, fq); }
        __syncthreads();
    }
    unsigned char* comp = (F.ws + WS_COMP) + (size_t)(h * 16 + g) * 24576;
#pragma unroll
    for (int i = 0; i < 2; ++i) { st_rm(OS, RW_LD, 16 * tr, 16 * (tc0 + i), am[i], fr, fq); *(f32x4*)(comp + 8192 + ((w * 2 + i) * 64 + lane) * 16) = ag[i]; }
    __syncthreads();
    l2g_64x64((bf16*)comp, OS, tid);
    __syncthreads();
}
DI void rwkv_l2_item(const Ctx& F, int h) {
    const int tid = F.tid, lane = F.lane, w = F.wave, fr = lane & 15, fq = lane >> 4, tr = w >> 1, tc0 = 2 * (w & 1);
    const lptr L = F.lds, MA = rw_slot(L, 0), EHT = rw_slot(L, 1);
    f32x4 e[2]; e[0] = (f32x4){0.f, 0.f, 0.f, 0.f}; e[1] = e[0];
    for (int g = 0; g < 16; ++g) {
        float* ent = ((float*)(F.ws + WS_ENT)) + (size_t)(h * 16 + g) * 4096;
#pragma unroll
        for (int i = 0; i < 2; ++i) *(f32x4*)(ent + ((w * 2 + i) * 64 + lane) * 4) = e[i];
        if (g == 15) break;
        const unsigned char* comp = (F.ws + WS_COMP) + (size_t)(h * 16 + g) * 24576;
        g2l_64x64(MA, (const bf16*)comp, tid);
#pragma unroll
        for (int i = 0; i < 2; ++i) st_tr(EHT, RW_LD, 16 * tr, 16 * (tc0 + i), e[i], fr, fq);
        f32x4 gh[2];
#pragma unroll
        for (int i = 0; i < 2; ++i) gh[i] = *(const f32x4*)(comp + 8192 + ((w * 2 + i) * 64 + lane) * 16);
        __syncthreads();
#pragma unroll
        for (int i = 0; i < 2; ++i) { e[i] = gh[i]; mma16<64>(e[i], MA + 16 * tr * RW_LD, RW_LD, EHT + 16 * (tc0 + i) * RW_LD, RW_LD, fr, fq); }
        __syncthreads();
    }
}
DI void rwkv_l3_item(const Ctx& F, int kind, int g, int h) {
    const int tid = F.tid, lane = F.lane, w = F.wave, fr = lane & 15, fq = lane >> 4, tr = w >> 1, tc0 = 2 * (w & 1);
    const lptr L = F.lds, MA = rw_slot(L, 0), SHT = rw_slot(L, 1);
    f32x4 s[2];
    int c0, nc;
    if (kind == 0) { c0 = g * 16; nc = 16; const float* ent = ((float*)(F.ws + WS_ENT)) + (size_t)(h * 16 + g) * 4096;
#pragma unroll
        for (int i = 0; i < 2; ++i) s[i] = *(const f32x4*)(ent + ((w * 2 + i) * 64 + lane) * 4); }
    else { c0 = 256 + g; nc = 1; const float* S = in_ptr(F, 3) + (size_t)(g * 8 + h) * 4096;
#pragma unroll
        for (int i = 0; i < 2; ++i) s[i] = *(const f32x4*)(S + (16 * (tc0 + i) + fr) * 64 + 16 * tr + 4 * fq); }
    for (int c = c0; c < c0 + nc; ++c) {
        const unsigned char* item = ((unsigned char*)F.out) + (size_t)(c * 8 + h) * 32768;
        bf16* stg = ((bf16*)(F.ws + WS_XB)) + (size_t)(c * 8 + h) * 4096;
        g2l_64x64(MA, (const bf16*)item, tid);
#pragma unroll
        for (int i = 0; i < 2; ++i) { st_tr(SHT, RW_LD, 16 * tr, 16 * (tc0 + i), s[i], fr, fq);
            *(u32x2*)(stg + (16 * (tc0 + i) + fr) * 64 + 16 * tr + 4 * fq) = pack4(s[i]); }
        f32x4 gc[2]; rw_ld_frag_bf16(item + 16384, w, lane, gc);
        __syncthreads();
#pragma unroll
        for (int i = 0; i < 2; ++i) { s[i] = gc[i]; mma16<64>(s[i], MA + 16 * tr * RW_LD, RW_LD, SHT + 16 * (tc0 + i) * RW_LD, RW_LD, fr, fq); }
        __syncthreads();
    }
    if (kind == 1 || g == 15) { float* out = kind == 1 ? (F.out + O_WKV_S) + (size_t)(g * 8 + h) * 4096 : (F.out + O_WKV_P) + (size_t)h * 4096;
#pragma unroll
        for (int i = 0; i < 2; ++i) *(f32x4*)(out + (16 * (tc0 + i) + fr) * 64 + 16 * tr + 4 * fq) = s[i]; }
}
DI void rwkv_p3_item(const Ctx& F, int c, int h) {
    const int tid = F.tid, lane = F.lane, w = F.wave, fr = lane & 15, fq = lane >> 4, tr = w >> 1, tc0 = 2 * (w & 1);
    const lptr L = F.lds, QA = rw_slot(L, 0), SB = rw_slot(L, 1), YS = rw_slot(L, 2);
    const unsigned char* item = ((unsigned char*)F.out) + (size_t)(c * 8 + h) * 32768;
    g2l_64x64(QA, (const bf16*)(item + 8192), tid);
    g2l_64x64(SB, ((bf16*)(F.ws + WS_XB)) + (size_t)(c * 8 + h) * 4096, tid);
    f32x4 y[2]; rw_ld_frag_bf16(item + 24576, w, lane, y);
    __syncthreads();
#pragma unroll
    for (int i = 0; i < 2; ++i) { mma16<64>(y[i], QA + 16 * tr * RW_LD, RW_LD, SB + 16 * (tc0 + i) * RW_LD, RW_LD, fr, fq);
#pragma unroll
        for (int r = 0; r < 4; ++r) *(LAS float*)(YS + (16 * tr + 4 * fq + r) * RW_LDF + (16 * (tc0 + i) + fr) * 4) = y[i][r]; }
    __syncthreads();
    {
        const int t = tid >> 3, s8 = tid & 7, i0 = 8 * s8, hi0 = h * 64 + i0;
        float yv[8], s = 0.f;
#pragma unroll
        for (int e = 0; e < 8; ++e) { yv[e] = *(LAS float*)(YS + t * RW_LDF + (i0 + e) * 4); s += yv[e]; }
        s += __shfl_xor(s, 1); s += __shfl_xor(s, 2); s += __shfl_xor(s, 4);
        const float mean = s * (1.0f / 64.0f); float q = 0.f;
#pragma unroll
        for (int e = 0; e < 8; ++e) { yv[e] -= mean; q += yv[e] * yv[e]; }
        q += __shfl_xor(q, 1); q += __shfl_xor(q, 2); q += __shfl_xor(q, 4);
        const float rstd = 1.0f / sqrtf(q * (1.0f / 64.0f) + RWKV_LN_EPS);
        float xv[8], lg_[8], lb_[8], gt[8], o[8];
        rw_shift(F, c, t, 1024 + hi0, xv);
        ld8f(in_ptr(F, 23) + hi0, lg_); ld8f(in_ptr(F, 24) + hi0, lb_);
        bf16* mp = ((bf16*)(F.ws + WS_MIX)) + (size_t)(c * 64 + t) * 1024 + 512 + hi0;
        ld8bf(mp, gt);
        const float rk = ((float*)(F.ws + WS_RK))[(size_t)(c * 8 + h) * 64 + t];
#pragma unroll
        for (int e = 0; e < 8; ++e) o[e] = (yv[e] * rstd * lg_[e] + lb_[e] + rk * xv[e]) * gt[e];
        *(v4u*)mp = pack8(o);
    }
    __syncthreads();
}
constexpr int RT_G = 4, RT_NG = 256 / RT_G;
constexpr int RT_LDQ = 272;
constexpr int RT_LDT = 144;
constexpr int RT_LDR = 272;
constexpr int RT_OFF_Q = 0, RT_OFF_K = 17408, RT_OFF_KT = 34816, RT_OFF_VT = 53248, RT_OFF_RT = 71680, RT_OFF_P = 106496, RT_OFF_OS = 0;
DI float ret_lg(int h) { return log1pf(-exp2f(-5.0f - (float)h)); }
DI int crow32(int reg, int hh) { return (reg & 3) + 8 * (reg >> 2) + 4 * hh; }
template <int KS> DI void mma32(f32x16& acc, lptr A, int lda, lptr Bt, int ldb, int r32, int hh) {
#pragma unroll
    for (int s = 0; s < KS; ++s) {
        const bf16x8 a = *(const LAS bf16x8*)(A + r32 * lda + (16 * s + 8 * hh) * 2);
        const bf16x8 b = *(const LAS bf16x8*)(Bt + r32 * ldb + (16 * s + 8 * hh) * 2);
        acc = __builtin_amdgcn_mfma_f32_32x32x16_bf16(a, b, acc, 0, 0, 0);
    }
}
DI void rope_cs(double inv, int pos, float& cs, float& sn) {
    const double a = (double)pos * inv; const double k = rint(a * 0.15915494309189535); const float r = (float)(a - k * 6.283185307179586);
    cs = __cosf(r); sn = __sinf(r);
}
DI void ret_stage(const Ctx& F, int c, int h, bool need_qk) {
    const int tid = F.tid, t = tid >> 3, s8 = tid & 7; const lptr L = F.lds;
    const int pos = (c < 256 ? c * 64 : PAST_POS) + t;
    const bf16* row = ((bf16*)(F.ws + WS_PROJ)) + (size_t)(c * 64 + t) * N_AB;
    const float lg = ret_lg(h), qd = __expf(lg * (float)(t + 1)), kd = __expf(lg * (float)(63 - t));
    float cs[8], sn[8];
#pragma unroll
    for (int e = 0; e < 8; ++e) rope_cs(((double*)(F.ws + WS_ROPE))[8 * s8 + e], pos, cs[e], sn[e]);
    float x1[8], x2[8], o1[8], o2[8];
    ld8bf(row + 512 + h * 128 + 8 * s8, x1); ld8bf(row + 512 + h * 128 + 64 + 8 * s8, x2);
#pragma unroll
    for (int e = 0; e < 8; ++e) { o1[e] = (x1[e] * cs[e] - x2[e] * sn[e]) * 0.08838834764831845f; o2[e] = (x1[e] * sn[e] + x2[e] * cs[e]) * 0.08838834764831845f; }
    if (need_qk) { *(LAS v4u*)(L + RT_OFF_K + t * RT_LDQ + s8 * 16) = pack8(o1); *(LAS v4u*)(L + RT_OFF_K + t * RT_LDQ + 128 + s8 * 16) = pack8(o2); }
#pragma unroll
    for (int e = 0; e < 8; ++e) { *(LAS bf16*)(L + RT_OFF_KT + (8 * s8 + e) * RT_LDT + t * 2) = (bf16)f2bf(o1[e] * kd); *(LAS bf16*)(L + RT_OFF_KT + (64 + 8 * s8 + e) * RT_LDT + t * 2) = (bf16)f2bf(o2[e] * kd); }
    if (need_qk) {
        ld8bf(row + h * 128 + 8 * s8, x1); ld8bf(row + h * 128 + 64 + 8 * s8, x2);
#pragma unroll
        for (int e = 0; e < 8; ++e) { o1[e] = (x1[e] * cs[e] - x2[e] * sn[e]) * qd; o2[e] = (x1[e] * sn[e] + x2[e] * cs[e]) * qd; }
        *(LAS v4u*)(L + RT_OFF_Q + t * RT_LDQ + s8 * 16) = pack8(o1); *(LAS v4u*)(L + RT_OFF_Q + t * RT_LDQ + 128 + s8 * 16) = pack8(o2);
    }
    ld8bf(row + 1024 + h * 128 + 8 * s8, x1); ld8bf(row + 1024 + h * 128 + 64 + 8 * s8, x2);
#pragma unroll
    for (int e = 0; e < 8; ++e) { *(LAS bf16*)(L + RT_OFF_VT + (8 * s8 + e) * RT_LDT + t * 2) = (bf16)f2bf(x1[e]); *(LAS bf16*)(L + RT_OFF_VT + (64 + 8 * s8 + e) * RT_LDT + t * 2) = (bf16)f2bf(x2[e]); }
}
DI void ret_kv_update(lptr L, f32x16* r, float cdec, int w, int r32, int hh) {
#pragma unroll
    for (int i = 0; i < 2; ++i) { r[i] = r[i] * cdec; mma32<4>(r[i], L + RT_OFF_KT + 32 * (w >> 1) * RT_LDT, RT_LDT, L + RT_OFF_VT + 32 * (2 * (w & 1) + i) * RT_LDT, RT_LDT, r32, hh); }
}
DI void ret_ld_state(const float* S, f32x16* r, int w, int r32, int hh) {
#pragma unroll
    for (int i = 0; i < 2; ++i)
#pragma unroll
        for (int g = 0; g < 16; ++g) r[i][g] = S[(32 * (w >> 1) + crow32(g, hh)) * 128 + 32 * (2 * (w & 1) + i) + r32];
}
DI void ret_st_state(float* S, const f32x16* r, int w, int r32, int hh) {
#pragma unroll
    for (int i = 0; i < 2; ++i)
#pragma unroll
        for (int g = 0; g < 16; ++g) S[(32 * (w >> 1) + crow32(g, hh)) * 128 + 32 * (2 * (w & 1) + i) + r32] = r[i][g];
}
DI void ret_p1_item(const Ctx& F, int kind, int gi, int h) {
    const int lane = F.lane, w = F.wave, r32 = lane & 31, hh = lane >> 5;
    const float cdec = __expf(ret_lg(h) * 64.0f);
    f32x16 r[2];
    int c0, nc;
    if (kind == 0) { c0 = gi * RT_G; nc = RT_G;
#pragma unroll
        for (int i = 0; i < 2; ++i)
#pragma unroll
            for (int g = 0; g < 16; ++g) r[i][g] = 0.f; }
    else { c0 = 256 + gi; nc = 1; ret_ld_state(in_ptr(F, 2) + (size_t)(gi * 4 + h) * 16384, r, w, r32, hh); }
    for (int c = c0; c < c0 + nc; ++c) {
        ret_stage(F, c, h, false);
        __syncthreads();
        ret_kv_update(F.lds, r, cdec, w, r32, hh);
        __syncthreads();
    }
    ret_st_state(kind == 0 ? ((float*)(F.ws + WS_XB + (size_t)NCH * 8 * 4096 * 2)) + (size_t)(gi * 4 + h) * 16384 : (F.out + O_RET_S) + (size_t)(gi * 4 + h) * 16384, r, w, r32, hh);
}
DI void ret_scan(const Ctx& F, int vidx) {
    const int n = 4 * 16384;
    for (int e = vidx * 512 + F.tid; e < n; e += F.G * 512) {
        const int h = e >> 14; const float c4 = __expf(ret_lg(h) * 64.0f * (float)RT_G);
        float acc = 0.f;
#pragma unroll 4
        for (int g = 0; g < RT_NG; ++g) { float* p = ((float*)(F.ws + WS_XB + (size_t)NCH * 8 * 4096 * 2)) + (size_t)g * 65536 + e; acc = acc * c4 + *p; *p = acc; }
        (F.out + O_RET_P)[e] = acc;
    }
}
DI void ret_p3_item(const Ctx& F, int kind, int gi, int h) {
    const int tid = F.tid, lane = F.lane, w = F.wave, r32 = lane & 31, hh = lane >> 5; const lptr L = F.lds;
    const float lg = ret_lg(h), cdec = __expf(lg * 64.0f);
    f32x16 r[2];
    int c0, nc;
    if (kind == 0) { c0 = gi * RT_G; nc = RT_G;
        if (gi == 0) {
#pragma unroll
            for (int i = 0; i < 2; ++i)
#pragma unroll
                for (int g = 0; g < 16; ++g) r[i][g] = 0.f; }
        else ret_ld_state(((float*)(F.ws + WS_XB + (size_t)NCH * 8 * 4096 * 2)) + (size_t)((gi - 1) * 4 + h) * 16384, r, w, r32, hh); }
    else { c0 = 256 + gi; nc = 1; ret_ld_state(in_ptr(F, 2) + (size_t)(gi * 4 + h) * 16384, r, w, r32, hh); }
    for (int c = c0; c < c0 + nc; ++c) {
        ret_stage(F, c, h, true);
#pragma unroll
        for (int i = 0; i < 2; ++i)
#pragma unroll
            for (int g4 = 0; g4 < 4; ++g4) { u32x2 v; v.x = pk2(r[i][4 * g4], r[i][4 * g4 + 1]); v.y = pk2(r[i][4 * g4 + 2], r[i][4 * g4 + 3]);
                *(LAS u32x2*)(L + RT_OFF_RT + (32 * (2 * (w & 1) + i) + r32) * RT_LDR + (32 * (w >> 1) + 8 * g4 + 4 * hh) * 2) = v; }
        __syncthreads();
        if (w < 4) { const int tb = w & 1, kb = w >> 1;
            f32x16 s;
#pragma unroll
            for (int g = 0; g < 16; ++g) s[g] = 0.f;
            if (kb <= tb) mma32<8>(s, L + RT_OFF_Q + 32 * tb * RT_LDQ, RT_LDQ, L + RT_OFF_K + 32 * kb * RT_LDQ, RT_LDQ, r32, hh);
            const int tp = 32 * kb + r32; const float f = __expf(-lg * (float)(tp + 1));
#pragma unroll
            for (int g = 0; g < 16; ++g) { const int tq = 32 * tb + crow32(g, hh); const float pv = tq >= tp ? s[g] * f : 0.f;
                *(LAS bf16*)(L + RT_OFF_P + tq * 144 + tp * 2) = (bf16)f2bf(pv); } }
        __syncthreads();
        const int tb = w & 1, db = w >> 1;
        f32x16 o;
#pragma unroll
        for (int g = 0; g < 16; ++g) o[g] = 0.f;
        mma32<4>(o, L + RT_OFF_P + 32 * tb * 144, 144, L + RT_OFF_VT + 32 * db * RT_LDT, RT_LDT, r32, hh);
        mma32<8>(o, L + RT_OFF_Q + 32 * tb * RT_LDQ, RT_LDQ, L + RT_OFF_RT + 32 * db * RT_LDR, RT_LDR, r32, hh);
        ret_kv_update(L, r, cdec, w, r32, hh);
        __syncthreads();
#pragma unroll
        for (int g = 0; g < 16; ++g) *(LAS float*)(L + RT_OFF_OS + (32 * tb + crow32(g, hh)) * 528 + (32 * db + r32) * 4) = o[g];
        __syncthreads();
        {
            const int t = tid >> 3, s8 = tid & 7;
            float v[16], s = 0.f;
#pragma unroll
            for (int e = 0; e < 16; ++e) { v[e] = *(LAS float*)(L + RT_OFF_OS + t * 528 + (16 * s8 + e) * 4); s += v[e]; }
            s += __shfl_xor(s, 1); s += __shfl_xor(s, 2); s += __shfl_xor(s, 4);
            const float mean = s * (1.0f / 128.0f); float q = 0.f;
#pragma unroll
            for (int e = 0; e < 16; ++e) { v[e] -= mean; q += v[e] * v[e]; }
            q += __shfl_xor(q, 1); q += __shfl_xor(q, 2); q += __shfl_xor(q, 4);
            const float rstd = 1.0f / sqrtf(q * (1.0f / 128.0f) + LN_EPS);
            const bf16* gp = ((bf16*)(F.ws + WS_PROJ)) + (size_t)(c * 64 + t) * N_AB + 1536 + h * 128 + 16 * s8;
            bf16* op = ((bf16*)(F.ws + WS_MIX)) + (size_t)(c * 64 + t) * 1024 + h * 128 + 16 * s8;
#pragma unroll
            for (int q2 = 0; q2 < 2; ++q2) { float gt[8], gn[8], o8[8]; ld8bf(gp + 8 * q2, gt); ld8f(in_ptr(F, 13) + h * 128 + 16 * s8 + 8 * q2, gn);
#pragma unroll
                for (int e = 0; e < 8; ++e) o8[e] = gt[e] / (1.0f + __expf(-gt[e])) * (v[8 * q2 + e] * rstd * gn[e]);
                *(v4u*)(op + 8 * q2) = pack8(o8); }
        }
        __syncthreads();
    }
}
constexpr int CV_OFF_U = 0, CV_OFF_Y = 63488;
DI void conv_item(const Ctx& F, int it) {
    const int tid = F.tid; const lptr L = F.lds;
    const int c = it >> 1, half = it & 1;
    const int seq_t0 = c < 256 ? 0 : c * 64;
    const int ta = c * 64 + 32 * half;
    const int b = c - 256;
    for (int q = tid; q < 62 * 64; q += 512) { const int rr = q >> 6, cg = q & 63, row = ta - 30 + rr;
        float u[8];
        if (row >= seq_t0) { float a[8], g[8]; const bf16* p = ((bf16*)(F.ws + WS_PROJ)) + (size_t)row * N_CD + 8 * cg; ld8bf(p, a); ld8bf(p + 512, g);
#pragma unroll
            for (int e = 0; e < 8; ++e) u[e] = a[e] * sigmoidf_(g[e]); }
        else if (c >= 256) ld8f(in_ptr(F, 5) + ((size_t)b * 30 + (30 + row - seq_t0)) * 512 + 8 * cg, u);
        else {
#pragma unroll
            for (int e = 0; e < 8; ++e) u[e] = 0.f; }
        *(LAS v4u*)(L + CV_OFF_U + rr * 1024 + cg * 16) = pack8(u);
        const int seq_last = c < 256 ? TP - 1 : c * 64 + 63;
        if (row > seq_last - 30 && row >= seq_t0 && ((c == 255 && half == 1) || (c >= 256 && half == 1))) {
            float* dst = (c < 256 ? (F.out + O_CONV_P) : (F.out + O_CONV_S) + (size_t)b * 30 * 512) + (size_t)(row - (seq_last - 29)) * 512 + 8 * cg; st8f(dst, u); }
    }
    __syncthreads();
    {
        const int ch = tid; float wgt[31];
#pragma unroll
        for (int k = 0; k < 31; ++k) wgt[k] = in_ptr(F, 27)[k * 512 + ch];
        const float bias = in_ptr(F, 28)[ch];
        float uv[62];
#pragma unroll
        for (int r = 0; r < 62; ++r) uv[r] = bf2f(*(LAS bf16*)(L + CV_OFF_U + r * 1024 + ch * 2));
#pragma unroll
        for (int t = 0; t < 32; ++t) { float acc = bias;
#pragma unroll
            for (int k = 0; k < 31; ++k) acc += wgt[k] * uv[t + k];
            *(LAS float*)(L + CV_OFF_Y + t * 2048 + ch * 4) = acc; }
    }
    __syncthreads();
    {
        const int t = tid >> 4, sub = tid & 15; f32x4 v[8]; float s = 0.f;
#pragma unroll
        for (int k = 0; k < 8; ++k) { v[k] = *(LAS f32x4*)(L + CV_OFF_Y + t * 2048 + (64 * k + 4 * sub) * 4); s += (v[k][0] + v[k][1]) + (v[k][2] + v[k][3]); }
        s += __shfl_xor(s, 1); s += __shfl_xor(s, 2); s += __shfl_xor(s, 4); s += __shfl_xor(s, 8);
        const float mean = s * (1.0f / 512.0f); float q = 0.f;
#pragma unroll
        for (int k = 0; k < 8; ++k) { v[k] = v[k] - mean; q += (v[k][0] * v[k][0] + v[k][1] * v[k][1]) + (v[k][2] * v[k][2] + v[k][3] * v[k][3]); }
        q += __shfl_xor(q, 1); q += __shfl_xor(q, 2); q += __shfl_xor(q, 4); q += __shfl_xor(q, 8);
        const float rstd = 1.0f / sqrtf(q * (1.0f / 512.0f) + LN_EPS);
        bf16* op = ((bf16*)(F.ws + WS_MIX)) + (size_t)(ta + t) * 1024;
#pragma unroll
        for (int k = 0; k < 8; ++k) { const int ch = 64 * k + 4 * sub; const f32x4 g = *(const f32x4*)(in_ptr(F, 29) + ch), bb = *(const f32x4*)(in_ptr(F, 30) + ch);
            f32x4 o;
#pragma unroll
            for (int e = 0; e < 4; ++e) { const float z = v[k][e] * rstd * g[e] + bb[e]; o[e] = z / (1.0f + __expf(-z)); }
            *(u32x2*)(op + ch) = pack4(o); }
    }
    __syncthreads();
}

constexpr int AT_OFF_K = 0, AT_OFF_VT = 27648, AT_OFF_TBL = 53248, AT_LDK = 144, AT_LDV = 400;
DI void attn_item(const Ctx& F, int c, int kh) {
    const int tid = F.tid, lane = F.lane, w = F.wave, r32 = lane & 31, hh = lane >> 5; const lptr L = F.lds;
    const int b = c - 256;
    const int row0 = c * 64 - 128;
    const int kvalid0 = c >= 256 ? 0 : (c == 0 ? 128 : (c == 1 ? 64 : 0));
    const bool last = (c == 255) || (c >= 256);
    for (int q = tid; q < 192 * 8; q += 512) { const int key = q >> 3, e = q & 7; const int pos = c >= 256 ? PAST_POS + (key - 128) : row0 + key;
        float cs, sn; rope_cs(((double*)(F.ws + WS_ROPE))[64 + e], pos, cs, sn); *(LAS f32x2*)(L + AT_OFF_TBL + q * 8) = (f32x2){cs, sn}; }
    __syncthreads();
    for (int q = tid; q < 192 * 8; q += 512) { const int key = q >> 3, s8 = q & 7;
        float kx[8], vx[8];
        if (c >= 256 && key < 128) { ld8f(in_ptr(F, 6) + (((size_t)b * 128 + key) * 2 + kh) * 64 + 8 * s8, kx); ld8f(in_ptr(F, 7) + (((size_t)b * 128 + key) * 2 + kh) * 64 + 8 * s8, vx); }
        else if (key < kvalid0) {
#pragma unroll
            for (int e = 0; e < 8; ++e) { kx[e] = 0.f; vx[e] = 0.f; } }
        else { const int row = c >= 256 ? c * 64 + (key - 128) : row0 + key; const bf16* p = ((bf16*)(F.ws + WS_PROJ)) + (size_t)row * N_CD;
            ld8bf(p + 1536 + kh * 64 + 8 * s8, kx); ld8bf(p + 1664 + kh * 64 + 8 * s8, vx);
            if (s8 < 2) {
                float px[8]; ld8bf(p + 1536 + kh * 64 + 8 * (s8 ^ 1), px);
#pragma unroll
                for (int e = 0; e < 8; ++e) { const f32x2 t2 = *(const LAS f32x2*)(L + AT_OFF_TBL + (key * 8 + e) * 8); const float cs = t2[0], sn = t2[1]; kx[e] = s8 == 0 ? kx[e] * cs - px[e] * sn : px[e] * sn + kx[e] * cs; }
            } }
        *(LAS v4u*)(L + AT_OFF_K + key * AT_LDK + s8 * 16) = pack8(kx);
#pragma unroll
        for (int e = 0; e < 8; ++e) *(LAS bf16*)(L + AT_OFF_VT + (8 * s8 + e) * AT_LDV + key * 2) = (bf16)f2bf(vx[e]);
        if (last && key >= 64) { float* kd = (c == 255 ? (F.out + O_K_P) : (F.out + O_K_S) + (size_t)b * 16384) + ((size_t)(key - 64) * 2 + kh) * 64 + 8 * s8;
            float* vd = (c == 255 ? (F.out + O_V_P) : (F.out + O_V_S) + (size_t)b * 16384) + ((size_t)(key - 64) * 2 + kh) * 64 + 8 * s8; st8f(kd, kx); st8f(vd, vx); }
    }
    const int hq = 4 * kh + (w >> 1), qrow = c * 64 + 32 * (w & 1) + r32;
    bf16x8 qf[4];
    { const bf16* qp = ((bf16*)(F.ws + WS_PROJ)) + (size_t)qrow * N_CD + 1024 + hq * 64;
#pragma unroll
        for (int s = 0; s < 4; ++s) { float x[8]; ld8bf(qp + 16 * s + 8 * hh, x);
            if (s == 0) { float px[8]; ld8bf(qp + 8 * (hh ^ 1), px);
#pragma unroll
                for (int e = 0; e < 8; ++e) { const f32x2 t2 = *(const LAS f32x2*)(L + AT_OFF_TBL + ((128 + 32 * (w & 1) + r32) * 8 + e) * 8); const float cs = t2[0], sn = t2[1]; x[e] = hh == 0 ? x[e] * cs - px[e] * sn : px[e] * sn + x[e] * cs; } }
            const v4u pk = pack8(x); qf[s] = __builtin_bit_cast(bf16x8, pk); } }
    __syncthreads();
    f32x16 x[6];
#pragma unroll
    for (int kb = 0; kb < 6; ++kb) {
#pragma unroll
        for (int g = 0; g < 16; ++g) x[kb][g] = 0.f;
#pragma unroll
        for (int s = 0; s < 4; ++s) { const bf16x8 a = *(const LAS bf16x8*)(L + AT_OFF_K + (32 * kb + r32) * AT_LDK + (16 * s + 8 * hh) * 2);
            x[kb] = __builtin_amdgcn_mfma_f32_32x32x16_bf16(a, qf[s], x[kb], 0, 0, 0); }
        __builtin_amdgcn_sched_barrier(0); }
    const float sink = in_ptr(F, 31)[hq];
    float m = sink;
#pragma unroll
    for (int kb = 0; kb < 6; ++kb)
#pragma unroll
        for (int g = 0; g < 16; ++g) { float sv = x[kb][g] * 0.125f; if (32 * kb < kvalid0) sv = -1e30f; x[kb][g] = sv; m = fmaxf(m, sv); }
    m = fmaxf(m, __shfl_xor(m, 32));
    float den = 0.f;
#pragma unroll
    for (int kb = 0; kb < 6; ++kb)
#pragma unroll
        for (int g = 0; g < 16; ++g) { const float e = __expf(x[kb][g] - m); x[kb][g] = e; den += e; }
    den += __shfl_xor(den, 32);
    den += __expf(sink - m);
    const float rden = 1.0f / den;
#pragma unroll
    for (int kb = 0; kb < 6; ++kb)
#pragma unroll
        for (int g = 0; g < 16; ++g) x[kb][g] *= rden;
    bf16* op = ((bf16*)(F.ws + WS_MIX)) + (size_t)(c * 64 + 32 * (w & 1)) * 1024 + 512 + hq * 64;
#pragma unroll
    for (int db = 0; db < 2; ++db) {
        f32x16 o;
#pragma unroll
        for (int g = 0; g < 16; ++g) o[g] = 0.f;
#pragma unroll
        for (int kb = 0; kb < 6; ++kb)
#pragma unroll
            for (int s = 0; s < 2; ++s) {
                float pv[8];
#pragma unroll
                for (int j = 0; j < 8; ++j) pv[j] = x[kb][8 * s + j];
                const v4u pk = pack8(pv); const bf16x8 pa = __builtin_bit_cast(bf16x8, pk);
                const lptr vp = L + AT_OFF_VT + (32 * db + r32) * AT_LDV + (32 * kb + 16 * s + 4 * hh) * 2;
                const u32x2 lo = *(const LAS u32x2*)vp, hi = *(const LAS u32x2*)(vp + 16);
                v4u bv; bv.x = lo.x; bv.y = lo.y; bv.z = hi.x; bv.w = hi.y;
                o = __builtin_amdgcn_mfma_f32_32x32x16_bf16(pa, __builtin_bit_cast(bf16x8, bv), o, 0, 0, 0);
                __builtin_amdgcn_sched_barrier(0); }
#pragma unroll
        for (int g = 0; g < 16; ++g) op[(size_t)crow32(g, hh) * 1024 + 32 * db + r32] = (bf16)f2bf(o[g]);
    }
    __syncthreads();
}
DI float wave_sum(float v) {
#pragma unroll
    for (int o = 1; o < 64; o <<= 1) v += __shfl_xor(v, o);
    return v;
}
DI void p0_transpose_item(const float* W, int K, int N, bf16* WT, int k0, int n0, int dst_row0, const float* gk, LAS float* scr, int lane) {
    {   const int kr = lane >> 3, n4 = (lane & 7) * 4; f32x4 v[8];
#pragma unroll
        for (int i = 0; i < 8; ++i) v[i] = *(const GAS f32x4*)(W + (size_t)(k0 + kr + 8 * i) * N + n0 + n4);
#pragma unroll
        for (int i = 0; i < 8; ++i) { const int kk = kr + 8 * i; const float g = gk ? gk[k0 + kk] : 1.0f;
#pragma unroll
            for (int e = 0; e < 4; ++e) scr[kk * 33 + n4 + e] = v[i][e] * g; } }
    LDS_WAIT(); asm volatile("" ::: "memory");
    const int c = lane & 7;
#pragma unroll
    for (int j = 0; j < 4; ++j) { const int n = (lane >> 3) + 8 * j; const LAS float* s = scr + (8 * c) * 33 + n;
        v4u o; o.x = pk2(s[0 * 33], s[1 * 33]); o.y = pk2(s[2 * 33], s[3 * 33]); o.z = pk2(s[4 * 33], s[5 * 33]); o.w = pk2(s[6 * 33], s[7 * 33]);
        *(GAS v4u*)(WT + (size_t)(dst_row0 + n) * K + k0 + 8 * c) = o; }
    LDS_WAIT(); asm volatile("" ::: "memory");
}
DI void p0_prologue(const Ctx& F) {
    LAS float* scr = (LAS float*)(F.lds + F.wave * 16384);
    const int gw = F.vcu * NWAVES + F.wave, NGW = F.G * NWAVES, lane = F.lane;
    if (F.vcu == 0 && F.tid < 72) { const int j = F.tid < 64 ? F.tid : F.tid - 64;
        ((double*)(F.ws + WS_ROPE))[F.tid] = F.tid < 64 ? exp((double)j * (-2.0 * log(10000.0) / 128.0)) : exp((double)j * (-2.0 * log(500000.0) / 16.0)); }
    constexpr int I_INAB = 16 * (N_AB / 32), I_SQ = 16 * 32, I_INCD = 16 * (N_CD / 32), I_GU = 16 * (D_FF / 32), I_DN = (D_FF / 64) * 32;
    constexpr int NITEMS = I_INAB + 2 * I_SQ + I_INCD + 4 * I_GU + 2 * I_DN;
    for (int it = gw; it < NITEMS; it += NGW) {
        int r = it;
        if (r < I_INAB) { const int nb = N_AB / 32; p0_transpose_item(in_ptr(F, 11), 1024, N_AB, ((bf16*)(F.ws + WS_W_INAB)), 64 * (r / nb), 32 * (r % nb), 32 * (r % nb), in_ptr(F, 8), scr, lane); continue; } r -= I_INAB;
        if (r < I_SQ) { p0_transpose_item(in_ptr(F, 12), 1024, 1024, ((bf16*)(F.ws + WS_W_OUTAB)), 64 * (r / 32), 32 * (r % 32), 32 * (r % 32), nullptr, scr, lane); continue; } r -= I_SQ;
        if (r < I_INCD) { const int nb = N_CD / 32; p0_transpose_item(in_ptr(F, 25), 1024, N_CD, ((bf16*)(F.ws + WS_W_INCD)), 64 * (r / nb), 32 * (r % nb), 32 * (r % nb), in_ptr(F, 8) + 1024, scr, lane); continue; } r -= I_INCD;
        if (r < I_SQ) { p0_transpose_item(in_ptr(F, 26), 1024, 1024, ((bf16*)(F.ws + WS_W_OUTCD)), 64 * (r / 32), 32 * (r % 32), 32 * (r % 32), nullptr, scr, lane); continue; } r -= I_SQ;
        if (r < 4 * I_GU) { const int which = r / I_GU, l = which >> 1, up = which & 1, q = r % I_GU, nb = D_FF / 32, n0 = 32 * (q % nb);
            p0_transpose_item((up ? in_ptr(F, 33) : in_ptr(F, 32)) + (size_t)l * 1024 * D_FF, 1024, D_FF, ((bf16*)(F.ws + WS_W_GU)) + (size_t)l * N_GU * 1024, 64 * (q / nb), n0, 256 * (n0 >> 7) + 128 * up + (n0 & 127), in_ptr(F, 9) + l * 1024, scr, lane); continue; } r -= 4 * I_GU;
        { const int l = r / I_DN, q = r % I_DN; p0_transpose_item(in_ptr(F, 34) + (size_t)l * D_FF * 1024, D_FF, 1024, ((bf16*)(F.ws + WS_W_DN)) + (size_t)l * 1024 * D_FF, 64 * (q / 32), 32 * (q % 32), 32 * (q % 32), nullptr, scr, lane); }
    }
    for (int m = gw; m < T_ALL; m += NGW) {
        const float* xrow = m < TP ? in_ptr(F, 0) + (size_t)m * 1024 : in_ptr(F, 1) + (size_t)(m - TP) * 1024;
        const GAS f32x4* xr = (const GAS f32x4*)xrow + lane; f32x4 v[4]; float s = 0.f;
#pragma unroll
        for (int j = 0; j < 4; ++j) { v[j] = xr[64 * j]; s += (v[j][0] * v[j][0] + v[j][1] * v[j][1]) + (v[j][2] * v[j][2] + v[j][3] * v[j][3]); }
        s = wave_sum(s);
        GAS unsigned long long* o8 = (GAS unsigned long long*)(((bf16*)(F.ws + WS_XB)) + (size_t)m * 1024) + lane;
#pragma unroll
        for (int j = 0; j < 4; ++j) o8[64 * j] = (unsigned long long)pk2(v[j][0], v[j][1]) | ((unsigned long long)pk2(v[j][2], v[j][3]) << 32);
        if (lane < 16) ((float*)(F.ws + WS_SS))[(size_t)m * 16 + lane] = lane == 0 ? s : 0.f;
    }
}
DI void final_norm(const Ctx& F) {
    const int gw = F.vcu * NWAVES + F.wave, NGW = F.G * NWAVES, lane = F.lane;
    for (int m = gw; m < T_ALL; m += NGW) {
        const float rs = pg8::row_rstd(((float*)(F.ws + WS_SS)), m);
        GAS f32x4* xr = (GAS f32x4*)((F.out + O_Y) + (size_t)m * 1024) + lane; const f32x4* gp = (const f32x4*)in_ptr(F, 10) + lane;
#pragma unroll
        for (int j = 0; j < 4; ++j) { const f32x4 v = xr[64 * j], g = gp[64 * j]; xr[64 * j] = v * rs * g; }
    }
}

constexpr int N_PHASES = 16;
struct Args { const float* in[35]; float* out; unsigned char* ws; int ph_lo, ph_hi, li, pad; };
__global__ void __launch_bounds__(NWAVES * 64, 2) hybrid_fwd(Args args) {
    extern __shared__ __attribute__((aligned(16))) unsigned char lds_raw[];
    Ctx F;
    F.lds = (lptr)lds_raw;
    volatile LAS unsigned* MISC = (volatile LAS unsigned*)(F.lds + MISC_OFF);
    F.tid = threadIdx.x; F.lane = F.tid & 63; F.wave = __builtin_amdgcn_readfirstlane(F.tid >> 6);
    F.G = gridDim.x; { const int bx = blockIdx.x; F.vcu = (F.G % 8 == 0) ? (bx % 8) * (F.G / 8) + bx / 8 : bx; }
    unsigned char* ws = args.ws;
    F.out = args.out; F.ws = args.ws;
    for (int u = F.tid; u < (LDS_BYTES - RING_BYTES) / 4; u += NWAVES * 64) ((LAS unsigned*)(F.lds + RING_BYTES))[u] = 0u;
    __syncthreads();
    XcdBarrier bar = xcd_barrier_post((unsigned*)(ws + WS_CTL) + 1024 + args.li * XCD_BAR_WORDS, MISC + 8);
    const int lo = args.ph_lo, hi = args.ph_hi, G = F.G, vcu = F.vcu;
#ifndef PH_MASK
#define PH_MASK 0xFFFF
#endif
#define IN(k) (((PH_MASK >> (k)) & 1) && lo <= (k) && (k) < hi)
#ifndef PROBE_LO
#define PROBE_LO -1
#define PROBE_HI -1
#endif
    unsigned long long pr_t0 = 0, pr_dt = 0; F.pr = &pr_dt;
#define SEAM(k) do { if (IN(k) && IN((k) + 1)) xcd_barrier(bar); \
        if ((k) + 1 == PROBE_LO) pr_t0 = __builtin_amdgcn_s_memrealtime(); if ((k) == PROBE_HI) pr_dt = __builtin_amdgcn_s_memrealtime() - pr_t0; } while (0)
    if (PROBE_LO == 0) pr_t0 = __builtin_amdgcn_s_memrealtime();
    typedef pg8::bf16_t gb;
    if (IN(0)) { p0_prologue(F); } SEAM(0);
    if (IN(1)) { pg8::Gemm g{(const gb*)((bf16*)(F.ws + WS_XB)), (const gb*)((bf16*)(F.ws + WS_W_INAB)), T_ALL, N_AB, 1024}; pg8::StaticOrder S; S.init(T_ALL, N_AB, G, (int)blockIdx.x);
        pg8::EpiNormBf16 E{(gb*)((bf16*)(F.ws + WS_PROJ)), N_AB, ((float*)(F.ws + WS_SS))}; pg8::gemm_phase<pg8::EpiNormBf16, pg8::StaticOrder, true, true>(F.lds, g, S, E); } SEAM(1);
    if (IN(2)) {
        for (int it = vcu; it < 320; it += G) { if (it < 256) ret_p1_item(F, 0, it >> 2, it & 3); else ret_p1_item(F, 1, (it - 256) >> 2, it & 3); }
        for (int it = (vcu + G - (64 % G)) % G; it < NCH * 8; it += G) rwkv_p1_item(F, it >> 3, it & 7);
    } SEAM(2);
    if (IN(3)) { for (int it = vcu; it < 128; it += G) rwkv_l1_item(F, it & 15, it >> 4);
        ret_scan(F, (vcu + G - (128 % G)) % G); } SEAM(3);
    if (IN(4)) { for (int it = vcu; it < 8; it += G) rwkv_l2_item(F, it);
        for (int it = (vcu + G - (8 % G)) % G; it < 320; it += G) { if (it < 256) ret_p3_item(F, 0, it >> 2, it & 3); else ret_p3_item(F, 1, (it - 256) >> 2, it & 3); } } SEAM(4);
    if (IN(5)) { for (int it = vcu; it < 256; it += G) { if (it < 128) rwkv_l3_item(F, 0, it & 15, it >> 4); else rwkv_l3_item(F, 1, (it - 128) >> 3, it & 7); } } SEAM(5);
    if (IN(6)) { for (int it = vcu; it < NCH * 8; it += G) rwkv_p3_item(F, it >> 3, it & 7); } SEAM(6);
    if (IN(7)) {
        { const pg8::ResidOp<0, false> rs{in_ptr(F, 1), TP, nullptr, (gb*)((bf16*)(F.ws + WS_XB))}; for (int tl = vcu; tl < 256; tl += G) gemm_small64(F, ((bf16*)(F.ws + WS_MIX)), ((bf16*)(F.ws + WS_W_OUTAB)), 1024, tl, rs, ((float*)(F.ws + WS_SS))); }
        pg8::Gemm g{(const gb*)((bf16*)(F.ws + WS_MIX)), (const gb*)((bf16*)(F.ws + WS_W_OUTAB)), TP, 1024, 1024}; pg8::StaticOrder S; S.init(TP, 1024, G, (int)blockIdx.x);
        pg8::EpiResid<0, false> E{{in_ptr(F, 0), 0, nullptr, (gb*)((bf16*)(F.ws + WS_XB))}, ((float*)(F.ws + WS_SS))}; pg8::gemm_phase<pg8::EpiResid<0, false>, pg8::StaticOrder, true, true>(F.lds, g, S, E); } SEAM(7);
    if (IN(8)) { pg8::Gemm g{(const gb*)((bf16*)(F.ws + WS_XB)), (const gb*)((bf16*)(F.ws + WS_W_GU)), T_ALL, N_GU, 1024}; pg8::StaticOrder S; S.init(T_ALL, N_GU, G, (int)blockIdx.x);
        pg8::EpiSwiGLU E{(gb*)((bf16*)(F.ws + WS_PROJ)), D_FF, ((float*)(F.ws + WS_SS))}; pg8::gemm_phase<pg8::EpiSwiGLU, pg8::StaticOrder, true, true>(F.lds, g, S, E); } SEAM(8);
    if (IN(9)) {
        { const pg8::ResidOp<1, false> rs{nullptr, 0, nullptr, (gb*)((bf16*)(F.ws + WS_XB))}; for (int tl = vcu; tl < 256; tl += G) gemm_small64(F, ((bf16*)(F.ws + WS_PROJ)), ((bf16*)(F.ws + WS_W_DN)), D_FF, tl, rs, ((float*)(F.ws + WS_SS))); }
        pg8::Gemm g{(const gb*)((bf16*)(F.ws + WS_PROJ)), (const gb*)((bf16*)(F.ws + WS_W_DN)), TP, 1024, D_FF}; pg8::StaticOrder S; S.init(TP, 1024, G, (int)blockIdx.x);
        pg8::EpiResid<1, false> E{{nullptr, 0, nullptr, (gb*)((bf16*)(F.ws + WS_XB))}, ((float*)(F.ws + WS_SS))}; pg8::gemm_phase<pg8::EpiResid<1, false>, pg8::StaticOrder, true, true>(F.lds, g, S, E); } SEAM(9);
    if (IN(10)) { pg8::Gemm g{(const gb*)((bf16*)(F.ws + WS_XB)), (const gb*)((bf16*)(F.ws + WS_W_INCD)), T_ALL, N_CD, 1024}; pg8::StaticOrder S; S.init(T_ALL, N_CD, G, (int)blockIdx.x);
        pg8::EpiNormBf16 E{(gb*)((bf16*)(F.ws + WS_PROJ)), N_CD, ((float*)(F.ws + WS_SS))}; pg8::gemm_phase<pg8::EpiNormBf16, pg8::StaticOrder, true, true>(F.lds, g, S, E); } SEAM(10);
    if (IN(11)) {
        for (int it = vcu; it < 544; it += G) attn_item(F, it >> 1, it & 1);
        for (int it = (vcu + G - (32 % G)) % G; it < 544; it += G) conv_item(F, it);
    } SEAM(11);
    if (IN(12)) {
        { const pg8::ResidOp<1, false> rs{nullptr, 0, nullptr, (gb*)((bf16*)(F.ws + WS_XB))}; for (int tl = vcu; tl < 256; tl += G) gemm_small64(F, ((bf16*)(F.ws + WS_MIX)), ((bf16*)(F.ws + WS_W_OUTCD)), 1024, tl, rs, ((float*)(F.ws + WS_SS))); }
        pg8::Gemm g{(const gb*)((bf16*)(F.ws + WS_MIX)), (const gb*)((bf16*)(F.ws + WS_W_OUTCD)), TP, 1024, 1024}; pg8::StaticOrder S; S.init(TP, 1024, G, (int)blockIdx.x);
        pg8::EpiResid<1, false> E{{nullptr, 0, nullptr, (gb*)((bf16*)(F.ws + WS_XB))}, ((float*)(F.ws + WS_SS))}; pg8::gemm_phase<pg8::EpiResid<1, false>, pg8::StaticOrder, true, true>(F.lds, g, S, E); } SEAM(12);
    if (IN(13)) { pg8::Gemm g{(const gb*)((bf16*)(F.ws + WS_XB)), (const gb*)(((bf16*)(F.ws + WS_W_GU)) + (size_t)N_GU * 1024), T_ALL, N_GU, 1024}; pg8::StaticOrder S; S.init(T_ALL, N_GU, G, (int)blockIdx.x);
        pg8::EpiSwiGLU E{(gb*)((bf16*)(F.ws + WS_PROJ)), D_FF, ((float*)(F.ws + WS_SS))}; pg8::gemm_phase<pg8::EpiSwiGLU, pg8::StaticOrder, true, true>(F.lds, g, S, E); } SEAM(13);
    if (IN(14)) {
        { const pg8::ResidOp<1, true> rs{nullptr, 0, (F.out + O_Y), (gb*)((bf16*)(F.ws + WS_XB))}; for (int tl = vcu; tl < 256; tl += G) gemm_small64(F, ((bf16*)(F.ws + WS_PROJ)), (((bf16*)(F.ws + WS_W_DN)) + (size_t)1024 * D_FF), D_FF, tl, rs, ((float*)(F.ws + WS_SS))); }
        pg8::Gemm g{(const gb*)((bf16*)(F.ws + WS_PROJ)), (const gb*)(((bf16*)(F.ws + WS_W_DN)) + (size_t)1024 * D_FF), TP, 1024, D_FF}; pg8::StaticOrder S; S.init(TP, 1024, G, (int)blockIdx.x);
        pg8::EpiResid<1, true> E{{nullptr, 0, (F.out + O_Y), (gb*)((bf16*)(F.ws + WS_XB))}, ((float*)(F.ws + WS_SS))}; pg8::gemm_phase<pg8::EpiResid<1, true>, pg8::StaticOrder, true, true>(F.lds, g, S, E); } SEAM(14);
    if (IN(15)) final_norm(F);
    if (PROBE_HI == 15) { asm volatile("s_waitcnt vmcnt(0)" ::: "memory"); pr_dt = __builtin_amdgcn_s_memrealtime() - pr_t0; }
    if ((PROBE_LO >= 0 || PROBE_SUB >= 0) && blockIdx.x == 0) { const unsigned long long t1 = __builtin_amdgcn_s_memrealtime(); while (__builtin_amdgcn_s_memrealtime() - t1 < pr_dt) __builtin_amdgcn_s_sleep(8); }
#undef IN
#undef SEAM
}

#ifndef MK_SPLIT
#define MK_SPLIT 0
#endif
extern "C" void kernel_launch(void* const* d_in, const int* in_sizes, int n_in, void* d_out, int out_size, void* d_ws, size_t ws_size, hipStream_t stream) {
    static int grid = 0;
    if (grid == 0) {
        if (n_in != 35 || out_size != (int)O_END || ws_size < WS_END) { fprintf(stderr, "kernel_launch: unexpected shapes: n_in %d out %d ws %zu\n", n_in, out_size, ws_size); grid = -1; return; }
        int dev = 0, cus = 0, per_cu = 0;
        if (hipGetDevice(&dev) != hipSuccess || hipDeviceGetAttribute(&cus, hipDeviceAttributeMultiprocessorCount, dev) != hipSuccess) { grid = -1; return; }
        if (hipFuncSetAttribute((const void*)hybrid_fwd, hipFuncAttributeMaxDynamicSharedMemorySize, LDS_BYTES) != hipSuccess) { fprintf(stderr, "kernel_launch: hipFuncSetAttribute failed\n"); grid = -1; return; }
        if (hipOccupancyMaxActiveBlocksPerMultiprocessor(&per_cu, (const void*)hybrid_fwd, NWAVES * 64, LDS_BYTES) != hipSuccess || per_cu < 1) { fprintf(stderr, "kernel_launch: occupancy query says %d blocks per CU; nothing launched\n", per_cu); (void)hipGetLastError(); grid = -1; return; }
        grid = cus;
    }
    if (grid < 0) return;
    (void)hipMemsetAsync((char*)d_ws + WS_CTL, 0, CTL_ZERO_BYTES, stream);
    Args a{};
    for (int i = 0; i < 35; ++i) a.in[i] = (const float*)d_in[i];
    a.out = (float*)d_out; a.ws = (unsigned char*)d_ws;
#if MK_SPLIT
    for (int p = 0; p < N_PHASES; ++p) { a.ph_lo = p; a.ph_hi = p + 1; a.li = 0; hipLaunchKernelGGL(hybrid_fwd, dim3(grid), dim3(NWAVES * 64), LDS_BYTES, stream, a); }
#else
    a.ph_lo = 0; a.ph_hi = N_PHASES; a.li = 0;
    hipLaunchKernelGGL(hybrid_fwd, dim3(grid), dim3(NWAVES * 64), LDS_BYTES, stream, a);
#endif
}
```

```cpp
#include <hip/hip_runtime.h>
#include <cstdio>
#include <cstdint>
#include <cmath>

constexpr int D_MODEL = 1024, TP = 16384, NSAMP = 16, LS = 64, T_ALL = TP + NSAMP * LS;
constexpr int NCH = T_ALL / 64;
constexpr int N_AB = 3840, N_CD = 1792, D_FF = 2816, N_GU = 2 * D_FF;
constexpr int PAST_POS = 4096;
constexpr int RWKV_PROJ = 1792, RW_OFF = 2048;
constexpr float RMS_EPS = 1e-6f, LN_EPS = 1e-5f, RWKV_LN_EPS = 64e-5f;
namespace pg8 {
#define PG8_LAS __attribute__((address_space(3)))
typedef unsigned short bf16_t;
typedef short bf16x8 __attribute__((ext_vector_type(8)));
typedef float f32x4 __attribute__((ext_vector_type(4)));
typedef unsigned u32x4 __attribute__((ext_vector_type(4)));
constexpr int BM = 256, BK = 64, HALF = 128, HTB = HALF * BK * 2  , STAGE_BYTES = 8 * HTB, NXCD = 8, WGM = 8;

__host__ __device__ __forceinline__ int lds_byte(int r, int c) { const int st = (r >> 4) * 2 + (c >> 5), rr = r & 15, cc = c & 31, ob = rr * 64 + cc * 2; return st * 1024 + (ob ^ (((ob >> 9) & 1) << 5)); }
__host__ __device__ __forceinline__ void stage_rc(int b, int& R, int& C) { const int st = b / 1024, sb = b % 1024, swz = sb ^ (((sb >> 9) & 1) << 5); R = (st >> 1) * 16 + swz / 64; C = (st & 1) * 32 + (swz % 64) / 2; }
__host__ __device__ __forceinline__ int perm32(int rho) { const int n = rho >> 4, i = rho & 15; return 8 * (i >> 2) + 4 * n + (i & 3); }

struct Unit { int pm, pn; };
struct Gemm { const bf16_t* A; const bf16_t* Bt; int M, N, K; };

struct StaticOrder {
    int nM, nN, nwg, G, c;
    __host__ __device__ void init(int M, int N, int G_, int c_) { nM = M / BM; nN = N / BM; nwg = nM * nN; G = G_; c = c_; }
    __host__ __device__ bool next(int i, Unit& u) const {
        const long L = (long)i * G + c; if (L >= nwg) return false;
        int wgid = (int)L; { const int q = nwg / NXCD, r = nwg % NXCD, xcd = wgid % NXCD, off = wgid / NXCD; wgid = (xcd < r ? xcd * (q + 1) : r * (q + 1) + (xcd - r) * q) + off; }
        const int nig = WGM * nN, gid = wgid / nig, fm = gid * WGM, gsz = (nM - fm) < WGM ? (nM - fm) : WGM;
        u.pm = fm + ((wgid % nig) % gsz); u.pn = (wgid % nig) / gsz; return true;
    }
    __device__ __forceinline__ void a_ready(const Unit&) const {}
    __device__ __forceinline__ void done(const Unit&) const {}
};

__device__ __forceinline__ unsigned cvt_pk_bf16(float lo, float hi) { unsigned r; asm volatile("v_cvt_pk_bf16_f32 %0, %1, %2" : "=v"(r) : "v"(lo), "v"(hi)); return r; }
__device__ __forceinline__ float row_rstd(const float* SS, int row) {
    const f32x4* p = (const f32x4*)(SS + (size_t)row * 16);
    const f32x4 a = p[0], b = p[1], c = p[2], d = p[3];
    const float s = (((a[0] + a[1]) + (a[2] + a[3])) + ((b[0] + b[1]) + (b[2] + b[3]))) + (((c[0] + c[1]) + (c[2] + c[3])) + ((d[0] + d[1]) + (d[2] + d[3])));
    return 1.0f / sqrtf(s * (1.0f / 1024.0f) + 1e-6f);
}
struct EpiNormBf16 {
    static constexpr bool PERM = true, AFTER_DRAIN = false;
    bf16_t* O; int ldc; const float* SS;
    __device__ __forceinline__ void operator()(const f32x4 (&acc)[2][2][4][2], const Unit& u, int wr, int wc, int fr, int fq) const {
        const int row0 = u.pm * BM + wr * 64 + fr, col0 = u.pn * BM + wc * 32 + 8 * fq;
#pragma unroll
        for (int ai = 0; ai < 2; ++ai)
#pragma unroll
            for (int m = 0; m < 4; ++m) { const int row = row0 + ai * HALF + m * 16; const float rs = row_rstd(SS, row); bf16_t* rowp = O + (size_t)row * ldc + col0;
#pragma unroll
                for (int bj = 0; bj < 2; ++bj) { const f32x4 v0 = acc[ai][bj][m][0] * rs, v1 = acc[ai][bj][m][1] * rs;
                    u32x4 w; w.x = cvt_pk_bf16(v0[0], v0[1]); w.y = cvt_pk_bf16(v0[2], v0[3]); w.z = cvt_pk_bf16(v1[0], v1[1]); w.w = cvt_pk_bf16(v1[2], v1[3]);
                    *(u32x4*)(rowp + bj * HALF) = w; } }
    }
};
template <int RES, bool OUT32> struct ResidOp {
    const float* res32; int res_row0;
    float* X; bf16_t* XB;
    __device__ __forceinline__ float operator()(int row, int col, f32x4 v0, f32x4 v1) const {
        if (RES == 0) { const float* rp = res32 + (size_t)(row - res_row0) * 1024 + col; v0 = v0 + *(const f32x4*)rp; v1 = v1 + *(const f32x4*)(rp + 4); }
        else { const u32x4 w = *(const u32x4*)(XB + (size_t)row * 1024 + col);
            v0 = v0 + (f32x4){__builtin_bit_cast(float, w.x << 16), __builtin_bit_cast(float, w.x & 0xffff0000u), __builtin_bit_cast(float, w.y << 16), __builtin_bit_cast(float, w.y & 0xffff0000u)};
            v1 = v1 + (f32x4){__builtin_bit_cast(float, w.z << 16), __builtin_bit_cast(float, w.z & 0xffff0000u), __builtin_bit_cast(float, w.w << 16), __builtin_bit_cast(float, w.w & 0xffff0000u)}; }
        if (OUT32) { float* xp = X + (size_t)row * 1024 + col; *(f32x4*)xp = v0; *(f32x4*)(xp + 4) = v1; }
        else { u32x4 w; w.x = cvt_pk_bf16(v0[0], v0[1]); w.y = cvt_pk_bf16(v0[2], v0[3]); w.z = cvt_pk_bf16(v1[0], v1[1]); w.w = cvt_pk_bf16(v1[2], v1[3]); *(u32x4*)(XB + (size_t)row * 1024 + col) = w; }
        return ((v0[0] * v0[0] + v0[1] * v0[1]) + (v0[2] * v0[2] + v0[3] * v0[3])) + ((v1[0] * v1[0] + v1[1] * v1[1]) + (v1[2] * v1[2] + v1[3] * v1[3]));
    }
};
template <int RES, bool OUT32> struct EpiResid {
    static constexpr bool PERM = true, AFTER_DRAIN = false;
    ResidOp<RES, OUT32> op; float* SS;
    __device__ __forceinline__ void operator()(const f32x4 (&acc)[2][2][4][2], const Unit& u, int wr, int wc, int fr, int fq) const {
        const int row0 = u.pm * BM + wr * 64 + fr, col0 = u.pn * BM + wc * 32 + 8 * fq;
#pragma unroll
        for (int ai = 0; ai < 2; ++ai)
#pragma unroll
            for (int m = 0; m < 4; ++m) { const int row = row0 + ai * HALF + m * 16; float ssq = 0.f;
#pragma unroll
                for (int bj = 0; bj < 2; ++bj) ssq += op(row, col0 + bj * HALF, acc[ai][bj][m][0], acc[ai][bj][m][1]);
                ssq += __shfl_xor(ssq, 16); ssq += __shfl_xor(ssq, 32);
                if (fq == 0) SS[(size_t)row * 16 + u.pn * 4 + wc] = ssq; }
    }
};
struct EpiSwiGLU {
    static constexpr bool PERM = true, AFTER_DRAIN = false;
    bf16_t* O; int ldc; const float* SS;
    __device__ __forceinline__ void operator()(const f32x4 (&acc)[2][2][4][2], const Unit& u, int wr, int wc, int fr, int fq) const {
        const int row0 = u.pm * BM + wr * 64 + fr, col0 = u.pn * HALF + wc * 32 + 8 * fq;
#pragma unroll
        for (int ai = 0; ai < 2; ++ai)
#pragma unroll
            for (int m = 0; m < 4; ++m) { const int row = row0 + ai * HALF + m * 16; const float rs = row_rstd(SS, row);
                float o[8];
#pragma unroll
                for (int n = 0; n < 2; ++n)
#pragma unroll
                    for (int e = 0; e < 4; ++e) { const float g = acc[ai][0][m][n][e] * rs, up = acc[ai][1][m][n][e] * rs; o[4 * n + e] = g / (1.0f + __expf(-g)) * up; }
                u32x4 w; w.x = cvt_pk_bf16(o[0], o[1]); w.y = cvt_pk_bf16(o[2], o[3]); w.z = cvt_pk_bf16(o[4], o[5]); w.w = cvt_pk_bf16(o[6], o[7]);
                *(u32x4*)(O + (size_t)row * ldc + col0) = w; }
    }
};
template <class Epi, class Sched, bool ALIGN_EPI = false, bool SP2 = false>
__device__ __forceinline__ void gemm_phase(PG8_LAS unsigned char* lds, const Gemm g, const Sched& S, const Epi& E) {
    const int tid = threadIdx.x, wid = __builtin_amdgcn_readfirstlane(tid >> 6), lane = tid & 63, wr = wid >> 2, wc = wid & 3, fr = lane & 15, fq = lane >> 4;
    const int K = g.K, nt = K / BK;
    unsigned voffA[2], voffB[2];
#pragma unroll
    for (int i = 0; i < 2; ++i) { int R, C; stage_rc(tid * 16 + i * 8192, R, C); const int Rb = Epi::PERM ? ((R & ~31) + perm32(R & 31)) : R;
        voffA[i] = (unsigned)(R * K + C) * 2u; voffB[i] = (unsigned)(Rb * K + C) * 2u; }
    const size_t kstep = (size_t)(BK * 2);
    const size_t hstep = (size_t)HALF * K * 2;
    const size_t tstep = 2 * hstep;
    const unsigned ldsw = (unsigned)wid * 1024u;
    const int aoff = lds_byte(wr * 64 + fr, fq * 8), boff = lds_byte(wc * 32 + fr, fq * 8);
#define PG8_SA(b, h) (((b) * 2 + (h)) * HTB)
#define PG8_SB(b, h) ((4 + (b) * 2 + (h)) * HTB)
#define PG8_STAGE(bufoff, gbase, voff) do { _Pragma("unroll") for (int _i = 0; _i < 2; ++_i) \
        __builtin_amdgcn_global_load_lds((const unsigned*)((const char*)(gbase) + (voff)[_i]), (PG8_LAS unsigned*)(lds + (bufoff) + ldsw + _i * 8192), 16, 0, 0); } while (0)
#define PG8_LDA(dst, b, h) do { _Pragma("unroll") for (int m = 0; m < 4; ++m) _Pragma("unroll") for (int k = 0; k < 2; ++k) dst[m][k] = *(const PG8_LAS bf16x8*)(lds + PG8_SA(b, h) + aoff + m * 2048 + k * 1024); } while (0)
#define PG8_LDB(dst, b, h) do { _Pragma("unroll") for (int n = 0; n < 2; ++n) _Pragma("unroll") for (int k = 0; k < 2; ++k) dst[n][k] = *(const PG8_LAS bf16x8*)(lds + PG8_SB(b, h) + boff + n * 2048 + k * 1024); } while (0)
#define PG8_MMA(ai, bj, At, Bt) do { __builtin_amdgcn_s_setprio(1); _Pragma("unroll") for (int m = 0; m < 4; ++m) _Pragma("unroll") for (int n = 0; n < 2; ++n) _Pragma("unroll") for (int k = 0; k < 2; ++k) \
        acc[ai][bj][m][n] = __builtin_amdgcn_mfma_f32_16x16x32_bf16(Bt[n][k], At[m][k], acc[ai][bj][m][n], 0, 0, 0); __builtin_amdgcn_s_setprio(0); } while (0)
#define PG8_WAIT_V(n) asm volatile("s_waitcnt vmcnt(" #n ")" ::: "memory")
#define PG8_WAIT_L(n) asm volatile("s_waitcnt lgkmcnt(" #n ")" ::: "memory")
#define PG8_BAR __builtin_amdgcn_s_barrier()
#define PG8_SCHED __builtin_amdgcn_sched_barrier(0)
    Unit cur, nxt; int ui = 0;
    if (!S.next(0, cur)) return;
    f32x4 acc[2][2][4][2];
#pragma unroll
    for (int a = 0; a < 2; ++a)
#pragma unroll
        for (int b = 0; b < 2; ++b)
#pragma unroll
            for (int m = 0; m < 4; ++m)
#pragma unroll
                for (int n = 0; n < 2; ++n) acc[a][b][m][n] = (f32x4){0.f, 0.f, 0.f, 0.f};
    bf16x8 At[4][2], B0[2][2], B1[2][2];
    const char* cA = (const char*)g.A + (size_t)cur.pm * tstep; const char* cB = (const char*)g.Bt + (size_t)cur.pn * tstep;
    S.a_ready(cur);
    if constexpr (SP2) {
        PG8_STAGE(PG8_SB(0, 0), cB, voffB); PG8_STAGE(PG8_SB(0, 1), cB + hstep, voffB); PG8_STAGE(PG8_SA(0, 0), cA, voffA); PG8_STAGE(PG8_SA(0, 1), cA + hstep, voffA);
        if (wr == 1) PG8_BAR;
        PG8_WAIT_V(2); PG8_BAR;
        PG8_STAGE(PG8_SB(1, 0), cB + kstep, voffB); PG8_STAGE(PG8_SA(1, 0), cA + kstep, voffA); PG8_STAGE(PG8_SB(1, 1), cB + hstep + kstep, voffB);
        PG8_WAIT_V(6); PG8_BAR;
    } else {
        PG8_STAGE(PG8_SB(0, 0), cB, voffB); PG8_STAGE(PG8_SA(0, 0), cA, voffA); PG8_STAGE(PG8_SB(0, 1), cB + hstep, voffB); PG8_STAGE(PG8_SA(0, 1), cA + hstep, voffA);
        if (wr == 1) PG8_BAR;
        PG8_WAIT_V(4); PG8_BAR;
        PG8_STAGE(PG8_SB(1, 0), cB + kstep, voffB); PG8_STAGE(PG8_SA(1, 0), cA + kstep, voffA); PG8_STAGE(PG8_SB(1, 1), cB + hstep + kstep, voffB);
        PG8_WAIT_V(6); PG8_BAR;
    }
    for (;;) {
        const bool has_next = S.next(ui + 1, nxt);
        const char* nA = has_next ? (const char*)g.A + (size_t)nxt.pm * tstep : cA; const char* nB = has_next ? (const char*)g.Bt + (size_t)nxt.pn * tstep : cB;
        for (int t = 0; t < nt; t += 2) {
            const bool last = (t == nt - 2);
            const char* a1 = cA + (size_t)(t + 1) * kstep;
            const char* a2 = last ? nA : cA + (size_t)(t + 2) * kstep; const char* b2 = last ? nB : cB + (size_t)(t + 2) * kstep;
            const char* a3 = a2 + kstep; const char* b3 = b2 + kstep;
            if (last && has_next) S.a_ready(nxt);
            if constexpr (SP2) {
            PG8_LDB(B0, 0, 0); PG8_LDB(B1, 0, 1); PG8_SCHED; PG8_LDA(At, 0, 0); PG8_STAGE(PG8_SA(1, 1), a1 + hstep, voffA);
            PG8_WAIT_V(8); PG8_WAIT_L(0); PG8_BAR; PG8_MMA(0, 0, At, B0); PG8_MMA(0, 1, At, B1); PG8_BAR; PG8_SCHED;
            PG8_LDA(At, 0, 1); PG8_STAGE(PG8_SB(0, 0), b2, voffB); PG8_STAGE(PG8_SB(0, 1), b2 + hstep, voffB); PG8_STAGE(PG8_SA(0, 0), a2, voffA);
            PG8_WAIT_V(8); PG8_WAIT_L(0); PG8_BAR; PG8_MMA(1, 0, At, B0); PG8_MMA(1, 1, At, B1); PG8_BAR; PG8_SCHED;
            PG8_LDB(B0, 1, 0); PG8_LDB(B1, 1, 1); PG8_SCHED; PG8_LDA(At, 1, 0); PG8_STAGE(PG8_SA(0, 1), a2 + hstep, voffA);
            PG8_WAIT_V(8); PG8_WAIT_L(0); PG8_BAR; PG8_MMA(0, 0, At, B0); PG8_MMA(0, 1, At, B1); PG8_BAR; PG8_SCHED;
            PG8_LDA(At, 1, 1); PG8_STAGE(PG8_SB(1, 0), b3, voffB); PG8_STAGE(PG8_SB(1, 1), b3 + hstep, voffB); PG8_STAGE(PG8_SA(1, 0), a3, voffA);
            PG8_WAIT_V(8); PG8_WAIT_L(0); PG8_BAR; PG8_MMA(1, 0, At, B0); PG8_MMA(1, 1, At, B1); PG8_BAR; PG8_SCHED;
            } else {
            PG8_LDB(B0, 0, 0); PG8_SCHED; PG8_LDA(At, 0, 0); PG8_STAGE(PG8_SA(1, 1), a1 + hstep, voffA);
            PG8_WAIT_L(8); PG8_BAR; PG8_WAIT_L(0); PG8_MMA(0, 0, At, B0); PG8_BAR; PG8_SCHED;
            PG8_LDB(B1, 0, 1); PG8_STAGE(PG8_SB(0, 0), b2, voffB);
            PG8_BAR; PG8_WAIT_L(0); PG8_MMA(0, 1, At, B1); PG8_BAR;
            PG8_LDA(At, 0, 1); PG8_STAGE(PG8_SA(0, 0), a2, voffA);
            PG8_BAR; PG8_WAIT_L(0); PG8_MMA(1, 0, At, B0); PG8_BAR; PG8_SCHED;
            PG8_STAGE(PG8_SB(0, 1), b2 + hstep, voffB);
            PG8_WAIT_V(6); PG8_BAR; PG8_MMA(1, 1, At, B1); PG8_BAR;
            PG8_LDB(B0, 1, 0); PG8_SCHED; PG8_LDA(At, 1, 0); PG8_STAGE(PG8_SA(0, 1), a2 + hstep, voffA);
            PG8_WAIT_L(8); PG8_BAR; PG8_WAIT_L(0); PG8_MMA(0, 0, At, B0); PG8_BAR; PG8_SCHED;
            PG8_LDB(B1, 1, 1); PG8_STAGE(PG8_SB(1, 0), b3, voffB);
            PG8_BAR; PG8_WAIT_L(0); PG8_MMA(0, 1, At, B1); PG8_BAR;
            PG8_LDA(At, 1, 1); PG8_STAGE(PG8_SA(1, 0), a3, voffA);
            PG8_BAR; PG8_WAIT_L(0); PG8_MMA(1, 0, At, B0); PG8_BAR; PG8_SCHED;
            PG8_STAGE(PG8_SB(1, 1), b3 + hstep, voffB);
            PG8_WAIT_V(6); PG8_BAR; PG8_MMA(1, 1, At, B1); PG8_BAR;
            }
        }
        if constexpr (ALIGN_EPI) { if (wr == 0) PG8_BAR; }
        if constexpr (!Epi::AFTER_DRAIN) { E(acc, cur, wr, wc, fr, fq); S.done(cur); }
        if (!has_next) break;
#pragma unroll
        for (int a = 0; a < 2; ++a)
#pragma unroll
            for (int b = 0; b < 2; ++b)
#pragma unroll
                for (int m = 0; m < 4; ++m)
#pragma unroll
                    for (int n = 0; n < 2; ++n) acc[a][b][m][n] = (f32x4){0.f, 0.f, 0.f, 0.f};
        cur = nxt; cA = nA; cB = nB; ++ui;
        if constexpr (ALIGN_EPI) { if (wr == 1) PG8_BAR; }
    }
    PG8_WAIT_V(0);
    if constexpr (!ALIGN_EPI) { if (wr == 0) PG8_BAR; }
    PG8_BAR;
    if constexpr (Epi::AFTER_DRAIN) { E.fused(acc, cur, wr, wc, fr, fq, lds, wid, lane); S.done(cur); }
#undef PG8_SA
#undef PG8_SB
#undef PG8_STAGE
#undef PG8_LDA
#undef PG8_LDB
#undef PG8_MMA
#undef PG8_WAIT_V
#undef PG8_WAIT_L
#undef PG8_BAR
#undef PG8_SCHED
}
}
#define GAS __attribute__((address_space(1)))
#define LAS __attribute__((address_space(3)))
typedef unsigned short bf16;
typedef unsigned v4u __attribute__((ext_vector_type(4)));
typedef float f32x4 __attribute__((ext_vector_type(4)));
typedef short bf16x8 __attribute__((ext_vector_type(8)));
typedef GAS unsigned gu32;
typedef GAS unsigned long long gu64;
#define RLX_AGENT __ATOMIC_RELAXED, __HIP_MEMORY_SCOPE_AGENT
#define LDS_WAIT() asm volatile("s_waitcnt lgkmcnt(0)" ::: "memory")
#define VM_WAIT() asm volatile("s_waitcnt vmcnt(0)" ::: "memory")
__device__ __forceinline__ unsigned long long rt() { return __builtin_amdgcn_s_memrealtime(); }
typedef float f32x2_cv __attribute__((ext_vector_type(2))); typedef __bf16 bf16x2_cv __attribute__((ext_vector_type(2)));
__device__ __forceinline__ unsigned pk2(float lo, float hi) { f32x2_cv v = {lo, hi}; bf16x2_cv b = __builtin_convertvector(v, bf16x2_cv); return __builtin_bit_cast(unsigned, b); }
__device__ __forceinline__ unsigned f2bf(float f) { return pk2(f, f) & 0xffffu; }
#define XB_TMO      128
#define XB_XCNT(j)  (256  + 64 * (j))
#define XB_XSUB(j)  (1280 + 64 * (j))
#define XB_XGEN(j)  (2304 + 64 * (j))
#define XB_TOP      3328
#define XB_TOPGEN   3392
#define XCD_BAR_WORDS 3456
#define XB_SPIN_CAP (1u << 18)

__device__ __forceinline__ unsigned xb_ld(unsigned* p)              { return __hip_atomic_load(p, __ATOMIC_RELAXED, __HIP_MEMORY_SCOPE_AGENT); }
__device__ __forceinline__ unsigned xb_add(unsigned* p, unsigned v) { return __hip_atomic_fetch_add(p, v, __ATOMIC_RELAXED, __HIP_MEMORY_SCOPE_AGENT); }
__device__ __forceinline__ unsigned xb_xcc_id() { return (unsigned)__builtin_amdgcn_s_getreg((3 << 11) | 20) & 0xFu; }
#define XB_SPIN(cond, bar) do { unsigned _sp = 0; while (cond) { __builtin_amdgcn_s_sleep(1); \
    if ((++_sp & 255u) == 0u) { if (xb_ld(&(bar)[XB_TMO])) break; if (_sp > XB_SPIN_CAP) { atomicAdd(&(bar)[XB_TMO], 1u); break; } } } } while (0)

struct XcdBarrier {
    unsigned* bar; unsigned x;
    volatile LAS unsigned* st;
};

__device__ __forceinline__ XcdBarrier xcd_barrier_post(unsigned* bar, volatile LAS unsigned* st) {
    XcdBarrier b; b.bar = bar; b.x = xb_xcc_id(); b.st = st;
    if (threadIdx.x == 0) (void)xb_add(&bar[XB_XCNT(b.x)], 1u);
    return b;
}
__device__ __forceinline__ void xcd_barrier_complete(unsigned* bar, unsigned x, unsigned& nloc, unsigned& nx) {
    const unsigned G = gridDim.x * gridDim.y * gridDim.z;
    unsigned sum, cnt, mine, sp = 0u;
    for (;;) {
        sum = 0u; cnt = 0u; mine = 0u;
#pragma unroll
        for (unsigned j = 0; j < 16; ++j) { const unsigned c = xb_ld(&bar[XB_XCNT(j)]); sum += c; cnt += (c > 0u) ? 1u : 0u; mine = (j == x) ? c : mine; }
        if (sum == G) break;
        __builtin_amdgcn_s_sleep(1);
        if ((++sp & 255u) == 0u) { if (xb_ld(&bar[XB_TMO])) break; if (sp > XB_SPIN_CAP) { atomicAdd(&bar[XB_TMO], 1u); break; } }
    }
    nloc = mine > 0u ? mine : 1u; nx = cnt > 0u ? cnt : 1u;
}

__device__ __forceinline__ void xcd_barrier(const XcdBarrier& b) {
    asm volatile("s_waitcnt vmcnt(0)" ::: "memory");
    __syncthreads();
    if (threadIdx.x == 0) {
        unsigned* bar = b.bar;
        __builtin_amdgcn_s_waitcnt(0);
        unsigned nloc = b.st[0], nx = b.st[1];
        if (nloc == 0u) { xcd_barrier_complete(bar, b.x, nloc, nx); b.st[0] = nloc; b.st[1] = nx; }
        const unsigned old = xb_add(&bar[XB_XSUB(b.x)], 1u);
        const unsigned gen = old / nloc;
        if (old + 1u == (gen + 1u) * nloc) {
            __builtin_amdgcn_fence(__ATOMIC_RELEASE, "agent");
            asm volatile("s_waitcnt vmcnt(0)" ::: "memory");
            const unsigned og = xb_add(&bar[XB_TOP], 1u);
            const unsigned tg = og / nx;
            if (og + 1u == (tg + 1u) * nx) xb_add(&bar[XB_TOPGEN], 1u);
            else XB_SPIN(xb_ld(&bar[XB_TOPGEN]) == tg, bar);
            __builtin_amdgcn_fence(__ATOMIC_ACQUIRE, "agent");
            xb_add(&bar[XB_XGEN(b.x)], 1u);
            asm volatile("s_waitcnt vmcnt(0)" ::: "memory");
        } else {
            XB_SPIN(xb_ld(&bar[XB_XGEN(b.x)]) == gen, bar);
            __builtin_amdgcn_fence(__ATOMIC_ACQUIRE, "agent");
            asm volatile("s_waitcnt vmcnt(0)" ::: "memory");
        }
    }
    __syncthreads();
}
constexpr size_t MiB = 1u << 20;
constexpr size_t WS_CTL = 0, CTL_ZERO_BYTES = 64 * 1024;
constexpr size_t WS_ROPE = 1 * MiB, WS_SS = 2 * MiB;
constexpr size_t WS_W_INAB = 4 * MiB, WS_W_OUTAB = WS_W_INAB + (size_t)N_AB * 1024 * 2, WS_W_INCD = WS_W_OUTAB + 2 * MiB, WS_W_OUTCD = WS_W_INCD + (size_t)N_CD * 1024 * 2,
                 WS_W_GU = WS_W_OUTCD + 2 * MiB, WS_W_DN = WS_W_GU + 2 * (size_t)N_GU * 1024 * 2, WS_W_END = WS_W_DN + 2 * (size_t)D_FF * 1024 * 2;
constexpr size_t WS_XB = 52 * MiB, WS_MIX = 86 * MiB, WS_PROJ = 120 * MiB, WS_PROJ_END = WS_PROJ + (size_t)T_ALL * N_AB * 2;
constexpr size_t WS_COMP = WS_PROJ_END, WS_ENT = WS_COMP + 3 * MiB, WS_RK = WS_ENT + 2 * MiB, WS_END = WS_RK + 1 * MiB;
static_assert(WS_W_END <= WS_XB && WS_XB + (size_t)T_ALL * 1024 * 2 <= WS_MIX && WS_MIX + (size_t)T_ALL * 1024 * 2 <= WS_PROJ && WS_END <= 256 * MiB, "d_ws map");
static_assert((size_t)NCH * 8 * 4096 * 2 + (size_t)64 * 4 * 16384 * 4 <= (size_t)T_ALL * 1024 * 2, "rwkv states + retention group states fit the XB region");
static_assert(128 * 24576 <= 3 * MiB && 128 * 16384 <= 2 * MiB && NCH * 8 * 64 * 4 <= 1 * MiB, "scan scratch");
constexpr size_t O_Y = 0, O_RET_P = (size_t)T_ALL * 1024, O_WKV_P = O_RET_P + 65536, O_SHIFT_P = O_WKV_P + 32768, O_CONV_P = O_SHIFT_P + 1792, O_K_P = O_CONV_P + 15360, O_V_P = O_K_P + 16384,
                 O_RET_S = O_V_P + 16384, O_WKV_S = O_RET_S + 16 * 65536, O_SHIFT_S = O_WKV_S + 16 * 32768, O_CONV_S = O_SHIFT_S + 16 * 1792, O_K_S = O_CONV_S + 16 * 15360, O_V_S = O_K_S + 16 * 16384,
                 O_END = O_V_S + 16 * 16384;
static_assert(O_END == 20345600, "output size");
constexpr int RING_BYTES = 131072, MISC_OFF = RING_BYTES + 320, LDS_BYTES = 147456, NWAVES = 8;

#define LBAR() do { asm volatile("s_waitcnt lgkmcnt(0)" ::: "memory"); __builtin_amdgcn_s_barrier(); asm volatile("" ::: "memory"); } while (0)
#define DI __device__ __forceinline__
typedef LAS unsigned char* lptr;
typedef unsigned u32x2 __attribute__((ext_vector_type(2)));
typedef float f32x16 __attribute__((ext_vector_type(16)));
typedef float f32x2 __attribute__((ext_vector_type(2)));
DI float bf2f(unsigned h) { return __builtin_bit_cast(float, h << 16); }
DI void unpack8(const v4u w, float* o) {
    o[0] = bf2f(w.x & 0xffffu); o[1] = bf2f(w.x >> 16); o[2] = bf2f(w.y & 0xffffu); o[3] = bf2f(w.y >> 16);
    o[4] = bf2f(w.z & 0xffffu); o[5] = bf2f(w.z >> 16); o[6] = bf2f(w.w & 0xffffu); o[7] = bf2f(w.w >> 16);
}
DI v4u pack8(const float* o) { v4u w; w.x = pk2(o[0], o[1]); w.y = pk2(o[2], o[3]); w.z = pk2(o[4], o[5]); w.w = pk2(o[6], o[7]); return w; }
DI void ld8f(const float* p, float* o) { const f32x4 a = *(const f32x4*)p, b = *(const f32x4*)(p + 4); o[0] = a[0]; o[1] = a[1]; o[2] = a[2]; o[3] = a[3]; o[4] = b[0]; o[5] = b[1]; o[6] = b[2]; o[7] = b[3]; }
DI void st8f(float* p, const float* o) { *(f32x4*)p = (f32x4){o[0], o[1], o[2], o[3]}; *(f32x4*)(p + 4) = (f32x4){o[4], o[5], o[6], o[7]}; }
DI void ld8bf(const bf16* p, float* o) { unpack8(*(const v4u*)p, o); }
DI float sigmoidf_(float x) { return 1.0f / (1.0f + __expf(-x)); }

template <int K> DI void mma16(f32x4& acc, lptr A, int lda, lptr Bt, int ldb, int fr, int fq) {
#pragma unroll
    for (int k0 = 0; k0 < K; k0 += 32) {
        const bf16x8 a = *(const LAS bf16x8*)(A + fr * lda + (k0 + 8 * fq) * 2);
        const bf16x8 b = *(const LAS bf16x8*)(Bt + fr * ldb + (k0 + 8 * fq) * 2);
        acc = __builtin_amdgcn_mfma_f32_16x16x32_bf16(a, b, acc, 0, 0, 0);
    }
}
DI void st_rm(lptr M, int ld, int r0, int c0, const f32x4 v, int fr, int fq) {
#pragma unroll
    for (int i = 0; i < 4; ++i) *(LAS bf16*)(M + (r0 + 4 * fq + i) * ld + (c0 + fr) * 2) = (bf16)f2bf(v[i]);
}
DI void st_tr(lptr MT, int ld, int r0, int c0, const f32x4 v, int fr, int fq) {
    u32x2 w; w.x = pk2(v[0], v[1]); w.y = pk2(v[2], v[3]);
    *(LAS u32x2*)(MT + (c0 + fr) * ld + (r0 + 4 * fq) * 2) = w;
}
DI u32x2 pack4(const f32x4 v) { u32x2 w; w.x = pk2(v[0], v[1]); w.y = pk2(v[2], v[3]); return w; }
DI f32x4 unpack4(const u32x2 w) { return (f32x4){bf2f(w.x & 0xffffu), bf2f(w.x >> 16), bf2f(w.y & 0xffffu), bf2f(w.y >> 16)}; }

typedef short v4i16_t __attribute__((ext_vector_type(4)));
DI u32x2 trd(lptr p) { return __builtin_bit_cast(u32x2, __builtin_amdgcn_ds_read_tr16_b64_v4i16((LAS v4i16_t*)p)); }
template <int MODE> DI bf16x8 frag16(lptr img, int ld, int r0, int k0, int fr, int fq) {
    if (MODE == 0) return *(const LAS bf16x8*)(img + (r0 + fr) * ld + (k0 + 8 * fq) * 2);
    const lptr p = img + (k0 + 8 * fq + (fr >> 2)) * ld + (r0 + 4 * (fr & 3)) * 2;
    const u32x2 lo = trd(p), hi = trd(p + 4 * ld); v4u w; w.x = lo.x; w.y = lo.y; w.z = hi.x; w.w = hi.y; return __builtin_bit_cast(bf16x8, w);
}
template <int K, int MA, int MB> DI void mmaX(f32x4& acc, lptr A, int lda, int ar0, lptr B, int ldb, int br0, int fr, int fq) {
#pragma unroll
    for (int k0 = 0; k0 < K; k0 += 32) acc = __builtin_amdgcn_mfma_f32_16x16x32_bf16(frag16<MA>(A, lda, ar0, k0, fr, fq), frag16<MB>(B, ldb, br0, k0, fr, fq), acc, 0, 0, 0);
}
DI void g2l_64x64(lptr dst, const bf16* src, int tid) { const int r = tid >> 3, s = tid & 7; *(LAS v4u*)(dst + r * 144 + s * 16) = *(const v4u*)(src + r * 64 + s * 8); }
DI void l2g_64x64(bf16* dst, lptr src, int tid) { const int r = tid >> 3, s = tid & 7; *(v4u*)(dst + r * 64 + s * 8) = *(const LAS v4u*)(src + r * 144 + s * 16); }

struct Ctx {
    float* out; unsigned char* ws;
    int tid, lane, wave, vcu, G;
    lptr lds;
    unsigned long long* pr;
};
#define CAS __attribute__((address_space(4)))
DI const float* in_ptr(const Ctx&, int i) { const CAS char* p = (const CAS char*)__builtin_amdgcn_kernarg_segment_ptr(); asm volatile("" : "+s"(p)); return *(const float* const CAS*)(p + 8 * i); }
#ifndef PROBE_SUB
#define PROBE_SUB -1
#endif
#ifndef PROBE_SUB_HI
#define PROBE_SUB_HI PROBE_SUB
#endif
#define STAMP_BEGIN() unsigned long long st_last_ = (PROBE_SUB >= 0) ? __builtin_amdgcn_s_memrealtime() : 0ull
#define STAMP(k) do { if (PROBE_SUB >= 0) { const unsigned long long n_ = __builtin_amdgcn_s_memrealtime(); if ((k) >= PROBE_SUB && (k) <= PROBE_SUB_HI) *F.pr += n_ - st_last_; st_last_ = n_; } } while (0)

template <class RF> DI void gemm_small64(const Ctx& F, const bf16* A, const bf16* Bt, int K, int tile, const RF& rf, float* SS) {
    const int tid = F.tid, lane = F.lane, w = F.wave, fr = lane & 15, fq = lane >> 4; const lptr L = F.lds;
    const int row0 = TP + 64 * (tile >> 4), c0 = 64 * (tile & 15);
    const int kw = K >> 3, nst = kw >> 5;
    const bf16* ap = A + (size_t)(row0 + fr) * K + w * kw + 8 * fq; const bf16* bp = Bt + (size_t)(c0 + fr) * K + w * kw + 8 * fq;
    f32x4 acc[4][4];
#pragma unroll
    for (int m = 0; m < 4; ++m)
#pragma unroll
        for (int n = 0; n < 4; ++n) acc[m][n] = (f32x4){0.f, 0.f, 0.f, 0.f};
    bf16x8 a[4], b[4], an[4], bn[4];
#pragma unroll
    for (int i = 0; i < 4; ++i) { a[i] = *(const bf16x8*)(ap + (size_t)16 * i * K); b[i] = *(const bf16x8*)(bp + (size_t)16 * i * K); }
    for (int st = 0; st < nst; ++st) {
        const int kn = (st + 1 < nst) ? 32 * (st + 1) : 32 * st;
#pragma unroll
        for (int i = 0; i < 4; ++i) { an[i] = *(const bf16x8*)(ap + (size_t)16 * i * K + kn); bn[i] = *(const bf16x8*)(bp + (size_t)16 * i * K + kn); }
#pragma unroll
        for (int m = 0; m < 4; ++m)
#pragma unroll
            for (int n = 0; n < 4; ++n) acc[m][n] = __builtin_amdgcn_mfma_f32_16x16x32_bf16(b[n], a[m], acc[m][n], 0, 0, 0);
#pragma unroll
        for (int i = 0; i < 4; ++i) { a[i] = an[i]; b[i] = bn[i]; }
    }
#pragma unroll
    for (int m = 0; m < 4; ++m)
#pragma unroll
        for (int n = 0; n < 4; ++n) { const int row = 16 * m + fr, g4 = 4 * n + fq; *(LAS f32x4*)(L + w * 16384 + row * 256 + ((g4 ^ (row & 15)) << 4)) = acc[m][n]; }
    LBAR();
    {   const int row = tid >> 3, g = tid & 7; f32x4 v0 = (f32x4){0.f, 0.f, 0.f, 0.f}, v1 = v0;
#pragma unroll
        for (int ww = 0; ww < 8; ++ww) { v0 = v0 + *(const LAS f32x4*)(L + ww * 16384 + row * 256 + (((2 * g) ^ (row & 15)) << 4)); v1 = v1 + *(const LAS f32x4*)(L + ww * 16384 + row * 256 + (((2 * g + 1) ^ (row & 15)) << 4)); }
        float ssq = rf(row0 + row, c0 + 8 * g, v0, v1);
        ssq += __shfl_xor(ssq, 1); ssq += __shfl_xor(ssq, 2); ssq += __shfl_xor(ssq, 4);
        if (g == 0) SS[(size_t)(row0 + row) * 16 + (tile & 15)] = ssq; }
    LBAR();
}
constexpr int RW_LD = 144, RW_SLOT = 9216;
constexpr int RW_LDF = 272;
DI lptr rw_slot(lptr lds, int i) { return lds + i * RW_SLOT; }

DI void rw_load_p(const Ctx& F, int c, int t, int col, float* p, float* pp) {
    ld8bf(((bf16*)(F.ws + WS_PROJ)) + (size_t)(c * 64 + t) * N_AB + RW_OFF + col, p);
    if (t == 0 && c >= 256) ld8f(in_ptr(F, 4) + (size_t)(c - 256) * RWKV_PROJ + col, pp);
    else if (t == 0 && c == 0) {
#pragma unroll
        for (int e = 0; e < 8; ++e) pp[e] = 0.f; }
    else ld8bf(((bf16*)(F.ws + WS_PROJ)) + (size_t)(c * 64 + t - 1) * N_AB + RW_OFF + col, pp);
}
DI void rw_shift(const Ctx& F, int c, int t, int col, float* xs) {
    float p[8], pp[8], mu[8]; rw_load_p(F, c, t, col, p, pp); ld8f(in_ptr(F, 14) + col, mu);
#pragma unroll
    for (int e = 0; e < 8; ++e) xs[e] = p[e] + (pp[e] - p[e]) * mu[e];
}

constexpr int RW_PAR_OFF = RING_BYTES + 1024;
enum { PAR_MU_WL = 0, PAR_MU_AL = 64, PAR_MU_GL = 128, PAR_MU_R = 256, PAR_MU_K = 320, PAR_MU_V = 384, PAR_KK = 448, PAR_KA = 512, PAR_RK = 576, PAR_W0 = 640, PAR_A0 = 704, PAR_N = 768 };
DI void rw_load_params(const Ctx& F, int h) {
    LAS float* P = (LAS float*)(F.lds + RW_PAR_OFF);
    for (int i = F.tid; i < PAR_N; i += 512) { float v;
        if (i < 256) v = in_ptr(F, 14)[1536 + i];
        else { const int k = (i - 256) >> 6, j = h * 64 + (i & 63);
            v = k == 0 ? in_ptr(F, 14)[j] : k == 1 ? in_ptr(F, 14)[512 + j] : k == 2 ? in_ptr(F, 14)[1024 + j] : k == 3 ? in_ptr(F, 20)[j] : k == 4 ? in_ptr(F, 21)[j] : k == 5 ? in_ptr(F, 22)[j] : k == 6 ? in_ptr(F, 15)[j] : in_ptr(F, 17)[j]; }
        P[i] = v; }
    LBAR();
}
struct RwPre { v4u pa[4], qa[4]; f32x4 w2[2]; };
DI v4u rw_prev16(const Ctx& F, int c, int t, int col) {
    if (t == 0 && c >= 256) { float v[8]; ld8f(in_ptr(F, 4) + (size_t)(c - 256) * RWKV_PROJ + col, v); return pack8(v); }
    if (t == 0 && c == 0) return (v4u){0u, 0u, 0u, 0u};
    return *(const v4u*)(((bf16*)(F.ws + WS_PROJ)) + (size_t)(c * 64 + t - 1) * N_AB + RW_OFF + col);
}
DI void rw_prefetch(const Ctx& F, int c, int h, RwPre& R) {
    const int t = F.tid >> 3, s8 = F.tid & 7; const bf16* row = ((bf16*)(F.ws + WS_PROJ)) + (size_t)(c * 64 + t) * N_AB + RW_OFF;
#pragma unroll
    for (int q = 0; q < 4; ++q) { const int col = 1536 + 64 * q + 8 * s8; R.pa[q] = *(const v4u*)(row + col); R.qa[q] = rw_prev16(F, c, t, col); }
#pragma unroll
    for (int q = 0; q < 2; ++q) { R.w2[q] = *(const f32x4*)(in_ptr(F, 16) + (size_t)t * 512 + h * 64 + 8 * s8 + 4 * q);
 }
}
DI void rw_mix8(const v4u p, const v4u pp, const LAS float* mu, float* xs) {
    float a[8], b[8]; unpack8(p, a); unpack8(pp, b);
#pragma unroll
    for (int e = 0; e < 8; ++e) xs[e] = a[e] + (b[e] - a[e]) * mu[e];
}
DI void rwkv_p1_item(const Ctx& F, int c, int h, RwPre& R, bool has_next, int nc, int nh) {
    const int tid = F.tid, lane = F.lane, w = F.wave, fr = lane & 15, fq = lane >> 4, tr = w >> 1, tc0 = 2 * (w & 1);
    const lptr L = F.lds;
    const int t = tid >> 3, s8 = tid & 7;
    const lptr TW = L, AL = L + 9216, SG = L + 18432, W2 = L + 35840, A2 = L + 45056, G2 = L + 54272;
    const lptr LG = L + 8 * RW_SLOT, A32 = LG + 17408;
    LAS float* GAMC = (LAS float*)(L + 14 * RW_SLOT);
    STAMP_BEGIN();
    v4u pc[3], qc[3];
    f32x4 g2r[4], a2r[2];
#pragma unroll
    for (int q = 0; q < 2; ++q) a2r[q] = *(const f32x4*)(in_ptr(F, 18) + (size_t)t * 512 + h * 64 + 8 * s8 + 4 * q);
#pragma unroll
    for (int q = 0; q < 2; ++q) { g2r[q] = *(const f32x4*)(in_ptr(F, 19) + (size_t)t * 512 + h * 64 + 8 * s8 + 4 * q); g2r[2 + q] = *(const f32x4*)(in_ptr(F, 19) + (size_t)(t + 64) * 512 + h * 64 + 8 * s8 + 4 * q); }
    { const bf16* row = ((bf16*)(F.ws + WS_PROJ)) + (size_t)(c * 64 + t) * N_AB + RW_OFF;
#pragma unroll
        for (int q = 0; q < 3; ++q) { const int col = 512 * q + h * 64 + 8 * s8; pc[q] = *(const v4u*)(row + col); qc[q] = rw_prev16(F, c, t, col); } }
    const LAS float* PAR = (const LAS float*)(L + RW_PAR_OFF);
    {
        float xs[8], o[8];
        rw_mix8(R.pa[0], R.qa[0], PAR + PAR_MU_WL + 8 * s8, xs);
#pragma unroll
        for (int e = 0; e < 8; ++e) o[e] = 1.0f - 2.0f / (1.0f + __expf(2.0f * xs[e]));
        *(LAS v4u*)(TW + t * RW_LD + s8 * 16) = pack8(o);
        rw_mix8(R.pa[1], R.qa[1], PAR + PAR_MU_AL + 8 * s8, xs);
        *(LAS v4u*)(AL + t * RW_LD + s8 * 16) = pack8(xs);
#pragma unroll
        for (int q = 0; q < 2; ++q) { rw_mix8(R.pa[2 + q], R.qa[2 + q], PAR + PAR_MU_GL + 64 * q + 8 * s8, xs);
#pragma unroll
            for (int e = 0; e < 8; ++e) o[e] = sigmoidf_(xs[e]);
            *(LAS v4u*)(SG + t * 272 + (64 * q + 8 * s8) * 2) = pack8(o); }
        {   float v8[8];
#pragma unroll
            for (int e = 0; e < 4; ++e) { v8[e] = R.w2[0][e]; v8[4 + e] = R.w2[1][e]; }
            *(LAS v4u*)(W2 + t * RW_LD + s8 * 16) = pack8(v8);
#pragma unroll
            for (int e = 0; e < 4; ++e) { v8[e] = a2r[0][e]; v8[4 + e] = a2r[1][e]; }
            *(LAS v4u*)(A2 + t * RW_LD + s8 * 16) = pack8(v8);
#pragma unroll
            for (int e = 0; e < 4; ++e) { v8[e] = g2r[0][e]; v8[4 + e] = g2r[1][e]; }
            *(LAS v4u*)(G2 + t * RW_LD + s8 * 16) = pack8(v8);
#pragma unroll
            for (int e = 0; e < 4; ++e) { v8[e] = g2r[2][e]; v8[4 + e] = g2r[3][e]; }
            *(LAS v4u*)(G2 + (t + 64) * RW_LD + s8 * 16) = pack8(v8); }
    }
    LBAR(); STAMP(0);
    {
        f32x4 aw[2], aa[2], ag[2];
#pragma unroll
        for (int i = 0; i < 2; ++i) { aw[i] = (f32x4){0.f, 0.f, 0.f, 0.f}; aa[i] = aw[i]; ag[i] = aw[i];
            mmaX<64, 0, 1>(aw[i], TW, RW_LD, 16 * tr, W2, RW_LD, 16 * (tc0 + i), fr, fq);
            mmaX<64, 0, 1>(aa[i], AL, RW_LD, 16 * tr, A2, RW_LD, 16 * (tc0 + i), fr, fq);
            mmaX<128, 0, 1>(ag[i], SG, 272, 16 * tr, G2, RW_LD, 16 * (tc0 + i), fr, fq); }
        LBAR();
#pragma unroll
        for (int i = 0; i < 2; ++i) { const int j = 16 * (tc0 + i) + fr; const float w0 = PAR[PAR_W0 + j], a0 = PAR[PAR_A0 + j];
#pragma unroll
            for (int r = 0; r < 4; ++r) { const int tt = 16 * tr + 4 * fq + r;
                const float z = -(w0 + aw[i][r]); const float sp = fmaxf(z, 0.f) + __logf(1.0f + __expf(-fabsf(z)));
                *(LAS float*)(LG + tt * RW_LDF + j * 4) = -__expf(-sp - 0.5f);
                *(LAS float*)(A32 + tt * RW_LDF + j * 4) = sigmoidf_(a0 + aa[i][r]);
            }
            st_rm(rw_slot(L, 12), RW_LD, 16 * tr, 16 * (tc0 + i), ag[i], fr, fq); }
    }
    LBAR(); STAMP(1);
    {   { const int r = tid >> 3, sg = tid & 7; *(v4u*)(((bf16*)(F.ws + WS_MIX)) + (size_t)(c * 64 + r) * 1024 + 512 + h * 64 + sg * 8) = *(const LAS v4u*)(rw_slot(L, 12) + r * RW_LD + sg * 16); }
        const int j = tid & 63, tb = tid >> 6; LAS float* TOT = (LAS float*)rw_slot(L, 13); float v[8];
#pragma unroll
        for (int i = 0; i < 8; ++i) v[i] = *(LAS float*)(LG + (8 * tb + i) * RW_LDF + j * 4);
#pragma unroll
        for (int i = 1; i < 8; ++i) v[i] += v[i - 1];
        TOT[tb * 64 + j] = v[7];
        LBAR();
        float off = 0.f;
#pragma unroll
        for (int bb = 0; bb < 7; ++bb) off += bb < tb ? TOT[bb * 64 + j] : 0.f;
#pragma unroll
        for (int i = 0; i < 8; ++i) *(LAS float*)(LG + (8 * tb + i) * RW_LDF + j * 4) = v[i] + off;
    }
    LBAR(); STAMP(2);
    const lptr KG = rw_slot(L, 0), RG = rw_slot(L, 1), BI = rw_slot(L, 2), KI = rw_slot(L, 3), VV = rw_slot(L, 4), BT = rw_slot(L, 5), KT = rw_slot(L, 6);
    {
        const int j0 = 8 * s8;
        float kk[8], k2[8], b[8];
        {   float xk[8], a[8]; rw_mix8(pc[1], qc[1], PAR + PAR_MU_K + j0, xk); const LAS float* w8 = PAR + PAR_KK + j0; float ss = 0.f;
#pragma unroll
            for (int e = 0; e < 8; ++e) { kk[e] = xk[e] * w8[e]; ss += kk[e] * kk[e]; }
            ss += __shfl_xor(ss, 1); ss += __shfl_xor(ss, 2); ss += __shfl_xor(ss, 4);
            const float inv = 1.0f / fmaxf(sqrtf(ss), 1e-12f);
            const LAS float* w9 = PAR + PAR_KA + j0;
#pragma unroll
            for (int e = 0; e < 8; ++e) { a[e] = *(LAS float*)(A32 + t * RW_LDF + (j0 + e) * 4); kk[e] *= inv; k2[e] = xk[e] * (1.0f + (a[e] - 1.0f) * w9[e]); b[e] = kk[e] * a[e]; } }
        asm volatile("" ::: "memory");
        float lg[8];
#pragma unroll
        for (int e = 0; e < 8; ++e) lg[e] = *(LAS float*)(LG + t * RW_LDF + (j0 + e) * 4);
        {   float xr[8], o[8]; rw_mix8(pc[0], qc[0], PAR + PAR_MU_R + j0, xr); const LAS float* w8 = PAR + PAR_RK + j0; float rks = 0.f;
#pragma unroll
            for (int e = 0; e < 8; ++e) { rks += xr[e] * k2[e] * w8[e]; o[e] = xr[e] * __expf(lg[e]); }
            rks += __shfl_xor(rks, 1); rks += __shfl_xor(rks, 2); rks += __shfl_xor(rks, 4);
            if (s8 == 0) ((float*)(F.ws + WS_RK))[(size_t)(c * 8 + h) * 64 + t] = rks;
            *(LAS v4u*)(RG + t * RW_LD + s8 * 16) = pack8(o); }
        asm volatile("" ::: "memory");
        {   float o[8];
#pragma unroll
            for (int e = 0; e < 8; ++e) { const float lgm = t > 0 ? *(LAS float*)(LG + (t - 1) * RW_LDF + (j0 + e) * 4) : 0.f; o[e] = kk[e] * __expf(lgm); }
            *(LAS v4u*)(KG + t * RW_LD + s8 * 16) = pack8(o); }
        asm volatile("" ::: "memory");
        {   float o1[8], o2[8];
#pragma unroll
            for (int e = 0; e < 8; ++e) { const float ei = __expf(-lg[e]); o1[e] = b[e] * ei; o2[e] = k2[e] * ei; }
            *(LAS v4u*)(BI + t * RW_LD + s8 * 16) = pack8(o1);
            *(LAS v4u*)(KI + t * RW_LD + s8 * 16) = pack8(o2); }
        asm volatile("" ::: "memory");
        {   float o1[8], o2[8];
#pragma unroll
            for (int e = 0; e < 8; ++e) { const float lgc = *(LAS float*)(LG + 63 * RW_LDF + (j0 + e) * 4); const float ec = __expf(lgc - lg[e]);
                if (t == 63) GAMC[j0 + e] = __expf(lgc);
                o1[e] = b[e] * ec; o2[e] = k2[e] * ec; }
            *(LAS v4u*)(BT + t * RW_LD + s8 * 16) = pack8(o1);
            *(LAS v4u*)(KT + t * RW_LD + s8 * 16) = pack8(o2); }
        asm volatile("" ::: "memory");
        {   float xv[8]; rw_mix8(pc[2], qc[2], PAR + PAR_MU_V + j0, xv); *(LAS v4u*)(VV + t * RW_LD + s8 * 16) = pack8(xv); }
    }
    if (has_next) rw_prefetch(F, nc, nh, R);
    LBAR(); STAMP(3);
    const lptr BMT = rw_slot(L, 7), PBT = rw_slot(L, 8), PKT = rw_slot(L, 9), XT0 = rw_slot(L, 10), XT1 = rw_slot(L, 2), PT0 = rw_slot(L, 11), PT1 = rw_slot(L, 3);
    f32x4 P[2];
    {
        f32x4 aA[2], aB[2], aPb[2], aPk[2];
#pragma unroll
        for (int i = 0; i < 2; ++i) { aA[i] = (f32x4){0.f, 0.f, 0.f, 0.f}; aB[i] = aA[i]; aPb[i] = aA[i]; aPk[i] = aA[i];
            mmaX<64, 0, 0>(aA[i], KG, RW_LD, 16 * tr, BI, RW_LD, 16 * (tc0 + i), fr, fq);
            mmaX<64, 0, 0>(aB[i], KG, RW_LD, 16 * tr, KI, RW_LD, 16 * (tc0 + i), fr, fq);
            mmaX<64, 0, 0>(aPb[i], RG, RW_LD, 16 * tr, BI, RW_LD, 16 * (tc0 + i), fr, fq);
            mmaX<64, 0, 0>(aPk[i], RG, RW_LD, 16 * tr, KI, RW_LD, 16 * (tc0 + i), fr, fq); }
        LBAR();
#pragma unroll
        for (int i = 0; i < 2; ++i) { const int s = 16 * (tc0 + i) + fr; f32x4 x, p1, bm, pb, pk;
#pragma unroll
            for (int r = 0; r < 4; ++r) { const int tt = 16 * tr + 4 * fq + r;
                x[r] = tt > s ? -aA[i][r] : 0.f; p1[r] = x[r] + (tt == s ? 1.f : 0.f); bm[r] = tt > s ? aB[i][r] : 0.f; pb[r] = tt >= s ? aPb[i][r] : 0.f; pk[r] = tt >= s ? aPk[i][r] : 0.f; }
            P[i] = p1;
            st_tr(XT0, RW_LD, 16 * tr, 16 * (tc0 + i), x, fr, fq); st_tr(PT0, RW_LD, 16 * tr, 16 * (tc0 + i), p1, fr, fq);
            st_tr(BMT, RW_LD, 16 * tr, 16 * (tc0 + i), bm, fr, fq); st_tr(PBT, RW_LD, 16 * tr, 16 * (tc0 + i), pb, fr, fq); st_tr(PKT, RW_LD, 16 * tr, 16 * (tc0 + i), pk, fr, fq); }
    }
    LBAR(); STAMP(4);
#pragma unroll
    for (int st = 1; st <= 6; ++st) {
        const lptr XTc = (st & 1) ? XT0 : XT1, XTn = (st & 1) ? XT1 : XT0;
        const lptr PTc = (st & 1) ? PT1 : PT0, PTn = (st & 1) ? PT0 : PT1;
        f32x4 xn[2];
#pragma unroll
        for (int i = 0; i < 2; ++i) {
            if (st < 6) { xn[i] = (f32x4){0.f, 0.f, 0.f, 0.f}; mmaX<64, 1, 0>(xn[i], XTc, RW_LD, 16 * tr, XTc, RW_LD, 16 * (tc0 + i), fr, fq); }
            if (st > 1) mmaX<64, 1, 0>(P[i], PTc, RW_LD, 16 * tr, XTc, RW_LD, 16 * (tc0 + i), fr, fq);
        }
#pragma unroll
        for (int i = 0; i < 2; ++i) {
            if (st < 6) st_tr(XTn, RW_LD, 16 * tr, 16 * (tc0 + i), xn[i], fr, fq);
            if (st > 1) st_tr(PTn, RW_LD, 16 * tr, 16 * (tc0 + i), P[i], fr, fq);
        }
        LBAR();
    }
    STAMP(5);
    const lptr TT = PT1, WT = rw_slot(L, 10), BVT = rw_slot(L, 11), UVT = rw_slot(L, 12), MS = rw_slot(L, 13), QS = rw_slot(L, 2);
    {
#pragma unroll
        for (int i = 0; i < 2; ++i) { f32x4 aw = (f32x4){0.f, 0.f, 0.f, 0.f}, ab = aw;
            mmaX<64, 1, 1>(aw, TT, RW_LD, 16 * tr, KG, RW_LD, 16 * (tc0 + i), fr, fq);
            mmaX<64, 1, 1>(ab, BMT, RW_LD, 16 * tr, VV, RW_LD, 16 * (tc0 + i), fr, fq);
            st_tr(WT, RW_LD, 16 * tr, 16 * (tc0 + i), aw, fr, fq); st_tr(BVT, RW_LD, 16 * tr, 16 * (tc0 + i), ab, fr, fq); }
    }
    LBAR();
    {
#pragma unroll
        for (int i = 0; i < 2; ++i) { f32x4 au = (f32x4){0.f, 0.f, 0.f, 0.f};
            mmaX<64, 1, 0>(au, TT, RW_LD, 16 * tr, BVT, RW_LD, 16 * (tc0 + i), fr, fq);
            st_tr(UVT, RW_LD, 16 * tr, 16 * (tc0 + i), au, fr, fq); }
    }
    LBAR();
    unsigned char* item = ((unsigned char*)F.out) + (size_t)(c * 8 + h) * 32768;
    {
#pragma unroll
        for (int i = 0; i < 2; ++i) { const int cb = 16 * (tc0 + i);
            f32x4 am = (f32x4){0.f, 0.f, 0.f, 0.f};
            mmaX<64, 0, 1>(am, WT, RW_LD, 16 * tr, BT, RW_LD, cb, fr, fq);
            { const int j = cb + fr; const float gc = GAMC[j]; f32x4 mv;
#pragma unroll
                for (int r = 0; r < 4; ++r) { const int jp = 16 * tr + 4 * fq + r; mv[r] = (jp == j ? gc : 0.f) - am[r]; }
                st_tr(MS, RW_LD, 16 * tr, cb, mv, fr, fq); }
            f32x4 aq = (f32x4){0.f, 0.f, 0.f, 0.f};
            mmaX<64, 0, 1>(aq, WT, RW_LD, 16 * tr, PBT, RW_LD, cb, fr, fq);
            { const f32x4 rgv = unpack4(*(const LAS u32x2*)(RG + (cb + fr) * RW_LD + (16 * tr + 4 * fq) * 2)); const f32x4 qv = rgv - aq; st_tr(QS, RW_LD, 16 * tr, cb, qv, fr, fq); }
            f32x4 g1 = (f32x4){0.f, 0.f, 0.f, 0.f}, g2 = g1, y1 = g1, y2 = g1;
            mmaX<64, 1, 1>(g1, KT, RW_LD, 16 * tr, VV, RW_LD, cb, fr, fq);
            mmaX<64, 1, 0>(g2, BT, RW_LD, 16 * tr, UVT, RW_LD, cb, fr, fq);
            mmaX<64, 1, 1>(y1, PKT, RW_LD, 16 * tr, VV, RW_LD, cb, fr, fq);
            mmaX<64, 1, 0>(y2, PBT, RW_LD, 16 * tr, UVT, RW_LD, cb, fr, fq);
            *(u32x2*)(item + 16384 + ((w * 2 + i) * 64 + lane) * 8) = pack4(g1 - g2);
            *(u32x2*)(item + 24576 + ((w * 2 + i) * 64 + lane) * 8) = pack4(y1 - y2); }
    }
    LBAR();
    l2g_64x64((bf16*)item, MS, tid); l2g_64x64((bf16*)(item + 8192), QS, tid);
    if (h == 0 && c >= 255) { float* dst = c == 255 ? (F.out + O_SHIFT_P) : (F.out + O_SHIFT_S) + (size_t)(c - 256) * RWKV_PROJ; const bf16* src = ((bf16*)(F.ws + WS_PROJ)) + (size_t)(c * 64 + 63) * N_AB + RW_OFF;
        for (int col = tid; col < RWKV_PROJ; col += 512) dst[col] = bf2f(src[col]); }
    LBAR(); STAMP(6);
}

DI void rw_ld_frag_bf16(const unsigned char* p, int w, int lane, f32x4* a) { a[0] = unpack4(*(const u32x2*)(p + ((w * 2) * 64 + lane) * 8)); a[1] = unpack4(*(const u32x2*)(p + ((w * 2 + 1) * 64 + lane) * 8)); }

DI void rwkv_l1_item(const Ctx& F, int g, int h) { STAMP_BEGIN();
    const int tid = F.tid, lane = F.lane, w = F.wave, fr = lane & 15, fq = lane >> 4, tr = w >> 1, tc0 = 2 * (w & 1);
    const lptr L = F.lds, OS = rw_slot(L, 6);
    const int c0 = g * 16;
    f32x4 am[2], ag[2];
    { const unsigned char* item = ((unsigned char*)F.out) + (size_t)(c0 * 8 + h) * 32768; const bf16* M = (const bf16*)item;
#pragma unroll
        for (int i = 0; i < 2; ++i)
#pragma unroll
            for (int r = 0; r < 4; ++r) am[i][r] = bf2f(M[(16 * tr + 4 * fq + r) * 64 + 16 * (tc0 + i) + fr]);
        rw_ld_frag_bf16(item + 16384, w, lane, ag); }
    const int pr_ = tid >> 3, ps_ = tid & 7;
    v4u mreg; u32x2 gq0, gq1;
    { const unsigned char* item = ((unsigned char*)F.out) + (size_t)((c0 + 1) * 8 + h) * 32768; mreg = *(const v4u*)((const bf16*)item + pr_ * 64 + ps_ * 8);
        gq0 = *(const u32x2*)(item + 16384 + ((w * 2) * 64 + lane) * 8); gq1 = *(const u32x2*)(item + 16384 + ((w * 2 + 1) * 64 + lane) * 8); }
    for (int c = c0 + 1; c < c0 + 16; ++c) {
        const lptr MA = rw_slot(L, 3 * (c & 1)), MHT = rw_slot(L, 3 * (c & 1) + 1), GHT = rw_slot(L, 3 * (c & 1) + 2);
        *(LAS v4u*)(MA + pr_ * 144 + ps_ * 16) = mreg;
#pragma unroll
        for (int i = 0; i < 2; ++i) { st_tr(MHT, RW_LD, 16 * tr, 16 * (tc0 + i), am[i], fr, fq); st_tr(GHT, RW_LD, 16 * tr, 16 * (tc0 + i), ag[i], fr, fq); }
        f32x4 gc[2]; gc[0] = unpack4(gq0); gc[1] = unpack4(gq1);
        if (c + 1 < c0 + 16) { const unsigned char* item = ((unsigned char*)F.out) + (size_t)((c + 1) * 8 + h) * 32768; mreg = *(const v4u*)((const bf16*)item + pr_ * 64 + ps_ * 8);
            gq0 = *(const u32x2*)(item + 16384 + ((w * 2) * 64 + lane) * 8); gq1 = *(const u32x2*)(item + 16384 + ((w * 2 + 1) * 64 + lane) * 8); }
        LBAR();
#pragma unroll
        for (int i = 0; i < 2; ++i) { am[i] = (f32x4){0.f, 0.f, 0.f, 0.f}; ag[i] = gc[i];
            mma16<64>(am[i], MA + 16 * tr * RW_LD, RW_LD, MHT + 16 * (tc0 + i) * RW_LD, RW_LD, fr, fq);
            mma16<64>(ag[i], MA + 16 * tr * RW_LD, RW_LD, GHT + 16 * (tc0 + i) * RW_LD, RW_LD, fr, fq); }
    }
    unsigned char* comp = (F.ws + WS_COMP) + (size_t)(h * 16 + g) * 24576;
#pragma unroll
    for (int i = 0; i < 2; ++i) { st_rm(OS, RW_LD, 16 * tr, 16 * (tc0 + i), am[i], fr, fq); *(f32x4*)(comp + 8192 + ((w * 2 + i) * 64 + lane) * 16) = ag[i]; }
    LBAR();
    l2g_64x64((bf16*)comp, OS, tid);
    LBAR();
    STAMP(12);
}
DI void rwkv_l2_item(const Ctx& F, int h) { STAMP_BEGIN();
    const int tid = F.tid, lane = F.lane, w = F.wave, fr = lane & 15, fq = lane >> 4, tr = w >> 1, tc0 = 2 * (w & 1);
    const lptr L = F.lds;
    f32x4 e[2]; e[0] = (f32x4){0.f, 0.f, 0.f, 0.f}; e[1] = e[0];
    const int pr_ = tid >> 3, ps_ = tid & 7;
    v4u mreg; f32x4 gh[2];
    { const unsigned char* comp = (F.ws + WS_COMP) + (size_t)(h * 16) * 24576; mreg = *(const v4u*)((const bf16*)comp + pr_ * 64 + ps_ * 8);
#pragma unroll
        for (int i = 0; i < 2; ++i) gh[i] = *(const f32x4*)(comp + 8192 + ((w * 2 + i) * 64 + lane) * 16); }
    for (int g = 0; g < 16; ++g) {
        float* ent = ((float*)(F.ws + WS_ENT)) + (size_t)(h * 16 + g) * 4096;
#pragma unroll
        for (int i = 0; i < 2; ++i) *(f32x4*)(ent + ((w * 2 + i) * 64 + lane) * 4) = e[i];
        if (g == 15) break;
        const lptr MA = rw_slot(L, 2 * (g & 1)), EHT = rw_slot(L, 2 * (g & 1) + 1);
        *(LAS v4u*)(MA + pr_ * 144 + ps_ * 16) = mreg;
#pragma unroll
        for (int i = 0; i < 2; ++i) st_tr(EHT, RW_LD, 16 * tr, 16 * (tc0 + i), e[i], fr, fq);
        f32x4 gcur[2]; gcur[0] = gh[0]; gcur[1] = gh[1];
        if (g + 1 < 15) { const unsigned char* comp = (F.ws + WS_COMP) + (size_t)(h * 16 + g + 1) * 24576; mreg = *(const v4u*)((const bf16*)comp + pr_ * 64 + ps_ * 8);
#pragma unroll
            for (int i = 0; i < 2; ++i) gh[i] = *(const f32x4*)(comp + 8192 + ((w * 2 + i) * 64 + lane) * 16); }
        LBAR();
#pragma unroll
        for (int i = 0; i < 2; ++i) { e[i] = gcur[i]; mma16<64>(e[i], MA + 16 * tr * RW_LD, RW_LD, EHT + 16 * (tc0 + i) * RW_LD, RW_LD, fr, fq); }
    }
    LBAR();
    STAMP(13);
}
DI void rwkv_l3_item(const Ctx& F, int kind, int g, int h) { STAMP_BEGIN();
    const int tid = F.tid, lane = F.lane, w = F.wave, fr = lane & 15, fq = lane >> 4, tr = w >> 1, tc0 = 2 * (w & 1);
    const lptr L = F.lds;
    f32x4 s[2];
    int c0, nc;
    if (kind == 0) { c0 = g * 16; nc = 16; const float* ent = ((float*)(F.ws + WS_ENT)) + (size_t)(h * 16 + g) * 4096;
#pragma unroll
        for (int i = 0; i < 2; ++i) s[i] = *(const f32x4*)(ent + ((w * 2 + i) * 64 + lane) * 4); }
    else { c0 = 256 + g; nc = 1; const float* S = in_ptr(F, 3) + (size_t)(g * 8 + h) * 4096;
#pragma unroll
        for (int i = 0; i < 2; ++i) s[i] = *(const f32x4*)(S + (16 * (tc0 + i) + fr) * 64 + 16 * tr + 4 * fq); }
    const int pr_ = tid >> 3, ps_ = tid & 7;
    v4u mreg; u32x2 gq0, gq1;
    { const unsigned char* item = ((unsigned char*)F.out) + (size_t)(c0 * 8 + h) * 32768; mreg = *(const v4u*)((const bf16*)item + pr_ * 64 + ps_ * 8);
        gq0 = *(const u32x2*)(item + 16384 + ((w * 2) * 64 + lane) * 8); gq1 = *(const u32x2*)(item + 16384 + ((w * 2 + 1) * 64 + lane) * 8); }
    for (int c = c0; c < c0 + nc; ++c) {
        bf16* stg = ((bf16*)(F.ws + WS_XB)) + (size_t)(c * 8 + h) * 4096;
        const lptr MA = rw_slot(L, 2 * (c & 1)), SHT = rw_slot(L, 2 * (c & 1) + 1);
        *(LAS v4u*)(MA + pr_ * 144 + ps_ * 16) = mreg;
#pragma unroll
        for (int i = 0; i < 2; ++i) { st_tr(SHT, RW_LD, 16 * tr, 16 * (tc0 + i), s[i], fr, fq);
            *(u32x2*)(stg + (16 * (tc0 + i) + fr) * 64 + 16 * tr + 4 * fq) = pack4(s[i]); }
        f32x4 gc[2]; gc[0] = unpack4(gq0); gc[1] = unpack4(gq1);
        if (c + 1 < c0 + nc) { const unsigned char* item = ((unsigned char*)F.out) + (size_t)((c + 1) * 8 + h) * 32768; mreg = *(const v4u*)((const bf16*)item + pr_ * 64 + ps_ * 8);
            gq0 = *(const u32x2*)(item + 16384 + ((w * 2) * 64 + lane) * 8); gq1 = *(const u32x2*)(item + 16384 + ((w * 2 + 1) * 64 + lane) * 8); }
        LBAR();
#pragma unroll
        for (int i = 0; i < 2; ++i) { s[i] = gc[i]; mma16<64>(s[i], MA + 16 * tr * RW_LD, RW_LD, SHT + 16 * (tc0 + i) * RW_LD, RW_LD, fr, fq); }
    }
    LBAR();
    if (kind == 1 || g == 15) { float* out = kind == 1 ? (F.out + O_WKV_S) + (size_t)(g * 8 + h) * 4096 : (F.out + O_WKV_P) + (size_t)h * 4096;
#pragma unroll
        for (int i = 0; i < 2; ++i) *(f32x4*)(out + (16 * (tc0 + i) + fr) * 64 + 16 * tr + 4 * fq) = s[i]; }
    STAMP(14);
}
DI void rwkv_p3_item(const Ctx& F, int c, int h) { STAMP_BEGIN();
    const int tid = F.tid, lane = F.lane, w = F.wave, fr = lane & 15, fq = lane >> 4, tr = w >> 1, tc0 = 2 * (w & 1);
    const lptr L = F.lds, QA = rw_slot(L, 0), SB = rw_slot(L, 1), YS = rw_slot(L, 2);
    const unsigned char* item = ((unsigned char*)F.out) + (size_t)(c * 8 + h) * 32768;
    g2l_64x64(QA, (const bf16*)(item + 8192), tid);
    g2l_64x64(SB, ((bf16*)(F.ws + WS_XB)) + (size_t)(c * 8 + h) * 4096, tid);
    f32x4 y[2]; rw_ld_frag_bf16(item + 24576, w, lane, y);
    LBAR();
#pragma unroll
    for (int i = 0; i < 2; ++i) { mma16<64>(y[i], QA + 16 * tr * RW_LD, RW_LD, SB + 16 * (tc0 + i) * RW_LD, RW_LD, fr, fq);
#pragma unroll
        for (int r = 0; r < 4; ++r) *(LAS float*)(YS + (16 * tr + 4 * fq + r) * RW_LDF + (16 * (tc0 + i) + fr) * 4) = y[i][r]; }
    LBAR();
    {
        const int t = tid >> 3, s8 = tid & 7, i0 = 8 * s8, hi0 = h * 64 + i0;
        float yv[8], s = 0.f;
#pragma unroll
        for (int e = 0; e < 8; ++e) { yv[e] = *(LAS float*)(YS + t * RW_LDF + (i0 + e) * 4); s += yv[e]; }
        s += __shfl_xor(s, 1); s += __shfl_xor(s, 2); s += __shfl_xor(s, 4);
        const float mean = s * (1.0f / 64.0f); float q = 0.f;
#pragma unroll
        for (int e = 0; e < 8; ++e) { yv[e] -= mean; q += yv[e] * yv[e]; }
        q += __shfl_xor(q, 1); q += __shfl_xor(q, 2); q += __shfl_xor(q, 4);
        const float rstd = 1.0f / sqrtf(q * (1.0f / 64.0f) + RWKV_LN_EPS);
        float xv[8], lg_[8], lb_[8], gt[8], o[8];
        rw_shift(F, c, t, 1024 + hi0, xv);
        ld8f(in_ptr(F, 23) + hi0, lg_); ld8f(in_ptr(F, 24) + hi0, lb_);
        bf16* mp = ((bf16*)(F.ws + WS_MIX)) + (size_t)(c * 64 + t) * 1024 + 512 + hi0;
        ld8bf(mp, gt);
        const float rk = ((float*)(F.ws + WS_RK))[(size_t)(c * 8 + h) * 64 + t];
#pragma unroll
        for (int e = 0; e < 8; ++e) o[e] = (yv[e] * rstd * lg_[e] + lb_[e] + rk * xv[e]) * gt[e];
        *(v4u*)mp = pack8(o);
    }
    LBAR();
    STAMP(15);
}
constexpr int RT_G = 4, RT_NG = 256 / RT_G;
constexpr int RT_LDQ = 272;
constexpr int RT_LDT = 144;
constexpr int RT_LDR = 272;
constexpr int RT_OFF_Q = 0, RT_OFF_K = 17408, RT_OFF_KT = 34816, RT_OFF_VT = 53248, RT_OFF_RT = 71680, RT_OFF_P = 106496, RT_OFF_OS = 0;
DI float ret_lg(int h) { return log1pf(-exp2f(-5.0f - (float)h)); }
DI int crow32(int reg, int hh) { return (reg & 3) + 8 * (reg >> 2) + 4 * hh; }
template <int KS> DI void mma32(f32x16& acc, lptr A, int lda, lptr Bt, int ldb, int r32, int hh) {
#pragma unroll
    for (int s = 0; s < KS; ++s) {
        const bf16x8 a = *(const LAS bf16x8*)(A + r32 * lda + (16 * s + 8 * hh) * 2);
        const bf16x8 b = *(const LAS bf16x8*)(Bt + r32 * ldb + (16 * s + 8 * hh) * 2);
        acc = __builtin_amdgcn_mfma_f32_32x32x16_bf16(a, b, acc, 0, 0, 0);
    }
}
DI void rope_cs(const Ctx& F, int j, int pos, float& cs, float& sn) {
    const f32x2* T = (const f32x2*)(F.ws + WS_ROPE); const f32x2 a = T[(pos >> 6) * 72 + j], b = T[(256 + (pos & 63)) * 72 + j];
    cs = a[0] * b[0] - a[1] * b[1]; sn = a[1] * b[0] + a[0] * b[1];
}
DI void ret_stage(const Ctx& F, int c, int h, bool need_qk) {
    const int tid = F.tid, t = tid >> 3, s8 = tid & 7; const lptr L = F.lds;
    const int pos = (c < 256 ? c * 64 : PAST_POS) + t;
    const bf16* row = ((bf16*)(F.ws + WS_PROJ)) + (size_t)(c * 64 + t) * N_AB;
    const float lg = ret_lg(h), qd = __expf(lg * (float)(t + 1)), kd = __expf(lg * (float)(63 - t));
    float cs[8], sn[8];
#pragma unroll
    for (int e = 0; e < 8; ++e) rope_cs(F, 8 * s8 + e, pos, cs[e], sn[e]);
    float x1[8], x2[8], o1[8], o2[8];
    ld8bf(row + 512 + h * 128 + 8 * s8, x1); ld8bf(row + 512 + h * 128 + 64 + 8 * s8, x2);
#pragma unroll
    for (int e = 0; e < 8; ++e) { o1[e] = (x1[e] * cs[e] - x2[e] * sn[e]) * 0.08838834764831845f; o2[e] = (x1[e] * sn[e] + x2[e] * cs[e]) * 0.08838834764831845f; }
    if (need_qk) { *(LAS v4u*)(L + RT_OFF_K + t * RT_LDQ + s8 * 16) = pack8(o1); *(LAS v4u*)(L + RT_OFF_K + t * RT_LDQ + 128 + s8 * 16) = pack8(o2); }
#pragma unroll
    for (int e = 0; e < 8; ++e) { *(LAS bf16*)(L + RT_OFF_KT + (8 * s8 + e) * RT_LDT + t * 2) = (bf16)f2bf(o1[e] * kd); *(LAS bf16*)(L + RT_OFF_KT + (64 + 8 * s8 + e) * RT_LDT + t * 2) = (bf16)f2bf(o2[e] * kd); }
    if (need_qk) {
        ld8bf(row + h * 128 + 8 * s8, x1); ld8bf(row + h * 128 + 64 + 8 * s8, x2);
#pragma unroll
        for (int e = 0; e < 8; ++e) { o1[e] = (x1[e] * cs[e] - x2[e] * sn[e]) * qd; o2[e] = (x1[e] * sn[e] + x2[e] * cs[e]) * qd; }
        *(LAS v4u*)(L + RT_OFF_Q + t * RT_LDQ + s8 * 16) = pack8(o1); *(LAS v4u*)(L + RT_OFF_Q + t * RT_LDQ + 128 + s8 * 16) = pack8(o2);
    }
    ld8bf(row + 1024 + h * 128 + 8 * s8, x1); ld8bf(row + 1024 + h * 128 + 64 + 8 * s8, x2);
#pragma unroll
    for (int e = 0; e < 8; ++e) { *(LAS bf16*)(L + RT_OFF_VT + (8 * s8 + e) * RT_LDT + t * 2) = (bf16)f2bf(x1[e]); *(LAS bf16*)(L + RT_OFF_VT + (64 + 8 * s8 + e) * RT_LDT + t * 2) = (bf16)f2bf(x2[e]); }
}
DI void ret_kv_update(lptr L, f32x16* r, float cdec, int w, int r32, int hh) {
#pragma unroll
    for (int i = 0; i < 2; ++i) { r[i] = r[i] * cdec; mma32<4>(r[i], L + RT_OFF_KT + 32 * (w >> 1) * RT_LDT, RT_LDT, L + RT_OFF_VT + 32 * (2 * (w & 1) + i) * RT_LDT, RT_LDT, r32, hh); }
}
DI void ret_ld_state(const float* S, f32x16* r, int w, int r32, int hh) {
#pragma unroll
    for (int i = 0; i < 2; ++i)
#pragma unroll
        for (int g = 0; g < 16; ++g) r[i][g] = S[(32 * (w >> 1) + crow32(g, hh)) * 128 + 32 * (2 * (w & 1) + i) + r32];
}
DI void ret_st_state(float* S, const f32x16* r, int w, int r32, int hh) {
#pragma unroll
    for (int i = 0; i < 2; ++i)
#pragma unroll
        for (int g = 0; g < 16; ++g) S[(32 * (w >> 1) + crow32(g, hh)) * 128 + 32 * (2 * (w & 1) + i) + r32] = r[i][g];
}
DI void ret_p1_item(const Ctx& F, int kind, int gi, int h) { STAMP_BEGIN();
    const int lane = F.lane, w = F.wave, r32 = lane & 31, hh = lane >> 5;
    const float cdec = __expf(ret_lg(h) * 64.0f);
    f32x16 r[2];
    int c0, nc;
    if (kind == 0) { c0 = gi * RT_G; nc = RT_G;
#pragma unroll
        for (int i = 0; i < 2; ++i)
#pragma unroll
            for (int g = 0; g < 16; ++g) r[i][g] = 0.f; }
    else { c0 = 256 + gi; nc = 1; ret_ld_state(in_ptr(F, 2) + (size_t)(gi * 4 + h) * 16384, r, w, r32, hh); }
    for (int c = c0; c < c0 + nc; ++c) {
        ret_stage(F, c, h, false);
        LBAR();
        ret_kv_update(F.lds, r, cdec, w, r32, hh);
        LBAR();
    }
    ret_st_state(kind == 0 ? ((float*)(F.ws + WS_XB + (size_t)NCH * 8 * 4096 * 2)) + (size_t)(gi * 4 + h) * 16384 : (F.out + O_RET_S) + (size_t)(gi * 4 + h) * 16384, r, w, r32, hh);
    STAMP(10);
}
DI void ret_scan(const Ctx& F, int vidx) {
    const int n = 4 * 16384;
    for (int e = vidx * 512 + F.tid; e < n; e += F.G * 512) {
        const int h = e >> 14; const float c4 = __expf(ret_lg(h) * 64.0f * (float)RT_G);
        float acc = 0.f;
#pragma unroll 4
        for (int g = 0; g < RT_NG; ++g) { float* p = ((float*)(F.ws + WS_XB + (size_t)NCH * 8 * 4096 * 2)) + (size_t)g * 65536 + e; acc = acc * c4 + *p; *p = acc; }
        (F.out + O_RET_P)[e] = acc;
    }
}
DI void ret_p3_item(const Ctx& F, int kind, int gi, int h) { STAMP_BEGIN();
    const int tid = F.tid, lane = F.lane, w = F.wave, r32 = lane & 31, hh = lane >> 5; const lptr L = F.lds;
    const float lg = ret_lg(h), cdec = __expf(lg * 64.0f);
    f32x16 r[2];
    int c0, nc;
    if (kind == 0) { c0 = gi * RT_G; nc = RT_G;
        if (gi == 0) {
#pragma unroll
            for (int i = 0; i < 2; ++i)
#pragma unroll
                for (int g = 0; g < 16; ++g) r[i][g] = 0.f; }
        else ret_ld_state(((float*)(F.ws + WS_XB + (size_t)NCH * 8 * 4096 * 2)) + (size_t)((gi - 1) * 4 + h) * 16384, r, w, r32, hh); }
    else { c0 = 256 + gi; nc = 1; ret_ld_state(in_ptr(F, 2) + (size_t)(gi * 4 + h) * 16384, r, w, r32, hh); }
    for (int c = c0; c < c0 + nc; ++c) {
        ret_stage(F, c, h, true);
#pragma unroll
        for (int i = 0; i < 2; ++i)
#pragma unroll
            for (int g4 = 0; g4 < 4; ++g4) { u32x2 v; v.x = pk2(r[i][4 * g4], r[i][4 * g4 + 1]); v.y = pk2(r[i][4 * g4 + 2], r[i][4 * g4 + 3]);
                *(LAS u32x2*)(L + RT_OFF_RT + (32 * (2 * (w & 1) + i) + r32) * RT_LDR + (32 * (w >> 1) + 8 * g4 + 4 * hh) * 2) = v; }
        LBAR();
        if (w < 4) { const int tb = w & 1, kb = w >> 1;
            f32x16 s;
#pragma unroll
            for (int g = 0; g < 16; ++g) s[g] = 0.f;
            if (kb <= tb) mma32<8>(s, L + RT_OFF_Q + 32 * tb * RT_LDQ, RT_LDQ, L + RT_OFF_K + 32 * kb * RT_LDQ, RT_LDQ, r32, hh);
            const int tp = 32 * kb + r32; const float f = __expf(-lg * (float)(tp + 1));
#pragma unroll
            for (int g = 0; g < 16; ++g) { const int tq = 32 * tb + crow32(g, hh); const float pv = tq >= tp ? s[g] * f : 0.f;
                *(LAS bf16*)(L + RT_OFF_P + tq * 144 + tp * 2) = (bf16)f2bf(pv); } }
        LBAR();
        const int tb = w & 1, db = w >> 1;
        f32x16 o;
#pragma unroll
        for (int g = 0; g < 16; ++g) o[g] = 0.f;
        mma32<4>(o, L + RT_OFF_P + 32 * tb * 144, 144, L + RT_OFF_VT + 32 * db * RT_LDT, RT_LDT, r32, hh);
        mma32<8>(o, L + RT_OFF_Q + 32 * tb * RT_LDQ, RT_LDQ, L + RT_OFF_RT + 32 * db * RT_LDR, RT_LDR, r32, hh);
        ret_kv_update(L, r, cdec, w, r32, hh);
        LBAR();
#pragma unroll
        for (int g = 0; g < 16; ++g) *(LAS float*)(L + RT_OFF_OS + (32 * tb + crow32(g, hh)) * 528 + (32 * db + r32) * 4) = o[g];
        LBAR();
        {
            const int t = tid >> 3, s8 = tid & 7;
            float v[16], s = 0.f;
#pragma unroll
            for (int e = 0; e < 16; ++e) { v[e] = *(LAS float*)(L + RT_OFF_OS + t * 528 + (16 * s8 + e) * 4); s += v[e]; }
            s += __shfl_xor(s, 1); s += __shfl_xor(s, 2); s += __shfl_xor(s, 4);
            const float mean = s * (1.0f / 128.0f); float q = 0.f;
#pragma unroll
            for (int e = 0; e < 16; ++e) { v[e] -= mean; q += v[e] * v[e]; }
            q += __shfl_xor(q, 1); q += __shfl_xor(q, 2); q += __shfl_xor(q, 4);
            const float rstd = 1.0f / sqrtf(q * (1.0f / 128.0f) + LN_EPS);
            const bf16* gp = ((bf16*)(F.ws + WS_PROJ)) + (size_t)(c * 64 + t) * N_AB + 1536 + h * 128 + 16 * s8;
            bf16* op = ((bf16*)(F.ws + WS_MIX)) + (size_t)(c * 64 + t) * 1024 + h * 128 + 16 * s8;
#pragma unroll
            for (int q2 = 0; q2 < 2; ++q2) { float gt[8], gn[8], o8[8]; ld8bf(gp + 8 * q2, gt); ld8f(in_ptr(F, 13) + h * 128 + 16 * s8 + 8 * q2, gn);
#pragma unroll
                for (int e = 0; e < 8; ++e) o8[e] = gt[e] / (1.0f + __expf(-gt[e])) * (v[8 * q2 + e] * rstd * gn[e]);
                *(v4u*)(op + 8 * q2) = pack8(o8); }
        }
        LBAR();
    }
    STAMP(11);
}
constexpr int CV_OFF_U = 0, CV_OFF_Y = 63488;
DI void conv_item(const Ctx& F, int it) { STAMP_BEGIN();
    const int tid = F.tid; const lptr L = F.lds;
    const int c = it >> 1, half = it & 1;
    const int seq_t0 = c < 256 ? 0 : c * 64;
    const int ta = c * 64 + 32 * half;
    const int b = c - 256;
    for (int q = tid; q < 62 * 64; q += 512) { const int rr = q >> 6, cg = q & 63, row = ta - 30 + rr;
        float u[8];
        if (row >= seq_t0) { float a[8], g[8]; const bf16* p = ((bf16*)(F.ws + WS_PROJ)) + (size_t)row * N_CD + 8 * cg; ld8bf(p, a); ld8bf(p + 512, g);
#pragma unroll
            for (int e = 0; e < 8; ++e) u[e] = a[e] * sigmoidf_(g[e]); }
        else if (c >= 256) ld8f(in_ptr(F, 5) + ((size_t)b * 30 + (30 + row - seq_t0)) * 512 + 8 * cg, u);
        else {
#pragma unroll
            for (int e = 0; e < 8; ++e) u[e] = 0.f; }
        *(LAS v4u*)(L + CV_OFF_U + rr * 1024 + cg * 16) = pack8(u);
        const int seq_last = c < 256 ? TP - 1 : c * 64 + 63;
        if (row > seq_last - 30 && row >= seq_t0 && ((c == 255 && half == 1) || (c >= 256 && half == 1))) {
            float* dst = (c < 256 ? (F.out + O_CONV_P) : (F.out + O_CONV_S) + (size_t)b * 30 * 512) + (size_t)(row - (seq_last - 29)) * 512 + 8 * cg; st8f(dst, u); }
    }
    LBAR();
    {
        const int ch = tid; float wgt[31];
#pragma unroll
        for (int k = 0; k < 31; ++k) wgt[k] = in_ptr(F, 27)[k * 512 + ch];
        const float bias = in_ptr(F, 28)[ch];
        float uv[62];
#pragma unroll
        for (int r = 0; r < 62; ++r) uv[r] = bf2f(*(LAS bf16*)(L + CV_OFF_U + r * 1024 + ch * 2));
#pragma unroll
        for (int t = 0; t < 32; ++t) { float acc = bias;
#pragma unroll
            for (int k = 0; k < 31; ++k) acc += wgt[k] * uv[t + k];
            *(LAS float*)(L + CV_OFF_Y + t * 2048 + ch * 4) = acc; }
    }
    LBAR();
    {
        const int t = tid >> 4, sub = tid & 15; f32x4 v[8]; float s = 0.f;
#pragma unroll
        for (int k = 0; k < 8; ++k) { v[k] = *(LAS f32x4*)(L + CV_OFF_Y + t * 2048 + (64 * k + 4 * sub) * 4); s += (v[k][0] + v[k][1]) + (v[k][2] + v[k][3]); }
        s += __shfl_xor(s, 1); s += __shfl_xor(s, 2); s += __shfl_xor(s, 4); s += __shfl_xor(s, 8);
        const float mean = s * (1.0f / 512.0f); float q = 0.f;
#pragma unroll
        for (int k = 0; k < 8; ++k) { v[k] = v[k] - mean; q += (v[k][0] * v[k][0] + v[k][1] * v[k][1]) + (v[k][2] * v[k][2] + v[k][3] * v[k][3]); }
        q += __shfl_xor(q, 1); q += __shfl_xor(q, 2); q += __shfl_xor(q, 4); q += __shfl_xor(q, 8);
        const float rstd = 1.0f / sqrtf(q * (1.0f / 512.0f) + LN_EPS);
        bf16* op = ((bf16*)(F.ws + WS_MIX)) + (size_t)(ta + t) * 1024;
#pragma unroll
        for (int k = 0; k < 8; ++k) { const int ch = 64 * k + 4 * sub; const f32x4 g = *(const f32x4*)(in_ptr(F, 29) + ch), bb = *(const f32x4*)(in_ptr(F, 30) + ch);
            f32x4 o;
#pragma unroll
            for (int e = 0; e < 4; ++e) { const float z = v[k][e] * rstd * g[e] + bb[e]; o[e] = z / (1.0f + __expf(-z)); }
            *(u32x2*)(op + ch) = pack4(o); }
    }
    LBAR();
    STAMP(17);
}

constexpr int AT_OFF_K = 0, AT_OFF_VT = 27648, AT_OFF_TBL = 53248, AT_LDK = 144, AT_LDV = 400;
DI void attn_item(const Ctx& F, int c, int kh) { STAMP_BEGIN();
    const int tid = F.tid, lane = F.lane, w = F.wave, r32 = lane & 31, hh = lane >> 5; const lptr L = F.lds;
    const int b = c - 256;
    const int row0 = c * 64 - 128;
    const int kvalid0 = c >= 256 ? 0 : (c == 0 ? 128 : (c == 1 ? 64 : 0));
    const bool last = (c == 255) || (c >= 256);
    for (int q = tid; q < 192 * 8; q += 512) { const int key = q >> 3, e = q & 7; const int pos = c >= 256 ? PAST_POS + (key - 128) : row0 + key;
        float cs, sn; rope_cs(F, 64 + e, pos < 0 ? 0 : pos, cs, sn); *(LAS f32x2*)(L + AT_OFF_TBL + q * 8) = (f32x2){cs, sn}; }
    LBAR();
    for (int q = tid; q < 192 * 8; q += 512) { const int key = q >> 3, s8 = q & 7;
        float kx[8], vx[8];
        if (c >= 256 && key < 128) { ld8f(in_ptr(F, 6) + (((size_t)b * 128 + key) * 2 + kh) * 64 + 8 * s8, kx); ld8f(in_ptr(F, 7) + (((size_t)b * 128 + key) * 2 + kh) * 64 + 8 * s8, vx); }
        else if (key < kvalid0) {
#pragma unroll
            for (int e = 0; e < 8; ++e) { kx[e] = 0.f; vx[e] = 0.f; } }
        else { const int row = c >= 256 ? c * 64 + (key - 128) : row0 + key; const bf16* p = ((bf16*)(F.ws + WS_PROJ)) + (size_t)row * N_CD;
            ld8bf(p + 1536 + kh * 64 + 8 * s8, kx); ld8bf(p + 1664 + kh * 64 + 8 * s8, vx);
            if (s8 < 2) {
                float px[8]; ld8bf(p + 1536 + kh * 64 + 8 * (s8 ^ 1), px);
#pragma unroll
                for (int e = 0; e < 8; ++e) { const f32x2 t2 = *(const LAS f32x2*)(L + AT_OFF_TBL + (key * 8 + e) * 8); const float cs = t2[0], sn = t2[1]; kx[e] = s8 == 0 ? kx[e] * cs - px[e] * sn : px[e] * sn + kx[e] * cs; }
            } }
        *(LAS v4u*)(L + AT_OFF_K + key * AT_LDK + s8 * 16) = pack8(kx);
#pragma unroll
        for (int e = 0; e < 8; ++e) *(LAS bf16*)(L + AT_OFF_VT + (8 * s8 + e) * AT_LDV + key * 2) = (bf16)f2bf(vx[e]);
        if (last && key >= 64) { float* kd = (c == 255 ? (F.out + O_K_P) : (F.out + O_K_S) + (size_t)b * 16384) + ((size_t)(key - 64) * 2 + kh) * 64 + 8 * s8;
            float* vd = (c == 255 ? (F.out + O_V_P) : (F.out + O_V_S) + (size_t)b * 16384) + ((size_t)(key - 64) * 2 + kh) * 64 + 8 * s8; st8f(kd, kx); st8f(vd, vx); }
    }
    const int hq = 4 * kh + (w >> 1), qrow = c * 64 + 32 * (w & 1) + r32;
    bf16x8 qf[4];
    { const bf16* qp = ((bf16*)(F.ws + WS_PROJ)) + (size_t)qrow * N_CD + 1024 + hq * 64;
#pragma unroll
        for (int s = 0; s < 4; ++s) { float x[8]; ld8bf(qp + 16 * s + 8 * hh, x);
            if (s == 0) { float px[8]; ld8bf(qp + 8 * (hh ^ 1), px);
#pragma unroll
                for (int e = 0; e < 8; ++e) { const f32x2 t2 = *(const LAS f32x2*)(L + AT_OFF_TBL + ((128 + 32 * (w & 1) + r32) * 8 + e) * 8); const float cs = t2[0], sn = t2[1]; x[e] = hh == 0 ? x[e] * cs - px[e] * sn : px[e] * sn + x[e] * cs; } }
            const v4u pk = pack8(x); qf[s] = __builtin_bit_cast(bf16x8, pk); } }
    LBAR();
    f32x16 x[6];
#pragma unroll
    for (int kb = 0; kb < 6; ++kb) {
#pragma unroll
        for (int g = 0; g < 16; ++g) x[kb][g] = 0.f;
#pragma unroll
        for (int s = 0; s < 4; ++s) { const bf16x8 a = *(const LAS bf16x8*)(L + AT_OFF_K + (32 * kb + r32) * AT_LDK + (16 * s + 8 * hh) * 2);
            x[kb] = __builtin_amdgcn_mfma_f32_32x32x16_bf16(a, qf[s], x[kb], 0, 0, 0); }
        __builtin_amdgcn_sched_barrier(0); }
    const float sink = in_ptr(F, 31)[hq];
    float m = sink;
#pragma unroll
    for (int kb = 0; kb < 6; ++kb)
#pragma unroll
        for (int g = 0; g < 16; ++g) { float sv = x[kb][g] * 0.125f; if (32 * kb < kvalid0) sv = -1e30f; x[kb][g] = sv; m = fmaxf(m, sv); }
    m = fmaxf(m, __shfl_xor(m, 32));
    float den = 0.f;
#pragma unroll
    for (int kb = 0; kb < 6; ++kb)
#pragma unroll
        for (int g = 0; g < 16; ++g) { const float e = __expf(x[kb][g] - m); x[kb][g] = e; den += e; }
    den += __shfl_xor(den, 32);
    den += __expf(sink - m);
    const float rden = 1.0f / den;
#pragma unroll
    for (int kb = 0; kb < 6; ++kb)
#pragma unroll
        for (int g = 0; g < 16; ++g) x[kb][g] *= rden;
    bf16* op = ((bf16*)(F.ws + WS_MIX)) + (size_t)(c * 64 + 32 * (w & 1)) * 1024 + 512 + hq * 64;
#pragma unroll
    for (int db = 0; db < 2; ++db) {
        f32x16 o;
#pragma unroll
        for (int g = 0; g < 16; ++g) o[g] = 0.f;
#pragma unroll
        for (int kb = 0; kb < 6; ++kb)
#pragma unroll
            for (int s = 0; s < 2; ++s) {
                float pv[8];
#pragma unroll
                for (int j = 0; j < 8; ++j) pv[j] = x[kb][8 * s + j];
                const v4u pk = pack8(pv); const bf16x8 pa = __builtin_bit_cast(bf16x8, pk);
                const lptr vp = L + AT_OFF_VT + (32 * db + r32) * AT_LDV + (32 * kb + 16 * s + 4 * hh) * 2;
                const u32x2 lo = *(const LAS u32x2*)vp, hi = *(const LAS u32x2*)(vp + 16);
                v4u bv; bv.x = lo.x; bv.y = lo.y; bv.z = hi.x; bv.w = hi.y;
                o = __builtin_amdgcn_mfma_f32_32x32x16_bf16(pa, __builtin_bit_cast(bf16x8, bv), o, 0, 0, 0);
                __builtin_amdgcn_sched_barrier(0); }
#pragma unroll
        for (int g = 0; g < 16; ++g) op[(size_t)crow32(g, hh) * 1024 + 32 * db + r32] = (bf16)f2bf(o[g]);
    }
    LBAR();
    STAMP(16);
}
DI float wave_sum(float v) {
#pragma unroll
    for (int o = 1; o < 64; o <<= 1) v += __shfl_xor(v, o);
    return v;
}
DI void p0_transpose_item(const float* W, int K, int N, bf16* WT, int k0, int n0, int dst_row0, const float* gk, LAS float* scr, int lane) {
    {   const int kr = lane >> 3, n4 = (lane & 7) * 4; f32x4 v[8];
#pragma unroll
        for (int i = 0; i < 8; ++i) v[i] = *(const GAS f32x4*)(W + (size_t)(k0 + kr + 8 * i) * N + n0 + n4);
#pragma unroll
        for (int i = 0; i < 8; ++i) { const int kk = kr + 8 * i; const float g = gk ? gk[k0 + kk] : 1.0f;
#pragma unroll
            for (int e = 0; e < 4; ++e) scr[kk * 33 + n4 + e] = v[i][e] * g; } }
    LDS_WAIT(); asm volatile("" ::: "memory");
    const int c = lane & 7;
#pragma unroll
    for (int j = 0; j < 4; ++j) { const int n = (lane >> 3) + 8 * j; const LAS float* s = scr + (8 * c) * 33 + n;
        v4u o; o.x = pk2(s[0 * 33], s[1 * 33]); o.y = pk2(s[2 * 33], s[3 * 33]); o.z = pk2(s[4 * 33], s[5 * 33]); o.w = pk2(s[6 * 33], s[7 * 33]);
        *(GAS v4u*)(WT + (size_t)(dst_row0 + n) * K + k0 + 8 * c) = o; }
    LDS_WAIT(); asm volatile("" ::: "memory");
}
DI void p0_prologue(const Ctx& F) {
    LAS float* scr = (LAS float*)(F.lds + F.wave * 16384);
    const int gw = F.vcu * NWAVES + F.wave, NGW = F.G * NWAVES, lane = F.lane;
    for (int q = F.vcu * 512 + F.tid; q < (256 + 64) * 72; q += F.G * 512) { const int r = q / 72, j = q % 72; const int pos = r < 256 ? 64 * r : r - 256;
        const double inv = j < 64 ? exp((double)j * (-2.0 * log(10000.0) / 128.0)) : exp((double)(j - 64) * (-2.0 * log(500000.0) / 16.0));
        const double a = (double)pos * inv, k = rint(a * 0.15915494309189535), rr = a - k * 6.283185307179586;
        ((f32x2*)(F.ws + WS_ROPE))[q] = (f32x2){(float)cos(rr), (float)sin(rr)}; }
    constexpr int I_INAB = 16 * (N_AB / 32), I_SQ = 16 * 32, I_INCD = 16 * (N_CD / 32), I_GU = 16 * (D_FF / 32), I_DN = (D_FF / 64) * 32;
    constexpr int NITEMS = I_INAB + 2 * I_SQ + I_INCD + 4 * I_GU + 2 * I_DN;
    for (int it = gw; it < NITEMS; it += NGW) {
        int r = it;
        if (r < I_INAB) { const int nb = N_AB / 32; p0_transpose_item(in_ptr(F, 11), 1024, N_AB, ((bf16*)(F.ws + WS_W_INAB)), 64 * (r / nb), 32 * (r % nb), 32 * (r % nb), in_ptr(F, 8), scr, lane); continue; } r -= I_INAB;
        if (r < I_SQ) { p0_transpose_item(in_ptr(F, 12), 1024, 1024, ((bf16*)(F.ws + WS_W_OUTAB)), 64 * (r / 32), 32 * (r % 32), 32 * (r % 32), nullptr, scr, lane); continue; } r -= I_SQ;
        if (r < I_INCD) { const int nb = N_CD / 32; p0_transpose_item(in_ptr(F, 25), 1024, N_CD, ((bf16*)(F.ws + WS_W_INCD)), 64 * (r / nb), 32 * (r % nb), 32 * (r % nb), in_ptr(F, 8) + 1024, scr, lane); continue; } r -= I_INCD;
        if (r < I_SQ) { p0_transpose_item(in_ptr(F, 26), 1024, 1024, ((bf16*)(F.ws + WS_W_OUTCD)), 64 * (r / 32), 32 * (r % 32), 32 * (r % 32), nullptr, scr, lane); continue; } r -= I_SQ;
        if (r < 4 * I_GU) { const int which = r / I_GU, l = which >> 1, up = which & 1, q = r % I_GU, nb = D_FF / 32, n0 = 32 * (q % nb);
            p0_transpose_item((up ? in_ptr(F, 33) : in_ptr(F, 32)) + (size_t)l * 1024 * D_FF, 1024, D_FF, ((bf16*)(F.ws + WS_W_GU)) + (size_t)l * N_GU * 1024, 64 * (q / nb), n0, 256 * (n0 >> 7) + 128 * up + (n0 & 127), in_ptr(F, 9) + l * 1024, scr, lane); continue; } r -= 4 * I_GU;
        { const int l = r / I_DN, q = r % I_DN; p0_transpose_item(in_ptr(F, 34) + (size_t)l * D_FF * 1024, D_FF, 1024, ((bf16*)(F.ws + WS_W_DN)) + (size_t)l * 1024 * D_FF, 64 * (q / 32), 32 * (q % 32), 32 * (q % 32), nullptr, scr, lane); }
    }
    for (int m = gw; m < T_ALL; m += NGW) {
        const float* xrow = m < TP ? in_ptr(F, 0) + (size_t)m * 1024 : in_ptr(F, 1) + (size_t)(m - TP) * 1024;
        const GAS f32x4* xr = (const GAS f32x4*)xrow + lane; f32x4 v[4]; float s = 0.f;
#pragma unroll
        for (int j = 0; j < 4; ++j) { v[j] = xr[64 * j]; s += (v[j][0] * v[j][0] + v[j][1] * v[j][1]) + (v[j][2] * v[j][2] + v[j][3] * v[j][3]); }
        s = wave_sum(s);
        GAS unsigned long long* o8 = (GAS unsigned long long*)(((bf16*)(F.ws + WS_XB)) + (size_t)m * 1024) + lane;
#pragma unroll
        for (int j = 0; j < 4; ++j) o8[64 * j] = (unsigned long long)pk2(v[j][0], v[j][1]) | ((unsigned long long)pk2(v[j][2], v[j][3]) << 32);
        if (lane < 16) ((float*)(F.ws + WS_SS))[(size_t)m * 16 + lane] = lane == 0 ? s : 0.f;
    }
}
DI void final_norm(const Ctx& F) {
    const int gw = F.vcu * NWAVES + F.wave, NGW = F.G * NWAVES, lane = F.lane;
    for (int m = gw; m < T_ALL; m += NGW) {
        const float rs = pg8::row_rstd(((float*)(F.ws + WS_SS)), m);
        GAS f32x4* xr = (GAS f32x4*)((F.out + O_Y) + (size_t)m * 1024) + lane; const f32x4* gp = (const f32x4*)in_ptr(F, 10) + lane;
#pragma unroll
        for (int j = 0; j < 4; ++j) { const f32x4 v = xr[64 * j], g = gp[64 * j]; xr[64 * j] = v * rs * g; }
    }
}

constexpr int N_PHASES = 16;
struct Args { const float* in[35]; float* out; unsigned char* ws; int ph_lo, ph_hi, li, pad; };
__global__ void __launch_bounds__(NWAVES * 64, 2) hybrid_fwd(Args args) {
    extern __shared__ __attribute__((aligned(16))) unsigned char lds_raw[];
    Ctx F;
    F.lds = (lptr)lds_raw;
    volatile LAS unsigned* MISC = (volatile LAS unsigned*)(F.lds + MISC_OFF);
    F.tid = threadIdx.x; F.lane = F.tid & 63; F.wave = __builtin_amdgcn_readfirstlane(F.tid >> 6);
    F.G = gridDim.x; { const int bx = blockIdx.x; F.vcu = (F.G % 8 == 0) ? (bx % 8) * (F.G / 8) + bx / 8 : bx; }
    unsigned char* ws = args.ws;
    F.out = args.out; F.ws = args.ws;
    for (int u = F.tid; u < (LDS_BYTES - RING_BYTES) / 4; u += NWAVES * 64) ((LAS unsigned*)(F.lds + RING_BYTES))[u] = 0u;
    __syncthreads();
    XcdBarrier bar = xcd_barrier_post((unsigned*)(ws + WS_CTL) + 1024 + args.li * XCD_BAR_WORDS, MISC + 8);
    const int lo = args.ph_lo, hi = args.ph_hi, G = F.G, vcu = F.vcu;
#ifndef PH_MASK
#define PH_MASK 0xFFFF
#endif
#define IN(k) (((PH_MASK >> (k)) & 1) && lo <= (k) && (k) < hi)
#ifndef PROBE_LO
#define PROBE_LO -1
#define PROBE_HI -1
#endif
    unsigned long long pr_t0 = 0, pr_dt = 0; F.pr = &pr_dt;
#define SEAM(k) do { if (IN(k) && IN((k) + 1)) xcd_barrier(bar); \
        if ((k) + 1 == PROBE_LO) pr_t0 = __builtin_amdgcn_s_memrealtime(); if ((k) == PROBE_HI) pr_dt = __builtin_amdgcn_s_memrealtime() - pr_t0; } while (0)
    if (PROBE_LO == 0) pr_t0 = __builtin_amdgcn_s_memrealtime();
    typedef pg8::bf16_t gb;
    if (IN(0)) { p0_prologue(F); } SEAM(0);
    if (IN(1)) { pg8::Gemm g{(const gb*)((bf16*)(F.ws + WS_XB)), (const gb*)((bf16*)(F.ws + WS_W_INAB)), T_ALL, N_AB, 1024}; pg8::StaticOrder S; S.init(T_ALL, N_AB, G, (int)blockIdx.x);
        pg8::EpiNormBf16 E{(gb*)((bf16*)(F.ws + WS_PROJ)), N_AB, ((float*)(F.ws + WS_SS))}; pg8::gemm_phase<pg8::EpiNormBf16, pg8::StaticOrder, true, true>(F.lds, g, S, E); } SEAM(1);
    if (IN(2)) {
        for (int it = vcu; it < 320; it += G) { if (it < 256) ret_p1_item(F, 0, it >> 2, it & 3); else ret_p1_item(F, 1, (it - 256) >> 2, it & 3); }
        { RwPre R; int it = (vcu + G - (64 % G)) % G, hcur = -1;
            if (it < NCH * 8) rw_prefetch(F, it >> 3, it & 7, R);
            for (; it < NCH * 8; it += G) { const int h = it & 7, nx = it + G; if (h != hcur) { rw_load_params(F, h); hcur = h; }
                rwkv_p1_item(F, it >> 3, h, R, nx < NCH * 8, nx >> 3, nx & 7); } }
    } SEAM(2);
    if (IN(3)) { for (int it = vcu; it < 128; it += G) rwkv_l1_item(F, it & 15, it >> 4);
        ret_scan(F, (vcu + G - (128 % G)) % G); } SEAM(3);
    if (IN(4)) { for (int it = vcu; it < 8; it += G) rwkv_l2_item(F, it);
        for (int it = (vcu + G - (8 % G)) % G; it < 320; it += G) { if (it < 256) ret_p3_item(F, 0, it >> 2, it & 3); else ret_p3_item(F, 1, (it - 256) >> 2, it & 3); } } SEAM(4);
    if (IN(5)) { for (int it = vcu; it < 256; it += G) { if (it < 128) rwkv_l3_item(F, 0, it & 15, it >> 4); else rwkv_l3_item(F, 1, (it - 128) >> 3, it & 7); } } SEAM(5);
    if (IN(6)) { for (int it = vcu; it < NCH * 8; it += G) rwkv_p3_item(F, it >> 3, it & 7); } SEAM(6);
    if (IN(7)) {
        { const pg8::ResidOp<0, false> rs{in_ptr(F, 1), TP, nullptr, (gb*)((bf16*)(F.ws + WS_XB))}; for (int tl = vcu; tl < 256; tl += G) gemm_small64(F, ((bf16*)(F.ws + WS_MIX)), ((bf16*)(F.ws + WS_W_OUTAB)), 1024, tl, rs, ((float*)(F.ws + WS_SS))); }
        pg8::Gemm g{(const gb*)((bf16*)(F.ws + WS_MIX)), (const gb*)((bf16*)(F.ws + WS_W_OUTAB)), TP, 1024, 1024}; pg8::StaticOrder S; S.init(TP, 1024, G, (int)blockIdx.x);
        pg8::EpiResid<0, false> E{{in_ptr(F, 0), 0, nullptr, (gb*)((bf16*)(F.ws + WS_XB))}, ((float*)(F.ws + WS_SS))}; pg8::gemm_phase<pg8::EpiResid<0, false>, pg8::StaticOrder, true, true>(F.lds, g, S, E); } SEAM(7);
    if (IN(8)) { pg8::Gemm g{(const gb*)((bf16*)(F.ws + WS_XB)), (const gb*)((bf16*)(F.ws + WS_W_GU)), T_ALL, N_GU, 1024}; pg8::StaticOrder S; S.init(T_ALL, N_GU, G, (int)blockIdx.x);
        pg8::EpiSwiGLU E{(gb*)((bf16*)(F.ws + WS_PROJ)), D_FF, ((float*)(F.ws + WS_SS))}; pg8::gemm_phase<pg8::EpiSwiGLU, pg8::StaticOrder, true, true>(F.lds, g, S, E); } SEAM(8);
    if (IN(9)) {
        { const pg8::ResidOp<1, false> rs{nullptr, 0, nullptr, (gb*)((bf16*)(F.ws + WS_XB))}; for (int tl = vcu; tl < 256; tl += G) gemm_small64(F, ((bf16*)(F.ws + WS_PROJ)), ((bf16*)(F.ws + WS_W_DN)), D_FF, tl, rs, ((float*)(F.ws + WS_SS))); }
        pg8::Gemm g{(const gb*)((bf16*)(F.ws + WS_PROJ)), (const gb*)((bf16*)(F.ws + WS_W_DN)), TP, 1024, D_FF}; pg8::StaticOrder S; S.init(TP, 1024, G, (int)blockIdx.x);
        pg8::EpiResid<1, false> E{{nullptr, 0, nullptr, (gb*)((bf16*)(F.ws + WS_XB))}, ((float*)(F.ws + WS_SS))}; pg8::gemm_phase<pg8::EpiResid<1, false>, pg8::StaticOrder, true, true>(F.lds, g, S, E); } SEAM(9);
    if (IN(10)) { pg8::Gemm g{(const gb*)((bf16*)(F.ws + WS_XB)), (const gb*)((bf16*)(F.ws + WS_W_INCD)), T_ALL, N_CD, 1024}; pg8::StaticOrder S; S.init(T_ALL, N_CD, G, (int)blockIdx.x);
        pg8::EpiNormBf16 E{(gb*)((bf16*)(F.ws + WS_PROJ)), N_CD, ((float*)(F.ws + WS_SS))}; pg8::gemm_phase<pg8::EpiNormBf16, pg8::StaticOrder, true, true>(F.lds, g, S, E); } SEAM(10);
    if (IN(11)) {
        for (int it = vcu; it < 544; it += G) attn_item(F, it >> 1, it & 1);
        for (int it = (vcu + G - (32 % G)) % G; it < 544; it += G) conv_item(F, it);
    } SEAM(11);
    if (IN(12)) {
        { const pg8::ResidOp<1, false> rs{nullptr, 0, nullptr, (gb*)((bf16*)(F.ws + WS_XB))}; for (int tl = vcu; tl < 256; tl += G) gemm_small64(F, ((bf16*)(F.ws + WS_MIX)), ((bf16*)(F.ws + WS_W_OUTCD)), 1024, tl, rs, ((float*)(F.ws + WS_SS))); }
        pg8::Gemm g{(const gb*)((bf16*)(F.ws + WS_MIX)), (const gb*)((bf16*)(F.ws + WS_W_OUTCD)), TP, 1024, 1024}; pg8::StaticOrder S; S.init(TP, 1024, G, (int)blockIdx.x);
        pg8::EpiResid<1, false> E{{nullptr, 0, nullptr, (gb*)((bf16*)(F.ws + WS_XB))}, ((float*)(F.ws + WS_SS))}; pg8::gemm_phase<pg8::EpiResid<1, false>, pg8::StaticOrder, true, true>(F.lds, g, S, E); } SEAM(12);
    if (IN(13)) { pg8::Gemm g{(const gb*)((bf16*)(F.ws + WS_XB)), (const gb*)(((bf16*)(F.ws + WS_W_GU)) + (size_t)N_GU * 1024), T_ALL, N_GU, 1024}; pg8::StaticOrder S; S.init(T_ALL, N_GU, G, (int)blockIdx.x);
        pg8::EpiSwiGLU E{(gb*)((bf16*)(F.ws + WS_PROJ)), D_FF, ((float*)(F.ws + WS_SS))}; pg8::gemm_phase<pg8::EpiSwiGLU, pg8::StaticOrder, true, true>(F.lds, g, S, E); } SEAM(13);
    if (IN(14)) {
        { const pg8::ResidOp<1, true> rs{nullptr, 0, (F.out + O_Y), (gb*)((bf16*)(F.ws + WS_XB))}; for (int tl = vcu; tl < 256; tl += G) gemm_small64(F, ((bf16*)(F.ws + WS_PROJ)), (((bf16*)(F.ws + WS_W_DN)) + (size_t)1024 * D_FF), D_FF, tl, rs, ((float*)(F.ws + WS_SS))); }
        pg8::Gemm g{(const gb*)((bf16*)(F.ws + WS_PROJ)), (const gb*)(((bf16*)(F.ws + WS_W_DN)) + (size_t)1024 * D_FF), TP, 1024, D_FF}; pg8::StaticOrder S; S.init(TP, 1024, G, (int)blockIdx.x);
        pg8::EpiResid<1, true> E{{nullptr, 0, (F.out + O_Y), (gb*)((bf16*)(F.ws + WS_XB))}, ((float*)(F.ws + WS_SS))}; pg8::gemm_phase<pg8::EpiResid<1, true>, pg8::StaticOrder, true, true>(F.lds, g, S, E); } SEAM(14);
    if (IN(15)) final_norm(F);
    if (PROBE_HI == 15) { asm volatile("s_waitcnt vmcnt(0)" ::: "memory"); pr_dt = __builtin_amdgcn_s_memrealtime() - pr_t0; }
    if ((PROBE_LO >= 0 || PROBE_SUB >= 0) && blockIdx.x == 0) { const unsigned long long t1 = __builtin_amdgcn_s_memrealtime(); while (__builtin_amdgcn_s_memrealtime() - t1 < pr_dt) __builtin_amdgcn_s_sleep(8); }
#undef IN
#undef SEAM
}

#ifndef MK_SPLIT
#define MK_SPLIT 0
#endif
extern "C" void kernel_launch(void* const* d_in, const int* in_sizes, int n_in, void* d_out, int out_size, void* d_ws, size_t ws_size, hipStream_t stream) {
    static int grid = 0;
    if (grid == 0) {
        if (n_in != 35 || out_size != (int)O_END || ws_size < WS_END) { fprintf(stderr, "kernel_launch: unexpected shapes: n_in %d out %d ws %zu\n", n_in, out_size, ws_size); grid = -1; return; }
        int dev = 0, cus = 0, per_cu = 0;
        if (hipGetDevice(&dev) != hipSuccess || hipDeviceGetAttribute(&cus, hipDeviceAttributeMultiprocessorCount, dev) != hipSuccess) { grid = -1; return; }
        if (hipFuncSetAttribute((const void*)hybrid_fwd, hipFuncAttributeMaxDynamicSharedMemorySize, LDS_BYTES) != hipSuccess) { fprintf(stderr, "kernel_launch: hipFuncSetAttribute failed\n"); grid = -1; return; }
        if (hipOccupancyMaxActiveBlocksPerMultiprocessor(&per_cu, (const void*)hybrid_fwd, NWAVES * 64, LDS_BYTES) != hipSuccess || per_cu < 1) { fprintf(stderr, "kernel_launch: occupancy query says %d blocks per CU; nothing launched\n", per_cu); (void)hipGetLastError(); grid = -1; return; }
        grid = cus;
    }
    if (grid < 0) return;
    (void)hipMemsetAsync((char*)d_ws + WS_CTL, 0, CTL_ZERO_BYTES, stream);
    Args a{};
    for (int i = 0; i < 35; ++i) a.in[i] = (const float*)d_in[i];
    a.out = (float*)d_out; a.ws = (unsigned char*)d_ws;
#if MK_SPLIT
    for (int p = 0; p < N_PHASES; ++p) { a.ph_lo = p; a.ph_hi = p + 1; a.li = 0; hipLaunchKernelGGL(hybrid_fwd, dim3(grid), dim3(NWAVES * 64), LDS_BYTES, stream, a); }
#else
    a.ph_lo = 0; a.ph_hi = N_PHASES; a.li = 0;
    hipLaunchKernelGGL(hybrid_fwd, dim3(grid), dim3(NWAVES * 64), LDS_BYTES, stream, a);
#endif
}
```

```cpp
#include <hip/hip_runtime.h>
#include <cstdio>
#include <cstdint>
#include <cmath>

constexpr int D_MODEL = 1024, TP = 16384, NSAMP = 16, LS = 64, T_ALL = TP + NSAMP * LS;
constexpr int NCH = T_ALL / 64;
constexpr int N_AB = 3840, N_CD = 1792, D_FF = 2816, N_GU = 2 * D_FF;
constexpr int PAST_POS = 4096;
constexpr int RWKV_PROJ = 1792, RW_OFF = 2048;
constexpr float RMS_EPS = 1e-6f, LN_EPS = 1e-5f, RWKV_LN_EPS = 64e-5f;
namespace pg8 {
#define PG8_LAS __attribute__((address_space(3)))
typedef unsigned short bf16_t;
typedef short bf16x8 __attribute__((ext_vector_type(8)));
typedef float f32x4 __attribute__((ext_vector_type(4)));
typedef unsigned u32x4 __attribute__((ext_vector_type(4)));
constexpr int BM = 256, BK = 64, HALF = 128, HTB = HALF * BK * 2  , STAGE_BYTES = 8 * HTB, NXCD = 8, WGM = 8;

__host__ __device__ __forceinline__ int lds_byte(int r, int c) { const int st = (r >> 4) * 2 + (c >> 5), rr = r & 15, cc = c & 31, ob = rr * 64 + cc * 2; return st * 1024 + (ob ^ (((ob >> 9) & 1) << 5)); }
__host__ __device__ __forceinline__ void stage_rc(int b, int& R, int& C) { const int st = b / 1024, sb = b % 1024, swz = sb ^ (((sb >> 9) & 1) << 5); R = (st >> 1) * 16 + swz / 64; C = (st & 1) * 32 + (swz % 64) / 2; }
__host__ __device__ __forceinline__ int perm32(int rho) { const int n = rho >> 4, i = rho & 15; return 8 * (i >> 2) + 4 * n + (i & 3); }

struct Unit { int pm, pn; };
struct Gemm { const bf16_t* A; const bf16_t* Bt; int M, N, K; };

struct StaticOrder {
    int nM, nN, nwg, G, c;
    __host__ __device__ void init(int M, int N, int G_, int c_) { nM = M / BM; nN = N / BM; nwg = nM * nN; G = G_; c = c_; }
    __host__ __device__ bool next(int i, Unit& u) const {
        const long L = (long)i * G + c; if (L >= nwg) return false;
        int wgid = (int)L; { const int q = nwg / NXCD, r = nwg % NXCD, xcd = wgid % NXCD, off = wgid / NXCD; wgid = (xcd < r ? xcd * (q + 1) : r * (q + 1) + (xcd - r) * q) + off; }
        const int nig = WGM * nN, gid = wgid / nig, fm = gid * WGM, gsz = (nM - fm) < WGM ? (nM - fm) : WGM;
        u.pm = fm + ((wgid % nig) % gsz); u.pn = (wgid % nig) / gsz; return true;
    }
    __device__ __forceinline__ void a_ready(const Unit&) const {}
    __device__ __forceinline__ void done(const Unit&) const {}
};

__device__ __forceinline__ unsigned cvt_pk_bf16(float lo, float hi) { unsigned r; asm volatile("v_cvt_pk_bf16_f32 %0, %1, %2" : "=v"(r) : "v"(lo), "v"(hi)); return r; }
__device__ __forceinline__ float row_rstd(const float* SS, int row) {
    const f32x4* p = (const f32x4*)(SS + (size_t)row * 16);
    const f32x4 a = p[0], b = p[1], c = p[2], d = p[3];
    const float s = (((a[0] + a[1]) + (a[2] + a[3])) + ((b[0] + b[1]) + (b[2] + b[3]))) + (((c[0] + c[1]) + (c[2] + c[3])) + ((d[0] + d[1]) + (d[2] + d[3])));
    return __builtin_amdgcn_rsqf(s * (1.0f / 1024.0f) + 1e-6f);
}
struct EpiNormBf16 {
    static constexpr bool PERM = true, AFTER_DRAIN = false;
    bf16_t* O; int ldc; const float* SS;
    __device__ __forceinline__ void operator()(const f32x4 (&acc)[2][2][4][2], const Unit& u, int wr, int wc, int fr, int fq) const {
        const int row0 = u.pm * BM + wr * 64 + fr, col0 = u.pn * BM + wc * 32 + 8 * fq;
#pragma unroll
        for (int ai = 0; ai < 2; ++ai)
#pragma unroll
            for (int m = 0; m < 4; ++m) { const int row = row0 + ai * HALF + m * 16; const float rs = row_rstd(SS, row); bf16_t* rowp = O + (size_t)row * ldc + col0;
#pragma unroll
                for (int bj = 0; bj < 2; ++bj) { const f32x4 v0 = acc[ai][bj][m][0] * rs, v1 = acc[ai][bj][m][1] * rs;
                    u32x4 w; w.x = cvt_pk_bf16(v0[0], v0[1]); w.y = cvt_pk_bf16(v0[2], v0[3]); w.z = cvt_pk_bf16(v1[0], v1[1]); w.w = cvt_pk_bf16(v1[2], v1[3]);
                    *(u32x4*)(rowp + bj * HALF) = w; } }
    }
};
template <int RES, bool OUT32> struct ResidOp {
    const float* res32; int res_row0;
    float* X; bf16_t* XB;
    __device__ __forceinline__ float operator()(int row, int col, f32x4 v0, f32x4 v1) const {
        if (RES == 0) { const float* rp = res32 + (size_t)(row - res_row0) * 1024 + col; v0 = v0 + *(const f32x4*)rp; v1 = v1 + *(const f32x4*)(rp + 4); }
        else { const u32x4 w = *(const u32x4*)(XB + (size_t)row * 1024 + col);
            v0 = v0 + (f32x4){__builtin_bit_cast(float, w.x << 16), __builtin_bit_cast(float, w.x & 0xffff0000u), __builtin_bit_cast(float, w.y << 16), __builtin_bit_cast(float, w.y & 0xffff0000u)};
            v1 = v1 + (f32x4){__builtin_bit_cast(float, w.z << 16), __builtin_bit_cast(float, w.z & 0xffff0000u), __builtin_bit_cast(float, w.w << 16), __builtin_bit_cast(float, w.w & 0xffff0000u)}; }
        if (OUT32) { float* xp = X + (size_t)row * 1024 + col; *(f32x4*)xp = v0; *(f32x4*)(xp + 4) = v1; }
        else { u32x4 w; w.x = cvt_pk_bf16(v0[0], v0[1]); w.y = cvt_pk_bf16(v0[2], v0[3]); w.z = cvt_pk_bf16(v1[0], v1[1]); w.w = cvt_pk_bf16(v1[2], v1[3]); *(u32x4*)(XB + (size_t)row * 1024 + col) = w; }
        return ((v0[0] * v0[0] + v0[1] * v0[1]) + (v0[2] * v0[2] + v0[3] * v0[3])) + ((v1[0] * v1[0] + v1[1] * v1[1]) + (v1[2] * v1[2] + v1[3] * v1[3]));
    }
};
template <int RES, bool OUT32> struct EpiResid {
    static constexpr bool PERM = true, AFTER_DRAIN = false;
    ResidOp<RES, OUT32> op; float* SS;
    __device__ __forceinline__ void operator()(const f32x4 (&acc)[2][2][4][2], const Unit& u, int wr, int wc, int fr, int fq) const {
        const int row0 = u.pm * BM + wr * 64 + fr, col0 = u.pn * BM + wc * 32 + 8 * fq;
#pragma unroll
        for (int ai = 0; ai < 2; ++ai)
#pragma unroll
            for (int m = 0; m < 4; ++m) { const int row = row0 + ai * HALF + m * 16; float ssq = 0.f;
#pragma unroll
                for (int bj = 0; bj < 2; ++bj) ssq += op(row, col0 + bj * HALF, acc[ai][bj][m][0], acc[ai][bj][m][1]);
                ssq += __shfl_xor(ssq, 16); ssq += __shfl_xor(ssq, 32);
                if (fq == 0) SS[(size_t)row * 16 + u.pn * 4 + wc] = ssq; }
    }
};
struct EpiSwiGLU {
    static constexpr bool PERM = true, AFTER_DRAIN = false;
    bf16_t* O; int ldc; const float* SS;
    __device__ __forceinline__ void operator()(const f32x4 (&acc)[2][2][4][2], const Unit& u, int wr, int wc, int fr, int fq) const {
        const int row0 = u.pm * BM + wr * 64 + fr, col0 = u.pn * HALF + wc * 32 + 8 * fq;
#pragma unroll
        for (int ai = 0; ai < 2; ++ai)
#pragma unroll
            for (int m = 0; m < 4; ++m) { const int row = row0 + ai * HALF + m * 16; const float rs = row_rstd(SS, row);
                float o[8];
#pragma unroll
                for (int n = 0; n < 2; ++n)
#pragma unroll
                    for (int e = 0; e < 4; ++e) { const float g = acc[ai][0][m][n][e] * rs, up = acc[ai][1][m][n][e] * rs; o[4 * n + e] = g * __builtin_amdgcn_rcpf(1.0f + __expf(-g)) * up; }
                u32x4 w; w.x = cvt_pk_bf16(o[0], o[1]); w.y = cvt_pk_bf16(o[2], o[3]); w.z = cvt_pk_bf16(o[4], o[5]); w.w = cvt_pk_bf16(o[6], o[7]);
                *(u32x4*)(O + (size_t)row * ldc + col0) = w; }
    }
};
template <class Epi, class Sched, bool ALIGN_EPI = false, bool SP2 = false>
__device__ __forceinline__ void gemm_phase(PG8_LAS unsigned char* lds, const Gemm g, const Sched& S, const Epi& E) {
    const int tid = threadIdx.x, wid = __builtin_amdgcn_readfirstlane(tid >> 6), lane = tid & 63, wr = wid >> 2, wc = wid & 3, fr = lane & 15, fq = lane >> 4;
    const int K = g.K, nt = K / BK;
    unsigned voffA[2], voffB[2];
#pragma unroll
    for (int i = 0; i < 2; ++i) { int R, C; stage_rc(tid * 16 + i * 8192, R, C); const int Rb = Epi::PERM ? ((R & ~31) + perm32(R & 31)) : R;
        voffA[i] = (unsigned)(R * K + C) * 2u; voffB[i] = (unsigned)(Rb * K + C) * 2u; }
    const size_t kstep = (size_t)(BK * 2);
    const size_t hstep = (size_t)HALF * K * 2;
    const size_t tstep = 2 * hstep;
    const unsigned ldsw = (unsigned)wid * 1024u;
    const int aoff = lds_byte(wr * 64 + fr, fq * 8), boff = lds_byte(wc * 32 + fr, fq * 8);
#define PG8_SA(b, h) (((b) * 2 + (h)) * HTB)
#define PG8_SB(b, h) ((4 + (b) * 2 + (h)) * HTB)
#define PG8_STAGE(bufoff, gbase, voff) do { _Pragma("unroll") for (int _i = 0; _i < 2; ++_i) \
        __builtin_amdgcn_global_load_lds((const unsigned*)((const char*)(gbase) + (voff)[_i]), (PG8_LAS unsigned*)(lds + (bufoff) + ldsw + _i * 8192), 16, 0, 0); } while (0)
#define PG8_LDA(dst, b, h) do { _Pragma("unroll") for (int m = 0; m < 4; ++m) _Pragma("unroll") for (int k = 0; k < 2; ++k) dst[m][k] = *(const PG8_LAS bf16x8*)(lds + PG8_SA(b, h) + aoff + m * 2048 + k * 1024); } while (0)
#define PG8_LDB(dst, b, h) do { _Pragma("unroll") for (int n = 0; n < 2; ++n) _Pragma("unroll") for (int k = 0; k < 2; ++k) dst[n][k] = *(const PG8_LAS bf16x8*)(lds + PG8_SB(b, h) + boff + n * 2048 + k * 1024); } while (0)
#define PG8_MMA(ai, bj, At, Bt) do { __builtin_amdgcn_s_setprio(1); _Pragma("unroll") for (int m = 0; m < 4; ++m) _Pragma("unroll") for (int n = 0; n < 2; ++n) _Pragma("unroll") for (int k = 0; k < 2; ++k) \
        acc[ai][bj][m][n] = __builtin_amdgcn_mfma_f32_16x16x32_bf16(Bt[n][k], At[m][k], acc[ai][bj][m][n], 0, 0, 0); __builtin_amdgcn_s_setprio(0); } while (0)
#define PG8_WAIT_V(n) asm volatile("s_waitcnt vmcnt(" #n ")" ::: "memory")
#define PG8_WAIT_L(n) asm volatile("s_waitcnt lgkmcnt(" #n ")" ::: "memory")
#define PG8_BAR __builtin_amdgcn_s_barrier()
#define PG8_SCHED __builtin_amdgcn_sched_barrier(0)
    Unit cur, nxt; int ui = 0;
    if (!S.next(0, cur)) return;
    f32x4 acc[2][2][4][2];
#pragma unroll
    for (int a = 0; a < 2; ++a)
#pragma unroll
        for (int b = 0; b < 2; ++b)
#pragma unroll
            for (int m = 0; m < 4; ++m)
#pragma unroll
                for (int n = 0; n < 2; ++n) acc[a][b][m][n] = (f32x4){0.f, 0.f, 0.f, 0.f};
    bf16x8 At[4][2], B0[2][2], B1[2][2];
    const char* cA = (const char*)g.A + (size_t)cur.pm * tstep; const char* cB = (const char*)g.Bt + (size_t)cur.pn * tstep;
    S.a_ready(cur);
    if constexpr (SP2) {
        PG8_STAGE(PG8_SB(0, 0), cB, voffB); PG8_STAGE(PG8_SB(0, 1), cB + hstep, voffB); PG8_STAGE(PG8_SA(0, 0), cA, voffA); PG8_STAGE(PG8_SA(0, 1), cA + hstep, voffA);
        if (wr == 1) PG8_BAR;
        PG8_WAIT_V(2); PG8_BAR;
        PG8_STAGE(PG8_SB(1, 0), cB + kstep, voffB); PG8_STAGE(PG8_SA(1, 0), cA + kstep, voffA); PG8_STAGE(PG8_SB(1, 1), cB + hstep + kstep, voffB);
        PG8_WAIT_V(6); PG8_BAR;
    } else {
        PG8_STAGE(PG8_SB(0, 0), cB, voffB); PG8_STAGE(PG8_SA(0, 0), cA, voffA); PG8_STAGE(PG8_SB(0, 1), cB + hstep, voffB); PG8_STAGE(PG8_SA(0, 1), cA + hstep, voffA);
        if (wr == 1) PG8_BAR;
        PG8_WAIT_V(4); PG8_BAR;
        PG8_STAGE(PG8_SB(1, 0), cB + kstep, voffB); PG8_STAGE(PG8_SA(1, 0), cA + kstep, voffA); PG8_STAGE(PG8_SB(1, 1), cB + hstep + kstep, voffB);
        PG8_WAIT_V(6); PG8_BAR;
    }
    for (;;) {
        const bool has_next = S.next(ui + 1, nxt);
        const char* nA = has_next ? (const char*)g.A + (size_t)nxt.pm * tstep : cA; const char* nB = has_next ? (const char*)g.Bt + (size_t)nxt.pn * tstep : cB;
        for (int t = 0; t < nt; t += 2) {
            const bool last = (t == nt - 2);
            const char* a1 = cA + (size_t)(t + 1) * kstep;
            const char* a2 = last ? nA : cA + (size_t)(t + 2) * kstep; const char* b2 = last ? nB : cB + (size_t)(t + 2) * kstep;
            const char* a3 = a2 + kstep; const char* b3 = b2 + kstep;
            if (last && has_next) S.a_ready(nxt);
            if constexpr (SP2) {
            PG8_LDB(B0, 0, 0); PG8_LDB(B1, 0, 1); PG8_SCHED; PG8_LDA(At, 0, 0); PG8_STAGE(PG8_SA(1, 1), a1 + hstep, voffA);
            PG8_WAIT_V(8); PG8_WAIT_L(0); PG8_BAR; PG8_MMA(0, 0, At, B0); PG8_MMA(0, 1, At, B1); PG8_BAR; PG8_SCHED;
            PG8_LDA(At, 0, 1); PG8_STAGE(PG8_SB(0, 0), b2, voffB); PG8_STAGE(PG8_SB(0, 1), b2 + hstep, voffB); PG8_STAGE(PG8_SA(0, 0), a2, voffA);
            PG8_WAIT_V(8); PG8_WAIT_L(0); PG8_BAR; PG8_MMA(1, 0, At, B0); PG8_MMA(1, 1, At, B1); PG8_BAR; PG8_SCHED;
            PG8_LDB(B0, 1, 0); PG8_LDB(B1, 1, 1); PG8_SCHED; PG8_LDA(At, 1, 0); PG8_STAGE(PG8_SA(0, 1), a2 + hstep, voffA);
            PG8_WAIT_V(8); PG8_WAIT_L(0); PG8_BAR; PG8_MMA(0, 0, At, B0); PG8_MMA(0, 1, At, B1); PG8_BAR; PG8_SCHED;
            PG8_LDA(At, 1, 1); PG8_STAGE(PG8_SB(1, 0), b3, voffB); PG8_STAGE(PG8_SB(1, 1), b3 + hstep, voffB); PG8_STAGE(PG8_SA(1, 0), a3, voffA);
            PG8_WAIT_V(8); PG8_WAIT_L(0); PG8_BAR; PG8_MMA(1, 0, At, B0); PG8_MMA(1, 1, At, B1); PG8_BAR; PG8_SCHED;
            } else {
            PG8_LDB(B0, 0, 0); PG8_SCHED; PG8_LDA(At, 0, 0); PG8_STAGE(PG8_SA(1, 1), a1 + hstep, voffA);
            PG8_WAIT_L(8); PG8_BAR; PG8_WAIT_L(0); PG8_MMA(0, 0, At, B0); PG8_BAR; PG8_SCHED;
            PG8_LDB(B1, 0, 1); PG8_STAGE(PG8_SB(0, 0), b2, voffB);
            PG8_BAR; PG8_WAIT_L(0); PG8_MMA(0, 1, At, B1); PG8_BAR;
            PG8_LDA(At, 0, 1); PG8_STAGE(PG8_SA(0, 0), a2, voffA);
            PG8_BAR; PG8_WAIT_L(0); PG8_MMA(1, 0, At, B0); PG8_BAR; PG8_SCHED;
            PG8_STAGE(PG8_SB(0, 1), b2 + hstep, voffB);
            PG8_WAIT_V(6); PG8_BAR; PG8_MMA(1, 1, At, B1); PG8_BAR;
            PG8_LDB(B0, 1, 0); PG8_SCHED; PG8_LDA(At, 1, 0); PG8_STAGE(PG8_SA(0, 1), a2 + hstep, voffA);
            PG8_WAIT_L(8); PG8_BAR; PG8_WAIT_L(0); PG8_MMA(0, 0, At, B0); PG8_BAR; PG8_SCHED;
            PG8_LDB(B1, 1, 1); PG8_STAGE(PG8_SB(1, 0), b3, voffB);
            PG8_BAR; PG8_WAIT_L(0); PG8_MMA(0, 1, At, B1); PG8_BAR;
            PG8_LDA(At, 1, 1); PG8_STAGE(PG8_SA(1, 0), a3, voffA);
            PG8_BAR; PG8_WAIT_L(0); PG8_MMA(1, 0, At, B0); PG8_BAR; PG8_SCHED;
            PG8_STAGE(PG8_SB(1, 1), b3 + hstep, voffB);
            PG8_WAIT_V(6); PG8_BAR; PG8_MMA(1, 1, At, B1); PG8_BAR;
            }
        }
        if constexpr (ALIGN_EPI) { if (wr == 0) PG8_BAR; }
        if constexpr (!Epi::AFTER_DRAIN) { E(acc, cur, wr, wc, fr, fq); S.done(cur); }
        if (!has_next) break;
#pragma unroll
        for (int a = 0; a < 2; ++a)
#pragma unroll
            for (int b = 0; b < 2; ++b)
#pragma unroll
                for (int m = 0; m < 4; ++m)
#pragma unroll
                    for (int n = 0; n < 2; ++n) acc[a][b][m][n] = (f32x4){0.f, 0.f, 0.f, 0.f};
        cur = nxt; cA = nA; cB = nB; ++ui;
        if constexpr (ALIGN_EPI) { if (wr == 1) PG8_BAR; }
    }
    PG8_WAIT_V(0);
    if constexpr (!ALIGN_EPI) { if (wr == 0) PG8_BAR; }
    PG8_BAR;
    if constexpr (Epi::AFTER_DRAIN) { E.fused(acc, cur, wr, wc, fr, fq, lds, wid, lane); S.done(cur); }
#undef PG8_SA
#undef PG8_SB
#undef PG8_STAGE
#undef PG8_LDA
#undef PG8_LDB
#undef PG8_MMA
#undef PG8_WAIT_V
#undef PG8_WAIT_L
#undef PG8_BAR
#undef PG8_SCHED
}
}
#define GAS __attribute__((address_space(1)))
#define LAS __attribute__((address_space(3)))
typedef unsigned short bf16;
typedef unsigned v4u __attribute__((ext_vector_type(4)));
typedef float f32x4 __attribute__((ext_vector_type(4)));
typedef short bf16x8 __attribute__((ext_vector_type(8)));
typedef GAS unsigned gu32;
typedef GAS unsigned long long gu64;
#define RLX_AGENT __ATOMIC_RELAXED, __HIP_MEMORY_SCOPE_AGENT
#define LDS_WAIT() asm volatile("s_waitcnt lgkmcnt(0)" ::: "memory")
#define VM_WAIT() asm volatile("s_waitcnt vmcnt(0)" ::: "memory")
__device__ __forceinline__ unsigned long long rt() { return __builtin_amdgcn_s_memrealtime(); }
typedef float f32x2_cv __attribute__((ext_vector_type(2))); typedef __bf16 bf16x2_cv __attribute__((ext_vector_type(2)));
__device__ __forceinline__ unsigned pk2(float lo, float hi) { f32x2_cv v = {lo, hi}; bf16x2_cv b = __builtin_convertvector(v, bf16x2_cv); return __builtin_bit_cast(unsigned, b); }
__device__ __forceinline__ unsigned f2bf(float f) { return pk2(f, f) & 0xffffu; }
#define XB_TMO      128
#define XB_XCNT(j)  (256  + 64 * (j))
#define XB_XSUB(j)  (1280 + 64 * (j))
#define XB_XGEN(j)  (2304 + 64 * (j))
#define XB_TOP      3328
#define XB_TOPGEN   3392
#define XCD_BAR_WORDS 3456
#define XB_SPIN_CAP (1u << 18)

__device__ __forceinline__ unsigned xb_ld(unsigned* p)              { return __hip_atomic_load(p, __ATOMIC_RELAXED, __HIP_MEMORY_SCOPE_AGENT); }
__device__ __forceinline__ unsigned xb_add(unsigned* p, unsigned v) { return __hip_atomic_fetch_add(p, v, __ATOMIC_RELAXED, __HIP_MEMORY_SCOPE_AGENT); }
__device__ __forceinline__ unsigned xb_xcc_id() { return (unsigned)__builtin_amdgcn_s_getreg((3 << 11) | 20) & 0xFu; }
#define XB_SPIN(cond, bar) do { unsigned _sp = 0; while (cond) { __builtin_amdgcn_s_sleep(1); \
    if ((++_sp & 255u) == 0u) { if (xb_ld(&(bar)[XB_TMO])) break; if (_sp > XB_SPIN_CAP) { atomicAdd(&(bar)[XB_TMO], 1u); break; } } } } while (0)

struct XcdBarrier {
    unsigned* bar; unsigned x;
    volatile LAS unsigned* st;
};

__device__ __forceinline__ XcdBarrier xcd_barrier_post(unsigned* bar, volatile LAS unsigned* st) {
    XcdBarrier b; b.bar = bar; b.x = xb_xcc_id(); b.st = st;
    if (threadIdx.x == 0) (void)xb_add(&bar[XB_XCNT(b.x)], 1u);
    return b;
}
__device__ __forceinline__ void xcd_barrier_complete(unsigned* bar, unsigned x, unsigned& nloc, unsigned& nx) {
    const unsigned G = gridDim.x * gridDim.y * gridDim.z;
    unsigned sum, cnt, mine, sp = 0u;
    for (;;) {
        sum = 0u; cnt = 0u; mine = 0u;
#pragma unroll
        for (unsigned j = 0; j < 16; ++j) { const unsigned c = xb_ld(&bar[XB_XCNT(j)]); sum += c; cnt += (c > 0u) ? 1u : 0u; mine = (j == x) ? c : mine; }
        if (sum == G) break;
        __builtin_amdgcn_s_sleep(1);
        if ((++sp & 255u) == 0u) { if (xb_ld(&bar[XB_TMO])) break; if (sp > XB_SPIN_CAP) { atomicAdd(&bar[XB_TMO], 1u); break; } }
    }
    nloc = mine > 0u ? mine : 1u; nx = cnt > 0u ? cnt : 1u;
}

__device__ __forceinline__ void xcd_barrier(const XcdBarrier& b) {
    asm volatile("s_waitcnt vmcnt(0)" ::: "memory");
    __syncthreads();
    if (threadIdx.x == 0) {
        unsigned* bar = b.bar;
        __builtin_amdgcn_s_waitcnt(0);
        unsigned nloc = b.st[0], nx = b.st[1];
        if (nloc == 0u) { xcd_barrier_complete(bar, b.x, nloc, nx); b.st[0] = nloc; b.st[1] = nx; }
        const unsigned old = xb_add(&bar[XB_XSUB(b.x)], 1u);
        const unsigned gen = old / nloc;
        if (old + 1u == (gen + 1u) * nloc) {
            __builtin_amdgcn_fence(__ATOMIC_RELEASE, "agent");
            asm volatile("s_waitcnt vmcnt(0)" ::: "memory");
            const unsigned og = xb_add(&bar[XB_TOP], 1u);
            const unsigned tg = og / nx;
            if (og + 1u == (tg + 1u) * nx) xb_add(&bar[XB_TOPGEN], 1u);
            else XB_SPIN(xb_ld(&bar[XB_TOPGEN]) == tg, bar);
            __builtin_amdgcn_fence(__ATOMIC_ACQUIRE, "agent");
            xb_add(&bar[XB_XGEN(b.x)], 1u);
            asm volatile("s_waitcnt vmcnt(0)" ::: "memory");
        } else {
            XB_SPIN(xb_ld(&bar[XB_XGEN(b.x)]) == gen, bar);
            __builtin_amdgcn_fence(__ATOMIC_ACQUIRE, "agent");
            asm volatile("s_waitcnt vmcnt(0)" ::: "memory");
        }
    }
    __syncthreads();
}
constexpr size_t MiB = 1u << 20;
constexpr size_t WS_CTL = 0, CTL_ZERO_BYTES = 64 * 1024;
constexpr size_t WS_ROPE = 1 * MiB, WS_SHB = 1 * MiB + 512 * 1024, WS_SS = 2 * MiB;
constexpr size_t WS_W_INAB = 4 * MiB, WS_W_OUTAB = WS_W_INAB + (size_t)N_AB * 1024 * 2, WS_W_INCD = WS_W_OUTAB + 2 * MiB, WS_W_OUTCD = WS_W_INCD + (size_t)N_CD * 1024 * 2,
                 WS_W_GU = WS_W_OUTCD + 2 * MiB, WS_W_DN = WS_W_GU + 2 * (size_t)N_GU * 1024 * 2, WS_W_END = WS_W_DN + 2 * (size_t)D_FF * 1024 * 2;
constexpr size_t WS_XB = 52 * MiB, WS_MIX = 86 * MiB, WS_PROJ = 120 * MiB, WS_PROJ_END = WS_PROJ + (size_t)T_ALL * N_AB * 2;
constexpr size_t WS_COMP = WS_PROJ_END, WS_ENT = WS_COMP + 3 * MiB, WS_RK = WS_ENT + 2 * MiB, WS_END = WS_RK + 1 * MiB;
static_assert(WS_W_END <= WS_XB && WS_XB + (size_t)T_ALL * 1024 * 2 <= WS_MIX && WS_MIX + (size_t)T_ALL * 1024 * 2 <= WS_PROJ && WS_END <= 256 * MiB, "d_ws map");
static_assert((size_t)NCH * 8 * 4096 * 2 + (size_t)64 * 4 * 16384 * 4 <= (size_t)T_ALL * 1024 * 2, "rwkv states + retention group states fit the XB region");
static_assert(128 * 24576 <= 3 * MiB && 128 * 16384 <= 2 * MiB && NCH * 8 * 64 * 4 <= 1 * MiB, "scan scratch");
constexpr size_t O_Y = 0, O_RET_P = (size_t)T_ALL * 1024, O_WKV_P = O_RET_P + 65536, O_SHIFT_P = O_WKV_P + 32768, O_CONV_P = O_SHIFT_P + 1792, O_K_P = O_CONV_P + 15360, O_V_P = O_K_P + 16384,
                 O_RET_S = O_V_P + 16384, O_WKV_S = O_RET_S + 16 * 65536, O_SHIFT_S = O_WKV_S + 16 * 32768, O_CONV_S = O_SHIFT_S + 16 * 1792, O_K_S = O_CONV_S + 16 * 15360, O_V_S = O_K_S + 16 * 16384,
                 O_END = O_V_S + 16 * 16384;
static_assert(O_END == 20345600, "output size");
constexpr int RING_BYTES = 131072, MISC_OFF = RING_BYTES + 320, LDS_BYTES = 147456, NWAVES = 8;

#define LBAR() do { asm volatile("s_waitcnt lgkmcnt(0)" ::: "memory"); __builtin_amdgcn_s_barrier(); asm volatile("" ::: "memory"); } while (0)
#define DI __device__ __forceinline__
typedef LAS unsigned char* lptr;
typedef unsigned u32x2 __attribute__((ext_vector_type(2)));
typedef float f32x16 __attribute__((ext_vector_type(16)));
typedef float f32x2 __attribute__((ext_vector_type(2)));
DI float bf2f(unsigned h) { return __builtin_bit_cast(float, h << 16); }
DI void unpack8(const v4u w, float* o) {
    o[0] = bf2f(w.x & 0xffffu); o[1] = bf2f(w.x >> 16); o[2] = bf2f(w.y & 0xffffu); o[3] = bf2f(w.y >> 16);
    o[4] = bf2f(w.z & 0xffffu); o[5] = bf2f(w.z >> 16); o[6] = bf2f(w.w & 0xffffu); o[7] = bf2f(w.w >> 16);
}
DI v4u pack8(const float* o) { v4u w; w.x = pk2(o[0], o[1]); w.y = pk2(o[2], o[3]); w.z = pk2(o[4], o[5]); w.w = pk2(o[6], o[7]); return w; }
DI void ld8f(const float* p, float* o) { const f32x4 a = *(const f32x4*)p, b = *(const f32x4*)(p + 4); o[0] = a[0]; o[1] = a[1]; o[2] = a[2]; o[3] = a[3]; o[4] = b[0]; o[5] = b[1]; o[6] = b[2]; o[7] = b[3]; }
DI void st8f(float* p, const float* o) { *(f32x4*)p = (f32x4){o[0], o[1], o[2], o[3]}; *(f32x4*)(p + 4) = (f32x4){o[4], o[5], o[6], o[7]}; }
DI void ld8bf(const bf16* p, float* o) { unpack8(*(const v4u*)p, o); }
DI float rcpf_(float x) { return __builtin_amdgcn_rcpf(x); }
DI float rsqf_(float x) { return __builtin_amdgcn_rsqf(x); }
DI float sigmoidf_(float x) { return rcpf_(1.0f + __expf(-x)); }

template <int K> DI void mma16(f32x4& acc, lptr A, int lda, lptr Bt, int ldb, int fr, int fq) {
#pragma unroll
    for (int k0 = 0; k0 < K; k0 += 32) {
        const bf16x8 a = *(const LAS bf16x8*)(A + fr * lda + (k0 + 8 * fq) * 2);
        const bf16x8 b = *(const LAS bf16x8*)(Bt + fr * ldb + (k0 + 8 * fq) * 2);
        acc = __builtin_amdgcn_mfma_f32_16x16x32_bf16(a, b, acc, 0, 0, 0);
    }
}
DI void st_rm(lptr M, int ld, int r0, int c0, const f32x4 v, int fr, int fq) {
#pragma unroll
    for (int i = 0; i < 4; ++i) *(LAS bf16*)(M + (r0 + 4 * fq + i) * ld + (c0 + fr) * 2) = (bf16)f2bf(v[i]);
}
DI void st_tr(lptr MT, int ld, int r0, int c0, const f32x4 v, int fr, int fq) {
    u32x2 w; w.x = pk2(v[0], v[1]); w.y = pk2(v[2], v[3]);
    *(LAS u32x2*)(MT + (c0 + fr) * ld + (r0 + 4 * fq) * 2) = w;
}
DI u32x2 pack4(const f32x4 v) { u32x2 w; w.x = pk2(v[0], v[1]); w.y = pk2(v[2], v[3]); return w; }
DI f32x4 unpack4(const u32x2 w) { return (f32x4){bf2f(w.x & 0xffffu), bf2f(w.x >> 16), bf2f(w.y & 0xffffu), bf2f(w.y >> 16)}; }

typedef short v4i16_t __attribute__((ext_vector_type(4)));
DI u32x2 trd(lptr p) { return __builtin_bit_cast(u32x2, __builtin_amdgcn_ds_read_tr16_b64_v4i16((LAS v4i16_t*)p)); }
template <int MODE> DI bf16x8 frag16(lptr img, int ld, int r0, int k0, int fr, int fq) {
    if (MODE == 0) return *(const LAS bf16x8*)(img + (r0 + fr) * ld + (k0 + 8 * fq) * 2);
    const lptr p = img + (k0 + 8 * fq + (fr >> 2)) * ld + (r0 + 4 * (fr & 3)) * 2;
    const u32x2 lo = trd(p), hi = trd(p + 4 * ld); v4u w; w.x = lo.x; w.y = lo.y; w.z = hi.x; w.w = hi.y; return __builtin_bit_cast(bf16x8, w);
}
template <int K, int MA, int MB> DI void mmaX(f32x4& acc, lptr A, int lda, int ar0, lptr B, int ldb, int br0, int fr, int fq) {
#pragma unroll
    for (int k0 = 0; k0 < K; k0 += 32) acc = __builtin_amdgcn_mfma_f32_16x16x32_bf16(frag16<MA>(A, lda, ar0, k0, fr, fq), frag16<MB>(B, ldb, br0, k0, fr, fq), acc, 0, 0, 0);
}
DI void g2l_64x64(lptr dst, const bf16* src, int tid) { const int r = tid >> 3, s = tid & 7; *(LAS v4u*)(dst + r * 144 + s * 16) = *(const v4u*)(src + r * 64 + s * 8); }
DI void l2g_64x64(bf16* dst, lptr src, int tid) { const int r = tid >> 3, s = tid & 7; *(v4u*)(dst + r * 64 + s * 8) = *(const LAS v4u*)(src + r * 144 + s * 16); }

struct Ctx {
    float* out; unsigned char* ws;
    int tid, lane, wave, vcu, G;
    lptr lds;
    unsigned long long* pr;
};
#define CAS __attribute__((address_space(4)))
DI const float* in_ptr(const Ctx&, int i) { const CAS char* p = (const CAS char*)__builtin_amdgcn_kernarg_segment_ptr(); asm volatile("" : "+s"(p)); return *(const float* const CAS*)(p + 8 * i); }
#ifndef PROBE_SUB
#define PROBE_SUB -1
#endif
#ifndef PROBE_SUB_HI
#define PROBE_SUB_HI PROBE_SUB
#endif
#define STAMP_BEGIN() unsigned long long st_last_ = (PROBE_SUB >= 0) ? __builtin_amdgcn_s_memrealtime() : 0ull
#define STAMP(k) do { if (PROBE_SUB >= 0) { const unsigned long long n_ = __builtin_amdgcn_s_memrealtime(); if ((k) >= PROBE_SUB && (k) <= PROBE_SUB_HI) *F.pr += n_ - st_last_; st_last_ = n_; } } while (0)

template <class RF> DI void gemm_small64(const Ctx& F, const bf16* A, const bf16* Bt, int K, int tile, const RF& rf, float* SS) {
    const int tid = F.tid, lane = F.lane, w = F.wave, fr = lane & 15, fq = lane >> 4; const lptr L = F.lds;
    const int row0 = TP + 64 * (tile >> 4), c0 = 64 * (tile & 15);
    const int kw = K >> 3, nst = kw >> 5;
    const bf16* ap = A + (size_t)(row0 + fr) * K + w * kw + 8 * fq; const bf16* bp = Bt + (size_t)(c0 + fr) * K + w * kw + 8 * fq;
    f32x4 acc[4][4];
#pragma unroll
    for (int m = 0; m < 4; ++m)
#pragma unroll
        for (int n = 0; n < 4; ++n) acc[m][n] = (f32x4){0.f, 0.f, 0.f, 0.f};
    bf16x8 a[4], b[4], an[4], bn[4];
#pragma unroll
    for (int i = 0; i < 4; ++i) { a[i] = *(const bf16x8*)(ap + (size_t)16 * i * K); b[i] = *(const bf16x8*)(bp + (size_t)16 * i * K); }
    for (int st = 0; st < nst; ++st) {
        const int kn = (st + 1 < nst) ? 32 * (st + 1) : 32 * st;
#pragma unroll
        for (int i = 0; i < 4; ++i) { an[i] = *(const bf16x8*)(ap + (size_t)16 * i * K + kn); bn[i] = *(const bf16x8*)(bp + (size_t)16 * i * K + kn); }
#pragma unroll
        for (int m = 0; m < 4; ++m)
#pragma unroll
            for (int n = 0; n < 4; ++n) acc[m][n] = __builtin_amdgcn_mfma_f32_16x16x32_bf16(b[n], a[m], acc[m][n], 0, 0, 0);
#pragma unroll
        for (int i = 0; i < 4; ++i) { a[i] = an[i]; b[i] = bn[i]; }
    }
#pragma unroll
    for (int m = 0; m < 4; ++m)
#pragma unroll
        for (int n = 0; n < 4; ++n) { const int row = 16 * m + fr, g4 = 4 * n + fq; *(LAS f32x4*)(L + w * 16384 + row * 256 + ((g4 ^ (row & 15)) << 4)) = acc[m][n]; }
    LBAR();
    {   const int row = tid >> 3, g = tid & 7; f32x4 v0 = (f32x4){0.f, 0.f, 0.f, 0.f}, v1 = v0;
#pragma unroll
        for (int ww = 0; ww < 8; ++ww) { v0 = v0 + *(const LAS f32x4*)(L + ww * 16384 + row * 256 + (((2 * g) ^ (row & 15)) << 4)); v1 = v1 + *(const LAS f32x4*)(L + ww * 16384 + row * 256 + (((2 * g + 1) ^ (row & 15)) << 4)); }
        float ssq = rf(row0 + row, c0 + 8 * g, v0, v1);
        ssq += __shfl_xor(ssq, 1); ssq += __shfl_xor(ssq, 2); ssq += __shfl_xor(ssq, 4);
        if (g == 0) SS[(size_t)(row0 + row) * 16 + (tile & 15)] = ssq; }
    LBAR();
}
constexpr int RW_LD = 144, RW_SLOT = 9216;
constexpr int RW_LDF = 272;
DI lptr rw_slot(lptr lds, int i) { return lds + i * RW_SLOT; }

DI void rw_load_p(const Ctx& F, int c, int t, int col, float* p, float* pp) {
    ld8bf(((bf16*)(F.ws + WS_PROJ)) + (size_t)(c * 64 + t) * N_AB + RW_OFF + col, p);
    if (t == 0 && c >= 256) ld8f(in_ptr(F, 4) + (size_t)(c - 256) * RWKV_PROJ + col, pp);
    else if (t == 0 && c == 0) {
#pragma unroll
        for (int e = 0; e < 8; ++e) pp[e] = 0.f; }
    else ld8bf(((bf16*)(F.ws + WS_PROJ)) + (size_t)(c * 64 + t - 1) * N_AB + RW_OFF + col, pp);
}
DI void rw_shift(const Ctx& F, int c, int t, int col, float* xs) {
    float p[8], pp[8], mu[8]; rw_load_p(F, c, t, col, p, pp); ld8f(in_ptr(F, 14) + col, mu);
#pragma unroll
    for (int e = 0; e < 8; ++e) xs[e] = p[e] + (pp[e] - p[e]) * mu[e];
}

constexpr int RW_PAR_OFF = RING_BYTES + 1024;
enum { PAR_MU_WL = 0, PAR_MU_AL = 64, PAR_MU_GL = 128, PAR_MU_R = 256, PAR_MU_K = 320, PAR_MU_V = 384, PAR_KK = 448, PAR_KA = 512, PAR_RK = 576, PAR_W0 = 640, PAR_A0 = 704, PAR_N = 768 };
DI void rw_load_params(const Ctx& F, int h) {
    LAS float* P = (LAS float*)(F.lds + RW_PAR_OFF);
    for (int i = F.tid; i < PAR_N; i += 512) { float v;
        if (i < 256) v = in_ptr(F, 14)[1536 + i];
        else { const int k = (i - 256) >> 6, j = h * 64 + (i & 63);
            v = k == 0 ? in_ptr(F, 14)[j] : k == 1 ? in_ptr(F, 14)[512 + j] : k == 2 ? in_ptr(F, 14)[1024 + j] : k == 3 ? in_ptr(F, 20)[j] : k == 4 ? in_ptr(F, 21)[j] : k == 5 ? in_ptr(F, 22)[j] : k == 6 ? in_ptr(F, 15)[j] : in_ptr(F, 17)[j]; }
        P[i] = v; }
    LBAR();
}
struct RwPre { v4u pa[4], qa[4]; f32x4 w2[2]; };
DI v4u rw_prev16(const Ctx& F, int c, int t, int col) {
    const bf16* shb = (const bf16*)(F.ws + WS_SHB) + (size_t)(c >= 256 ? c - 256 : 16) * RWKV_PROJ;
    const bf16* prj = ((bf16*)(F.ws + WS_PROJ)) + (size_t)(c * 64 + t - 1) * N_AB + RW_OFF;
    const bf16* src = (t == 0 && (c >= 256 || c == 0)) ? shb : prj;
    return *(const v4u*)(src + col);
}
DI void rw_prefetch(const Ctx& F, int c, int h, RwPre& R) {
    const int t = F.tid >> 3, s8 = F.tid & 7; const bf16* row = ((bf16*)(F.ws + WS_PROJ)) + (size_t)(c * 64 + t) * N_AB + RW_OFF;
#pragma unroll
    for (int q = 0; q < 4; ++q) { const int col = 1536 + 64 * q + 8 * s8; R.pa[q] = *(const v4u*)(row + col); R.qa[q] = rw_prev16(F, c, t, col); }
#pragma unroll
    for (int q = 0; q < 2; ++q) { R.w2[q] = *(const f32x4*)(in_ptr(F, 16) + (size_t)t * 512 + h * 64 + 8 * s8 + 4 * q);
 }
}
DI void rw_mix8(const v4u p, const v4u pp, const LAS float* mu, float* xs) {
    float a[8], b[8]; unpack8(p, a); unpack8(pp, b);
#pragma unroll
    for (int e = 0; e < 8; ++e) xs[e] = a[e] + (b[e] - a[e]) * mu[e];
}
DI void rwkv_p1_item(const Ctx& F, int c, int h, RwPre& R, bool has_next, int nc, int nh) {
    const int tid = F.tid, lane = F.lane, w = F.wave, fr = lane & 15, fq = lane >> 4, tr = w >> 1, tc0 = 2 * (w & 1);
    const lptr L = F.lds;
    const int t = tid >> 3, s8 = tid & 7;
    const lptr TW = L, AL = L + 9216, SG = L + 18432, W2 = L + 35840, A2 = L + 45056, G2 = L + 54272;
    const lptr LG = L + 8 * RW_SLOT, A32 = LG + 17408;
    LAS float* GAMC = (LAS float*)(L + 14 * RW_SLOT);
    STAMP_BEGIN();
    v4u pc[3], qc[3];
    f32x4 g2r[4], a2r[2];
#pragma unroll
    for (int q = 0; q < 2; ++q) a2r[q] = *(const f32x4*)(in_ptr(F, 18) + (size_t)t * 512 + h * 64 + 8 * s8 + 4 * q);
#pragma unroll
    for (int q = 0; q < 2; ++q) { g2r[q] = *(const f32x4*)(in_ptr(F, 19) + (size_t)t * 512 + h * 64 + 8 * s8 + 4 * q); g2r[2 + q] = *(const f32x4*)(in_ptr(F, 19) + (size_t)(t + 64) * 512 + h * 64 + 8 * s8 + 4 * q); }
    const LAS float* PAR = (const LAS float*)(L + RW_PAR_OFF);
    {
        float xs[8], o[8];
        rw_mix8(R.pa[0], R.qa[0], PAR + PAR_MU_WL + 8 * s8, xs);
#pragma unroll
        for (int e = 0; e < 8; ++e) o[e] = 1.0f - 2.0f * rcpf_(1.0f + __expf(2.0f * xs[e]));
        *(LAS v4u*)(TW + t * RW_LD + s8 * 16) = pack8(o);
        rw_mix8(R.pa[1], R.qa[1], PAR + PAR_MU_AL + 8 * s8, xs);
        *(LAS v4u*)(AL + t * RW_LD + s8 * 16) = pack8(xs);
#pragma unroll
        for (int q = 0; q < 2; ++q) { rw_mix8(R.pa[2 + q], R.qa[2 + q], PAR + PAR_MU_GL + 64 * q + 8 * s8, xs);
#pragma unroll
            for (int e = 0; e < 8; ++e) o[e] = sigmoidf_(xs[e]);
            *(LAS v4u*)(SG + t * 272 + (64 * q + 8 * s8) * 2) = pack8(o); }
        {   float v8[8];
#pragma unroll
            for (int e = 0; e < 4; ++e) { v8[e] = R.w2[0][e]; v8[4 + e] = R.w2[1][e]; }
            *(LAS v4u*)(W2 + t * RW_LD + s8 * 16) = pack8(v8);
#pragma unroll
            for (int e = 0; e < 4; ++e) { v8[e] = a2r[0][e]; v8[4 + e] = a2r[1][e]; }
            *(LAS v4u*)(A2 + t * RW_LD + s8 * 16) = pack8(v8);
#pragma unroll
            for (int e = 0; e < 4; ++e) { v8[e] = g2r[0][e]; v8[4 + e] = g2r[1][e]; }
            *(LAS v4u*)(G2 + t * RW_LD + s8 * 16) = pack8(v8);
#pragma unroll
            for (int e = 0; e < 4; ++e) { v8[e] = g2r[2][e]; v8[4 + e] = g2r[3][e]; }
            *(LAS v4u*)(G2 + (t + 64) * RW_LD + s8 * 16) = pack8(v8); }
    }
    LBAR(); STAMP(0);
    { const bf16* row = ((bf16*)(F.ws + WS_PROJ)) + (size_t)(c * 64 + t) * N_AB + RW_OFF;
#pragma unroll
        for (int q = 0; q < 3; ++q) { const int col = 512 * q + h * 64 + 8 * s8; pc[q] = *(const v4u*)(row + col); qc[q] = rw_prev16(F, c, t, col); } }
    {
        f32x4 aw[2], aa[2], ag[2];
#pragma unroll
        for (int i = 0; i < 2; ++i) { aw[i] = (f32x4){0.f, 0.f, 0.f, 0.f}; aa[i] = aw[i]; ag[i] = aw[i];
            mmaX<64, 0, 1>(aw[i], TW, RW_LD, 16 * tr, W2, RW_LD, 16 * (tc0 + i), fr, fq);
            mmaX<64, 0, 1>(aa[i], AL, RW_LD, 16 * tr, A2, RW_LD, 16 * (tc0 + i), fr, fq);
            mmaX<128, 0, 1>(ag[i], SG, 272, 16 * tr, G2, RW_LD, 16 * (tc0 + i), fr, fq); }
        LBAR();
#pragma unroll
        for (int i = 0; i < 2; ++i) { const int j = 16 * (tc0 + i) + fr; const float w0 = PAR[PAR_W0 + j], a0 = PAR[PAR_A0 + j];
#pragma unroll
            for (int r = 0; r < 4; ++r) { const int tt = 16 * tr + 4 * fq + r;
                const float z = -(w0 + aw[i][r]); const float sp = fmaxf(z, 0.f) + __logf(1.0f + __expf(-fabsf(z)));
                *(LAS float*)(LG + tt * RW_LDF + j * 4) = -__expf(-sp - 0.5f);
                *(LAS float*)(A32 + tt * RW_LDF + j * 4) = sigmoidf_(a0 + aa[i][r]);
            }
            st_rm(rw_slot(L, 12), RW_LD, 16 * tr, 16 * (tc0 + i), ag[i], fr, fq); }
    }
    LBAR(); STAMP(1);
    {   { const int r = tid >> 3, sg = tid & 7; *(v4u*)(((bf16*)(F.ws + WS_MIX)) + (size_t)(c * 64 + r) * 1024 + 512 + h * 64 + sg * 8) = *(const LAS v4u*)(rw_slot(L, 12) + r * RW_LD + sg * 16); }
        const int j = tid & 63, tb = tid >> 6; LAS float* TOT = (LAS float*)rw_slot(L, 13); float v[8];
#pragma unroll
        for (int i = 0; i < 8; ++i) v[i] = *(LAS float*)(LG + (8 * tb + i) * RW_LDF + j * 4);
#pragma unroll
        for (int i = 1; i < 8; ++i) v[i] += v[i - 1];
        TOT[tb * 64 + j] = v[7];
        LBAR();
        float off = 0.f;
#pragma unroll
        for (int bb = 0; bb < 7; ++bb) off += bb < tb ? TOT[bb * 64 + j] : 0.f;
#pragma unroll
        for (int i = 0; i < 8; ++i) *(LAS float*)(LG + (8 * tb + i) * RW_LDF + j * 4) = v[i] + off;
    }
    LBAR(); STAMP(2);
    const lptr KG = rw_slot(L, 0), RG = rw_slot(L, 1), BI = rw_slot(L, 2), KI = rw_slot(L, 3), VV = rw_slot(L, 4), BT = rw_slot(L, 5), KT = rw_slot(L, 6);
    {
        const int j0 = 8 * s8;
        float kk[8], k2[8], b[8];
        {   float xk[8], a[8]; rw_mix8(pc[1], qc[1], PAR + PAR_MU_K + j0, xk); const LAS float* w8 = PAR + PAR_KK + j0; float ss = 0.f;
#pragma unroll
            for (int e = 0; e < 8; ++e) { kk[e] = xk[e] * w8[e]; ss += kk[e] * kk[e]; }
            ss += __shfl_xor(ss, 1); ss += __shfl_xor(ss, 2); ss += __shfl_xor(ss, 4);
            const float inv = ss > 1e-24f ? rsqf_(ss) : 1e12f;
            const LAS float* w9 = PAR + PAR_KA + j0;
#pragma unroll
            for (int e = 0; e < 8; ++e) { a[e] = *(LAS float*)(A32 + t * RW_LDF + (j0 + e) * 4); kk[e] *= inv; k2[e] = xk[e] * (1.0f + (a[e] - 1.0f) * w9[e]); b[e] = kk[e] * a[e]; } }
        asm volatile("" ::: "memory");
        float lg[8];
#pragma unroll
        for (int e = 0; e < 8; ++e) lg[e] = *(LAS float*)(LG + t * RW_LDF + (j0 + e) * 4);
        {   float xr[8], o[8]; rw_mix8(pc[0], qc[0], PAR + PAR_MU_R + j0, xr); const LAS float* w8 = PAR + PAR_RK + j0; float rks = 0.f;
#pragma unroll
            for (int e = 0; e < 8; ++e) { rks += xr[e] * k2[e] * w8[e]; o[e] = xr[e] * __expf(lg[e]); }
            rks += __shfl_xor(rks, 1); rks += __shfl_xor(rks, 2); rks += __shfl_xor(rks, 4);
            if (s8 == 0) ((float*)(F.ws + WS_RK))[(size_t)(c * 8 + h) * 64 + t] = rks;
            *(LAS v4u*)(RG + t * RW_LD + s8 * 16) = pack8(o); }
        asm volatile("" ::: "memory");
        {   float o[8];
#pragma unroll
            for (int e = 0; e < 8; ++e) { const float lgm = t > 0 ? *(LAS float*)(LG + (t - 1) * RW_LDF + (j0 + e) * 4) : 0.f; o[e] = kk[e] * __expf(lgm); }
            *(LAS v4u*)(KG + t * RW_LD + s8 * 16) = pack8(o); }
        asm volatile("" ::: "memory");
        {   float o1[8], o2[8];
#pragma unroll
            for (int e = 0; e < 8; ++e) { const float ei = __expf(-lg[e]); o1[e] = b[e] * ei; o2[e] = k2[e] * ei; }
            *(LAS v4u*)(BI + t * RW_LD + s8 * 16) = pack8(o1);
            *(LAS v4u*)(KI + t * RW_LD + s8 * 16) = pack8(o2); }
        asm volatile("" ::: "memory");
        {   float o1[8], o2[8];
#pragma unroll
            for (int e = 0; e < 8; ++e) { const float lgc = *(LAS float*)(LG + 63 * RW_LDF + (j0 + e) * 4); const float ec = __expf(lgc - lg[e]);
                if (t == 63) GAMC[j0 + e] = __expf(lgc);
                o1[e] = b[e] * ec; o2[e] = k2[e] * ec; }
            *(LAS v4u*)(BT + t * RW_LD + s8 * 16) = pack8(o1);
            *(LAS v4u*)(KT + t * RW_LD + s8 * 16) = pack8(o2); }
        asm volatile("" ::: "memory");
        {   float xv[8]; rw_mix8(pc[2], qc[2], PAR + PAR_MU_V + j0, xv); *(LAS v4u*)(VV + t * RW_LD + s8 * 16) = pack8(xv); }
    }
    if (has_next) rw_prefetch(F, nc, nh, R);
    LBAR(); STAMP(3);
    const lptr BMT = rw_slot(L, 7), PBT = rw_slot(L, 8), PKT = rw_slot(L, 9), XT0 = rw_slot(L, 10), XT1 = rw_slot(L, 2), PT0 = rw_slot(L, 11), PT1 = rw_slot(L, 3);
    f32x4 P[2];
    {
        f32x4 aA[2], aB[2], aPb[2], aPk[2];
#pragma unroll
        for (int i = 0; i < 2; ++i) { aA[i] = (f32x4){0.f, 0.f, 0.f, 0.f}; aB[i] = aA[i]; aPb[i] = aA[i]; aPk[i] = aA[i];
            mmaX<64, 0, 0>(aA[i], KG, RW_LD, 16 * tr, BI, RW_LD, 16 * (tc0 + i), fr, fq);
            mmaX<64, 0, 0>(aB[i], KG, RW_LD, 16 * tr, KI, RW_LD, 16 * (tc0 + i), fr, fq);
            mmaX<64, 0, 0>(aPb[i], RG, RW_LD, 16 * tr, BI, RW_LD, 16 * (tc0 + i), fr, fq);
            mmaX<64, 0, 0>(aPk[i], RG, RW_LD, 16 * tr, KI, RW_LD, 16 * (tc0 + i), fr, fq); }
        LBAR();
#pragma unroll
        for (int i = 0; i < 2; ++i) { const int s = 16 * (tc0 + i) + fr; f32x4 x, p1, bm, pb, pk;
#pragma unroll
            for (int r = 0; r < 4; ++r) { const int tt = 16 * tr + 4 * fq + r;
                x[r] = tt > s ? -aA[i][r] : 0.f; p1[r] = x[r] + (tt == s ? 1.f : 0.f); bm[r] = tt > s ? aB[i][r] : 0.f; pb[r] = tt >= s ? aPb[i][r] : 0.f; pk[r] = tt >= s ? aPk[i][r] : 0.f; }
            P[i] = p1;
            st_tr(XT0, RW_LD, 16 * tr, 16 * (tc0 + i), x, fr, fq); st_tr(PT0, RW_LD, 16 * tr, 16 * (tc0 + i), p1, fr, fq);
            st_tr(BMT, RW_LD, 16 * tr, 16 * (tc0 + i), bm, fr, fq); st_tr(PBT, RW_LD, 16 * tr, 16 * (tc0 + i), pb, fr, fq); st_tr(PKT, RW_LD, 16 * tr, 16 * (tc0 + i), pk, fr, fq); }
    }
    LBAR(); STAMP(4);
#pragma unroll
    for (int st = 1; st <= 6; ++st) {
        const lptr XTc = (st & 1) ? XT0 : XT1, XTn = (st & 1) ? XT1 : XT0;
        const lptr PTc = (st & 1) ? PT1 : PT0, PTn = (st & 1) ? PT0 : PT1;
        f32x4 xn[2];
#pragma unroll
        for (int i = 0; i < 2; ++i) {
            if (st < 6) { xn[i] = (f32x4){0.f, 0.f, 0.f, 0.f}; mmaX<64, 1, 0>(xn[i], XTc, RW_LD, 16 * tr, XTc, RW_LD, 16 * (tc0 + i), fr, fq); }
            if (st > 1) mmaX<64, 1, 0>(P[i], PTc, RW_LD, 16 * tr, XTc, RW_LD, 16 * (tc0 + i), fr, fq);
        }
#pragma unroll
        for (int i = 0; i < 2; ++i) {
            if (st < 6) st_tr(XTn, RW_LD, 16 * tr, 16 * (tc0 + i), xn[i], fr, fq);
            if (st > 1) st_tr(PTn, RW_LD, 16 * tr, 16 * (tc0 + i), P[i], fr, fq);
        }
        LBAR();
    }
    STAMP(5);
    const lptr TT = PT1, WT = rw_slot(L, 10), BVT = rw_slot(L, 11), UVT = rw_slot(L, 12), MS = rw_slot(L, 13), QS = rw_slot(L, 2);
    {
#pragma unroll
        for (int i = 0; i < 2; ++i) { f32x4 aw = (f32x4){0.f, 0.f, 0.f, 0.f}, ab = aw;
            mmaX<64, 1, 1>(aw, TT, RW_LD, 16 * tr, KG, RW_LD, 16 * (tc0 + i), fr, fq);
            mmaX<64, 1, 1>(ab, BMT, RW_LD, 16 * tr, VV, RW_LD, 16 * (tc0 + i), fr, fq);
            st_tr(WT, RW_LD, 16 * tr, 16 * (tc0 + i), aw, fr, fq); st_tr(BVT, RW_LD, 16 * tr, 16 * (tc0 + i), ab, fr, fq); }
    }
    LBAR();
    {
#pragma unroll
        for (int i = 0; i < 2; ++i) { f32x4 au = (f32x4){0.f, 0.f, 0.f, 0.f};
            mmaX<64, 1, 0>(au, TT, RW_LD, 16 * tr, BVT, RW_LD, 16 * (tc0 + i), fr, fq);
            st_tr(UVT, RW_LD, 16 * tr, 16 * (tc0 + i), au, fr, fq); }
    }
    LBAR();
    unsigned char* item = ((unsigned char*)F.out) + (size_t)(c * 8 + h) * 32768;
    {
#pragma unroll
        for (int i = 0; i < 2; ++i) { const int cb = 16 * (tc0 + i);
            f32x4 am = (f32x4){0.f, 0.f, 0.f, 0.f};
            mmaX<64, 0, 1>(am, WT, RW_LD, 16 * tr, BT, RW_LD, cb, fr, fq);
            { const int j = cb + fr; const float gc = GAMC[j]; f32x4 mv;
#pragma unroll
                for (int r = 0; r < 4; ++r) { const int jp = 16 * tr + 4 * fq + r; mv[r] = (jp == j ? gc : 0.f) - am[r]; }
                st_tr(MS, RW_LD, 16 * tr, cb, mv, fr, fq); }
            f32x4 aq = (f32x4){0.f, 0.f, 0.f, 0.f};
            mmaX<64, 0, 1>(aq, WT, RW_LD, 16 * tr, PBT, RW_LD, cb, fr, fq);
            { const f32x4 rgv = unpack4(*(const LAS u32x2*)(RG + (cb + fr) * RW_LD + (16 * tr + 4 * fq) * 2)); const f32x4 qv = rgv - aq; st_tr(QS, RW_LD, 16 * tr, cb, qv, fr, fq); }
            f32x4 g1 = (f32x4){0.f, 0.f, 0.f, 0.f}, g2 = g1, y1 = g1, y2 = g1;
            mmaX<64, 1, 1>(g1, KT, RW_LD, 16 * tr, VV, RW_LD, cb, fr, fq);
            mmaX<64, 1, 0>(g2, BT, RW_LD, 16 * tr, UVT, RW_LD, cb, fr, fq);
            mmaX<64, 1, 1>(y1, PKT, RW_LD, 16 * tr, VV, RW_LD, cb, fr, fq);
            mmaX<64, 1, 0>(y2, PBT, RW_LD, 16 * tr, UVT, RW_LD, cb, fr, fq);
            *(u32x2*)(item + 16384 + ((w * 2 + i) * 64 + lane) * 8) = pack4(g1 - g2);
            *(u32x2*)(item + 24576 + ((w * 2 + i) * 64 + lane) * 8) = pack4(y1 - y2); }
    }
    LBAR();
    l2g_64x64((bf16*)item, MS, tid); l2g_64x64((bf16*)(item + 8192), QS, tid);
    if (h == 0 && c >= 255) { float* dst = c == 255 ? (F.out + O_SHIFT_P) : (F.out + O_SHIFT_S) + (size_t)(c - 256) * RWKV_PROJ; const bf16* src = ((bf16*)(F.ws + WS_PROJ)) + (size_t)(c * 64 + 63) * N_AB + RW_OFF;
        for (int col = tid; col < RWKV_PROJ; col += 512) dst[col] = bf2f(src[col]); }
    LBAR(); STAMP(6);
}

DI void rw_ld_frag_bf16(const unsigned char* p, int w, int lane, f32x4* a) { a[0] = unpack4(*(const u32x2*)(p + ((w * 2) * 64 + lane) * 8)); a[1] = unpack4(*(const u32x2*)(p + ((w * 2 + 1) * 64 + lane) * 8)); }

DI void rwkv_l1_item(const Ctx& F, int g, int h) { STAMP_BEGIN();
    const int tid = F.tid, lane = F.lane, w = F.wave, fr = lane & 15, fq = lane >> 4, tr = w >> 1, tc0 = 2 * (w & 1);
    const lptr L = F.lds, OS = rw_slot(L, 6);
    const int c0 = g * 16;
    f32x4 am[2], ag[2];
    { const unsigned char* item = ((unsigned char*)F.out) + (size_t)(c0 * 8 + h) * 32768; const bf16* M = (const bf16*)item;
#pragma unroll
        for (int i = 0; i < 2; ++i)
#pragma unroll
            for (int r = 0; r < 4; ++r) am[i][r] = bf2f(M[(16 * tr + 4 * fq + r) * 64 + 16 * (tc0 + i) + fr]);
        rw_ld_frag_bf16(item + 16384, w, lane, ag); }
    const int pr_ = tid >> 3, ps_ = tid & 7;
    v4u mreg; u32x2 gq0, gq1;
    { const unsigned char* item = ((unsigned char*)F.out) + (size_t)((c0 + 1) * 8 + h) * 32768; mreg = *(const v4u*)((const bf16*)item + pr_ * 64 + ps_ * 8);
        gq0 = *(const u32x2*)(item + 16384 + ((w * 2) * 64 + lane) * 8); gq1 = *(const u32x2*)(item + 16384 + ((w * 2 + 1) * 64 + lane) * 8); }
    for (int c = c0 + 1; c < c0 + 16; ++c) {
        const lptr MA = rw_slot(L, 3 * (c & 1)), MHT = rw_slot(L, 3 * (c & 1) + 1), GHT = rw_slot(L, 3 * (c & 1) + 2);
        *(LAS v4u*)(MA + pr_ * 144 + ps_ * 16) = mreg;
#pragma unroll
        for (int i = 0; i < 2; ++i) { st_tr(MHT, RW_LD, 16 * tr, 16 * (tc0 + i), am[i], fr, fq); st_tr(GHT, RW_LD, 16 * tr, 16 * (tc0 + i), ag[i], fr, fq); }
        f32x4 gc[2]; gc[0] = unpack4(gq0); gc[1] = unpack4(gq1);
        if (c + 1 < c0 + 16) { const unsigned char* item = ((unsigned char*)F.out) + (size_t)((c + 1) * 8 + h) * 32768; mreg = *(const v4u*)((const bf16*)item + pr_ * 64 + ps_ * 8);
            gq0 = *(const u32x2*)(item + 16384 + ((w * 2) * 64 + lane) * 8); gq1 = *(const u32x2*)(item + 16384 + ((w * 2 + 1) * 64 + lane) * 8); }
        LBAR();
#pragma unroll
        for (int i = 0; i < 2; ++i) { am[i] = (f32x4){0.f, 0.f, 0.f, 0.f}; ag[i] = gc[i];
            mma16<64>(am[i], MA + 16 * tr * RW_LD, RW_LD, MHT + 16 * (tc0 + i) * RW_LD, RW_LD, fr, fq);
            mma16<64>(ag[i], MA + 16 * tr * RW_LD, RW_LD, GHT + 16 * (tc0 + i) * RW_LD, RW_LD, fr, fq); }
    }
    unsigned char* comp = (F.ws + WS_COMP) + (size_t)(h * 16 + g) * 24576;
#pragma unroll
    for (int i = 0; i < 2; ++i) { st_rm(OS, RW_LD, 16 * tr, 16 * (tc0 + i), am[i], fr, fq); *(f32x4*)(comp + 8192 + ((w * 2 + i) * 64 + lane) * 16) = ag[i]; }
    LBAR();
    l2g_64x64((bf16*)comp, OS, tid);
    LBAR();
    STAMP(12);
}
DI void rwkv_l2_item(const Ctx& F, int h) { STAMP_BEGIN();
    const int tid = F.tid, lane = F.lane, w = F.wave, fr = lane & 15, fq = lane >> 4, tr = w >> 1, tc0 = 2 * (w & 1);
    const lptr L = F.lds;
    f32x4 e[2]; e[0] = (f32x4){0.f, 0.f, 0.f, 0.f}; e[1] = e[0];
    const int pr_ = tid >> 3, ps_ = tid & 7;
    v4u mreg; f32x4 gh[2];
    { const unsigned char* comp = (F.ws + WS_COMP) + (size_t)(h * 16) * 24576; mreg = *(const v4u*)((const bf16*)comp + pr_ * 64 + ps_ * 8);
#pragma unroll
        for (int i = 0; i < 2; ++i) gh[i] = *(const f32x4*)(comp + 8192 + ((w * 2 + i) * 64 + lane) * 16); }
    for (int g = 0; g < 16; ++g) {
        float* ent = ((float*)(F.ws + WS_ENT)) + (size_t)(h * 16 + g) * 4096;
#pragma unroll
        for (int i = 0; i < 2; ++i) *(f32x4*)(ent + ((w * 2 + i) * 64 + lane) * 4) = e[i];
        if (g == 15) break;
        const lptr MA = rw_slot(L, 2 * (g & 1)), EHT = rw_slot(L, 2 * (g & 1) + 1);
        *(LAS v4u*)(MA + pr_ * 144 + ps_ * 16) = mreg;
#pragma unroll
        for (int i = 0; i < 2; ++i) st_tr(EHT, RW_LD, 16 * tr, 16 * (tc0 + i), e[i], fr, fq);
        f32x4 gcur[2]; gcur[0] = gh[0]; gcur[1] = gh[1];
        if (g + 1 < 15) { const unsigned char* comp = (F.ws + WS_COMP) + (size_t)(h * 16 + g + 1) * 24576; mreg = *(const v4u*)((const bf16*)comp + pr_ * 64 + ps_ * 8);
#pragma unroll
            for (int i = 0; i < 2; ++i) gh[i] = *(const f32x4*)(comp + 8192 + ((w * 2 + i) * 64 + lane) * 16); }
        LBAR();
#pragma unroll
        for (int i = 0; i < 2; ++i) { e[i] = gcur[i]; mma16<64>(e[i], MA + 16 * tr * RW_LD, RW_LD, EHT + 16 * (tc0 + i) * RW_LD, RW_LD, fr, fq); }
    }
    LBAR();
    STAMP(13);
}
DI void rwkv_l3_item(const Ctx& F, int kind, int g, int h) { STAMP_BEGIN();
    const int tid = F.tid, lane = F.lane, w = F.wave, fr = lane & 15, fq = lane >> 4, tr = w >> 1, tc0 = 2 * (w & 1);
    const lptr L = F.lds;
    f32x4 s[2];
    int c0, nc;
    if (kind == 0) { c0 = g * 16; nc = 16; const float* ent = ((float*)(F.ws + WS_ENT)) + (size_t)(h * 16 + g) * 4096;
#pragma unroll
        for (int i = 0; i < 2; ++i) s[i] = *(const f32x4*)(ent + ((w * 2 + i) * 64 + lane) * 4); }
    else { c0 = 256 + g; nc = 1; const float* S = in_ptr(F, 3) + (size_t)(g * 8 + h) * 4096;
#pragma unroll
        for (int i = 0; i < 2; ++i) s[i] = *(const f32x4*)(S + (16 * (tc0 + i) + fr) * 64 + 16 * tr + 4 * fq); }
    const int pr_ = tid >> 3, ps_ = tid & 7;
    v4u mreg; u32x2 gq0, gq1;
    { const unsigned char* item = ((unsigned char*)F.out) + (size_t)(c0 * 8 + h) * 32768; mreg = *(const v4u*)((const bf16*)item + pr_ * 64 + ps_ * 8);
        gq0 = *(const u32x2*)(item + 16384 + ((w * 2) * 64 + lane) * 8); gq1 = *(const u32x2*)(item + 16384 + ((w * 2 + 1) * 64 + lane) * 8); }
    for (int c = c0; c < c0 + nc; ++c) {
        bf16* stg = ((bf16*)(F.ws + WS_XB)) + (size_t)(c * 8 + h) * 4096;
        const lptr MA = rw_slot(L, 2 * (c & 1)), SHT = rw_slot(L, 2 * (c & 1) + 1);
        *(LAS v4u*)(MA + pr_ * 144 + ps_ * 16) = mreg;
#pragma unroll
        for (int i = 0; i < 2; ++i) { st_tr(SHT, RW_LD, 16 * tr, 16 * (tc0 + i), s[i], fr, fq);
            *(u32x2*)(stg + (16 * (tc0 + i) + fr) * 64 + 16 * tr + 4 * fq) = pack4(s[i]); }
        f32x4 gc[2]; gc[0] = unpack4(gq0); gc[1] = unpack4(gq1);
        if (c + 1 < c0 + nc) { const unsigned char* item = ((unsigned char*)F.out) + (size_t)((c + 1) * 8 + h) * 32768; mreg = *(const v4u*)((const bf16*)item + pr_ * 64 + ps_ * 8);
            gq0 = *(const u32x2*)(item + 16384 + ((w * 2) * 64 + lane) * 8); gq1 = *(const u32x2*)(item + 16384 + ((w * 2 + 1) * 64 + lane) * 8); }
        LBAR();
#pragma unroll
        for (int i = 0; i < 2; ++i) { s[i] = gc[i]; mma16<64>(s[i], MA + 16 * tr * RW_LD, RW_LD, SHT + 16 * (tc0 + i) * RW_LD, RW_LD, fr, fq); }
    }
    LBAR();
    if (kind == 1 || g == 15) { float* out = kind == 1 ? (F.out + O_WKV_S) + (size_t)(g * 8 + h) * 4096 : (F.out + O_WKV_P) + (size_t)h * 4096;
#pragma unroll
        for (int i = 0; i < 2; ++i) *(f32x4*)(out + (16 * (tc0 + i) + fr) * 64 + 16 * tr + 4 * fq) = s[i]; }
    STAMP(14);
}
DI void rwkv_p3_item(const Ctx& F, int c, int h) { STAMP_BEGIN();
    const int tid = F.tid, lane = F.lane, w = F.wave, fr = lane & 15, fq = lane >> 4, tr = w >> 1, tc0 = 2 * (w & 1);
    const lptr L = F.lds, QA = rw_slot(L, 0), SB = rw_slot(L, 1), YS = rw_slot(L, 2);
    const unsigned char* item = ((unsigned char*)F.out) + (size_t)(c * 8 + h) * 32768;
    g2l_64x64(QA, (const bf16*)(item + 8192), tid);
    g2l_64x64(SB, ((bf16*)(F.ws + WS_XB)) + (size_t)(c * 8 + h) * 4096, tid);
    f32x4 y[2]; rw_ld_frag_bf16(item + 24576, w, lane, y);
    LBAR();
#pragma unroll
    for (int i = 0; i < 2; ++i) { mma16<64>(y[i], QA + 16 * tr * RW_LD, RW_LD, SB + 16 * (tc0 + i) * RW_LD, RW_LD, fr, fq);
#pragma unroll
        for (int r = 0; r < 4; ++r) *(LAS float*)(YS + (16 * tr + 4 * fq + r) * RW_LDF + (16 * (tc0 + i) + fr) * 4) = y[i][r]; }
    LBAR();
    {
        const int t = tid >> 3, s8 = tid & 7, i0 = 8 * s8, hi0 = h * 64 + i0;
        float yv[8], s = 0.f;
#pragma unroll
        for (int e = 0; e < 8; ++e) { yv[e] = *(LAS float*)(YS + t * RW_LDF + (i0 + e) * 4); s += yv[e]; }
        s += __shfl_xor(s, 1); s += __shfl_xor(s, 2); s += __shfl_xor(s, 4);
        const float mean = s * (1.0f / 64.0f); float q = 0.f;
#pragma unroll
        for (int e = 0; e < 8; ++e) { yv[e] -= mean; q += yv[e] * yv[e]; }
        q += __shfl_xor(q, 1); q += __shfl_xor(q, 2); q += __shfl_xor(q, 4);
        const float rstd = rsqf_(q * (1.0f / 64.0f) + RWKV_LN_EPS);
        float xv[8], lg_[8], lb_[8], gt[8], o[8];
        rw_shift(F, c, t, 1024 + hi0, xv);
        ld8f(in_ptr(F, 23) + hi0, lg_); ld8f(in_ptr(F, 24) + hi0, lb_);
        bf16* mp = ((bf16*)(F.ws + WS_MIX)) + (size_t)(c * 64 + t) * 1024 + 512 + hi0;
        ld8bf(mp, gt);
        const float rk = ((float*)(F.ws + WS_RK))[(size_t)(c * 8 + h) * 64 + t];
#pragma unroll
        for (int e = 0; e < 8; ++e) o[e] = (yv[e] * rstd * lg_[e] + lb_[e] + rk * xv[e]) * gt[e];
        *(v4u*)mp = pack8(o);
    }
    LBAR();
    STAMP(15);
}
constexpr int RT_G = 4, RT_NG = 256 / RT_G;
constexpr int RT_LDQ = 272;
constexpr int RT_LDT = 144;
constexpr int RT_LDR = 272;
constexpr int RT_OFF_Q = 0, RT_OFF_K = 17408, RT_OFF_KD = 34816, RT_OFF_V = 52224, RT_OFF_RT = 71680, RT_OFF_P = 106496, RT_OFF_OS = 0;
DI float ret_lg(int h) { return log1pf(-exp2f(-5.0f - (float)h)); }
DI int crow32(int reg, int hh) { return (reg & 3) + 8 * (reg >> 2) + 4 * hh; }
template <int MODE> DI bf16x8 frag32(lptr img, int ld, int r0, int s, int lane) {
    const int r32 = lane & 31, hh = lane >> 5;
    if (MODE == 0) return *(const LAS bf16x8*)(img + (r0 + r32) * ld + (16 * s + 8 * hh) * 2);
    const lptr p = img + (16 * s + 8 * hh + ((lane & 15) >> 2)) * ld + (r0 + 16 * ((lane >> 4) & 1) + 4 * (lane & 3)) * 2;
    const u32x2 lo = trd(p), hi = trd(p + 4 * ld); v4u w; w.x = lo.x; w.y = lo.y; w.z = hi.x; w.w = hi.y; return __builtin_bit_cast(bf16x8, w);
}
template <int KS, int MA, int MB> DI void mma32(f32x16& acc, lptr A, int lda, int ar0, lptr B, int ldb, int br0, int lane) {
#pragma unroll
    for (int s = 0; s < KS; ++s) acc = __builtin_amdgcn_mfma_f32_32x32x16_bf16(frag32<MA>(A, lda, ar0, s, lane), frag32<MB>(B, ldb, br0, s, lane), acc, 0, 0, 0);
}
DI void rope_cs(const Ctx& F, int j, int pos, float& cs, float& sn) {
    const f32x2* T = (const f32x2*)(F.ws + WS_ROPE); const f32x2 a = T[(pos >> 6) * 72 + j], b = T[(256 + (pos & 63)) * 72 + j];
    cs = a[0] * b[0] - a[1] * b[1]; sn = a[1] * b[0] + a[0] * b[1];
}
DI void ret_stage(const Ctx& F, int c, int h, bool need_qk) {
    const int tid = F.tid, t = tid >> 3, s8 = tid & 7; const lptr L = F.lds;
    const int pos = (c < 256 ? c * 64 : PAST_POS) + t;
    const bf16* row = ((bf16*)(F.ws + WS_PROJ)) + (size_t)(c * 64 + t) * N_AB;
    const float lg = ret_lg(h), qd = __expf(lg * (float)(t + 1)), kd = __expf(lg * (float)(63 - t));
    float cs[8], sn[8];
#pragma unroll
    for (int e = 0; e < 8; ++e) rope_cs(F, 8 * s8 + e, pos, cs[e], sn[e]);
    float x1[8], x2[8], o1[8], o2[8];
    ld8bf(row + 512 + h * 128 + 8 * s8, x1); ld8bf(row + 512 + h * 128 + 64 + 8 * s8, x2);
#pragma unroll
    for (int e = 0; e < 8; ++e) { o1[e] = (x1[e] * cs[e] - x2[e] * sn[e]) * 0.08838834764831845f; o2[e] = (x1[e] * sn[e] + x2[e] * cs[e]) * 0.08838834764831845f; }
    if (need_qk) { *(LAS v4u*)(L + RT_OFF_K + t * RT_LDQ + s8 * 16) = pack8(o1); *(LAS v4u*)(L + RT_OFF_K + t * RT_LDQ + 128 + s8 * 16) = pack8(o2); }
#pragma unroll
    for (int e = 0; e < 8; ++e) { o1[e] *= kd; o2[e] *= kd; }
    *(LAS v4u*)(L + RT_OFF_KD + t * RT_LDQ + s8 * 16) = pack8(o1); *(LAS v4u*)(L + RT_OFF_KD + t * RT_LDQ + 128 + s8 * 16) = pack8(o2);
    if (need_qk) {
        ld8bf(row + h * 128 + 8 * s8, x1); ld8bf(row + h * 128 + 64 + 8 * s8, x2);
#pragma unroll
        for (int e = 0; e < 8; ++e) { o1[e] = (x1[e] * cs[e] - x2[e] * sn[e]) * qd; o2[e] = (x1[e] * sn[e] + x2[e] * cs[e]) * qd; }
        *(LAS v4u*)(L + RT_OFF_Q + t * RT_LDQ + s8 * 16) = pack8(o1); *(LAS v4u*)(L + RT_OFF_Q + t * RT_LDQ + 128 + s8 * 16) = pack8(o2);
    }
    ld8bf(row + 1024 + h * 128 + 8 * s8, x1); ld8bf(row + 1024 + h * 128 + 64 + 8 * s8, x2);
    *(LAS v4u*)(L + RT_OFF_V + t * RT_LDQ + s8 * 16) = pack8(x1); *(LAS v4u*)(L + RT_OFF_V + t * RT_LDQ + 128 + s8 * 16) = pack8(x2);
}
DI void ret_kv_update(lptr L, f32x16* r, float cdec, int w, int r32, int hh) {
#pragma unroll
    for (int i = 0; i < 2; ++i) { r[i] = r[i] * cdec; mma32<4, 1, 1>(r[i], L + RT_OFF_KD, RT_LDQ, 32 * (w >> 1), L + RT_OFF_V, RT_LDQ, 32 * (2 * (w & 1) + i), hh * 32 + r32); }
}
DI void ret_ld_state(const float* S, f32x16* r, int w, int r32, int hh) {
#pragma unroll
    for (int i = 0; i < 2; ++i)
#pragma unroll
        for (int g = 0; g < 16; ++g) r[i][g] = S[(32 * (w >> 1) + crow32(g, hh)) * 128 + 32 * (2 * (w & 1) + i) + r32];
}
DI void ret_st_state(float* S, const f32x16* r, int w, int r32, int hh) {
#pragma unroll
    for (int i = 0; i < 2; ++i)
#pragma unroll
        for (int g = 0; g < 16; ++g) S[(32 * (w >> 1) + crow32(g, hh)) * 128 + 32 * (2 * (w & 1) + i) + r32] = r[i][g];
}
DI void ret_p1_item(const Ctx& F, int kind, int gi, int h) { STAMP_BEGIN();
    const int lane = F.lane, w = F.wave, r32 = lane & 31, hh = lane >> 5;
    const float cdec = __expf(ret_lg(h) * 64.0f);
    f32x16 r[2];
    int c0, nc;
    if (kind == 0) { c0 = gi * RT_G; nc = RT_G;
#pragma unroll
        for (int i = 0; i < 2; ++i)
#pragma unroll
            for (int g = 0; g < 16; ++g) r[i][g] = 0.f; }
    else { c0 = 256 + gi; nc = 1; ret_ld_state(in_ptr(F, 2) + (size_t)(gi * 4 + h) * 16384, r, w, r32, hh); }
    for (int c = c0; c < c0 + nc; ++c) {
        ret_stage(F, c, h, false);
        LBAR();
        ret_kv_update(F.lds, r, cdec, w, r32, hh);
        LBAR();
    }
    ret_st_state(kind == 0 ? ((float*)(F.ws + WS_XB + (size_t)NCH * 8 * 4096 * 2)) + (size_t)(gi * 4 + h) * 16384 : (F.out + O_RET_S) + (size_t)(gi * 4 + h) * 16384, r, w, r32, hh);
    STAMP(10);
}
DI void ret_scan(const Ctx& F, int vidx) {
    const int n = 4 * 16384;
    for (int e = vidx * 512 + F.tid; e < n; e += F.G * 512) {
        const int h = e >> 14; const float c4 = __expf(ret_lg(h) * 64.0f * (float)RT_G);
        float acc = 0.f;
#pragma unroll 4
        for (int g = 0; g < RT_NG; ++g) { float* p = ((float*)(F.ws + WS_XB + (size_t)NCH * 8 * 4096 * 2)) + (size_t)g * 65536 + e; acc = acc * c4 + *p; *p = acc; }
        (F.out + O_RET_P)[e] = acc;
    }
}
DI void ret_p3_item(const Ctx& F, int kind, int gi, int h) { STAMP_BEGIN();
    const int tid = F.tid, lane = F.lane, w = F.wave, r32 = lane & 31, hh = lane >> 5; const lptr L = F.lds;
    const float lg = ret_lg(h), cdec = __expf(lg * 64.0f);
    f32x16 r[2];
    int c0, nc;
    if (kind == 0) { c0 = gi * RT_G; nc = RT_G;
        if (gi == 0) {
#pragma unroll
            for (int i = 0; i < 2; ++i)
#pragma unroll
                for (int g = 0; g < 16; ++g) r[i][g] = 0.f; }
        else ret_ld_state(((float*)(F.ws + WS_XB + (size_t)NCH * 8 * 4096 * 2)) + (size_t)((gi - 1) * 4 + h) * 16384, r, w, r32, hh); }
    else { c0 = 256 + gi; nc = 1; ret_ld_state(in_ptr(F, 2) + (size_t)(gi * 4 + h) * 16384, r, w, r32, hh); }
    for (int c = c0; c < c0 + nc; ++c) {
        ret_stage(F, c, h, true);
#pragma unroll
        for (int i = 0; i < 2; ++i)
#pragma unroll
            for (int g4 = 0; g4 < 4; ++g4) { u32x2 v; v.x = pk2(r[i][4 * g4], r[i][4 * g4 + 1]); v.y = pk2(r[i][4 * g4 + 2], r[i][4 * g4 + 3]);
                *(LAS u32x2*)(L + RT_OFF_RT + (32 * (2 * (w & 1) + i) + r32) * RT_LDR + (32 * (w >> 1) + 8 * g4 + 4 * hh) * 2) = v; }
        LBAR();
        if (w < 4) { const int tb = w & 1, kb = w >> 1;
            f32x16 s;
#pragma unroll
            for (int g = 0; g < 16; ++g) s[g] = 0.f;
            if (kb <= tb) mma32<8, 0, 0>(s, L + RT_OFF_Q, RT_LDQ, 32 * tb, L + RT_OFF_K, RT_LDQ, 32 * kb, lane);
            const int tp = 32 * kb + r32; const float f = __expf(-lg * (float)(tp + 1));
#pragma unroll
            for (int g = 0; g < 16; ++g) { const int tq = 32 * tb + crow32(g, hh); const float pv = tq >= tp ? s[g] * f : 0.f;
                *(LAS bf16*)(L + RT_OFF_P + tq * 144 + tp * 2) = (bf16)f2bf(pv); } }
        LBAR();
        const int tb = w & 1, db = w >> 1;
        f32x16 o;
#pragma unroll
        for (int g = 0; g < 16; ++g) o[g] = 0.f;
        mma32<4, 0, 1>(o, L + RT_OFF_P, 144, 32 * tb, L + RT_OFF_V, RT_LDQ, 32 * db, lane);
        mma32<8, 0, 0>(o, L + RT_OFF_Q, RT_LDQ, 32 * tb, L + RT_OFF_RT, RT_LDR, 32 * db, lane);
        ret_kv_update(L, r, cdec, w, r32, hh);
        LBAR();
#pragma unroll
        for (int g = 0; g < 16; ++g) *(LAS float*)(L + RT_OFF_OS + (32 * tb + crow32(g, hh)) * 528 + (32 * db + r32) * 4) = o[g];
        LBAR();
        {
            const int t = tid >> 3, s8 = tid & 7;
            float v[16], s = 0.f;
#pragma unroll
            for (int e = 0; e < 16; ++e) { v[e] = *(LAS float*)(L + RT_OFF_OS + t * 528 + (16 * s8 + e) * 4); s += v[e]; }
            s += __shfl_xor(s, 1); s += __shfl_xor(s, 2); s += __shfl_xor(s, 4);
            const float mean = s * (1.0f / 128.0f); float q = 0.f;
#pragma unroll
            for (int e = 0; e < 16; ++e) { v[e] -= mean; q += v[e] * v[e]; }
            q += __shfl_xor(q, 1); q += __shfl_xor(q, 2); q += __shfl_xor(q, 4);
            const float rstd = rsqf_(q * (1.0f / 128.0f) + LN_EPS);
            const bf16* gp = ((bf16*)(F.ws + WS_PROJ)) + (size_t)(c * 64 + t) * N_AB + 1536 + h * 128 + 16 * s8;
            bf16* op = ((bf16*)(F.ws + WS_MIX)) + (size_t)(c * 64 + t) * 1024 + h * 128 + 16 * s8;
#pragma unroll
            for (int q2 = 0; q2 < 2; ++q2) { float gt[8], gn[8], o8[8]; ld8bf(gp + 8 * q2, gt); ld8f(in_ptr(F, 13) + h * 128 + 16 * s8 + 8 * q2, gn);
#pragma unroll
                for (int e = 0; e < 8; ++e) o8[e] = gt[e] * rcpf_(1.0f + __expf(-gt[e])) * (v[8 * q2 + e] * rstd * gn[e]);
                *(v4u*)(op + 8 * q2) = pack8(o8); }
        }
        LBAR();
    }
    STAMP(11);
}
constexpr int CV_OFF_U = 0, CV_OFF_Y = 63488;
DI void conv_item(const Ctx& F, int it) { STAMP_BEGIN();
    const int tid = F.tid; const lptr L = F.lds;
    const int c = it >> 1, half = it & 1;
    const int seq_t0 = c < 256 ? 0 : c * 64;
    const int ta = c * 64 + 32 * half;
    const int b = c - 256;
    for (int q = tid; q < 62 * 64; q += 512) { const int rr = q >> 6, cg = q & 63, row = ta - 30 + rr;
        float u[8];
        if (row >= seq_t0) { float a[8], g[8]; const bf16* p = ((bf16*)(F.ws + WS_PROJ)) + (size_t)row * N_CD + 8 * cg; ld8bf(p, a); ld8bf(p + 512, g);
#pragma unroll
            for (int e = 0; e < 8; ++e) u[e] = a[e] * sigmoidf_(g[e]); }
        else if (c >= 256) ld8f(in_ptr(F, 5) + ((size_t)b * 30 + (30 + row - seq_t0)) * 512 + 8 * cg, u);
        else {
#pragma unroll
            for (int e = 0; e < 8; ++e) u[e] = 0.f; }
        *(LAS v4u*)(L + CV_OFF_U + rr * 1024 + cg * 16) = pack8(u);
        const int seq_last = c < 256 ? TP - 1 : c * 64 + 63;
        if (row > seq_last - 30 && row >= seq_t0 && ((c == 255 && half == 1) || (c >= 256 && half == 1))) {
            float* dst = (c < 256 ? (F.out + O_CONV_P) : (F.out + O_CONV_S) + (size_t)b * 30 * 512) + (size_t)(row - (seq_last - 29)) * 512 + 8 * cg; st8f(dst, u); }
    }
    LBAR();
    {
        const int ch = tid; float wgt[31];
#pragma unroll
        for (int k = 0; k < 31; ++k) wgt[k] = in_ptr(F, 27)[k * 512 + ch];
        const float bias = in_ptr(F, 28)[ch];
        float uv[62];
#pragma unroll
        for (int r = 0; r < 62; ++r) uv[r] = bf2f(*(LAS bf16*)(L + CV_OFF_U + r * 1024 + ch * 2));
#pragma unroll
        for (int t = 0; t < 32; ++t) { float acc = bias;
#pragma unroll
            for (int k = 0; k < 31; ++k) acc += wgt[k] * uv[t + k];
            *(LAS float*)(L + CV_OFF_Y + t * 2048 + ch * 4) = acc; }
    }
    LBAR();
    {
        const int t = tid >> 4, sub = tid & 15; f32x4 v[8]; float s = 0.f;
#pragma unroll
        for (int k = 0; k < 8; ++k) { v[k] = *(LAS f32x4*)(L + CV_OFF_Y + t * 2048 + (64 * k + 4 * sub) * 4); s += (v[k][0] + v[k][1]) + (v[k][2] + v[k][3]); }
        s += __shfl_xor(s, 1); s += __shfl_xor(s, 2); s += __shfl_xor(s, 4); s += __shfl_xor(s, 8);
        const float mean = s * (1.0f / 512.0f); float q = 0.f;
#pragma unroll
        for (int k = 0; k < 8; ++k) { v[k] = v[k] - mean; q += (v[k][0] * v[k][0] + v[k][1] * v[k][1]) + (v[k][2] * v[k][2] + v[k][3] * v[k][3]); }
        q += __shfl_xor(q, 1); q += __shfl_xor(q, 2); q += __shfl_xor(q, 4); q += __shfl_xor(q, 8);
        const float rstd = rsqf_(q * (1.0f / 512.0f) + LN_EPS);
        bf16* op = ((bf16*)(F.ws + WS_MIX)) + (size_t)(ta + t) * 1024;
#pragma unroll
        for (int k = 0; k < 8; ++k) { const int ch = 64 * k + 4 * sub; const f32x4 g = *(const f32x4*)(in_ptr(F, 29) + ch), bb = *(const f32x4*)(in_ptr(F, 30) + ch);
            f32x4 o;
#pragma unroll
            for (int e = 0; e < 4; ++e) { const float z = v[k][e] * rstd * g[e] + bb[e]; o[e] = z * rcpf_(1.0f + __expf(-z)); }
            *(u32x2*)(op + ch) = pack4(o); }
    }
    LBAR();
    STAMP(17);
}

constexpr int AT_OFF_K = 0, AT_OFF_V = 27648, AT_OFF_TBL = 55296, AT_LDK = 144;
DI void attn_item(const Ctx& F, int c, int kh) { STAMP_BEGIN();
    const int tid = F.tid, lane = F.lane, w = F.wave, r32 = lane & 31, hh = lane >> 5; const lptr L = F.lds;
    const int b = c - 256;
    const int row0 = c * 64 - 128;
    const int kvalid0 = c >= 256 ? 0 : (c == 0 ? 128 : (c == 1 ? 64 : 0));
    const bool last = (c == 255) || (c >= 256);
    for (int q = tid; q < 192 * 8; q += 512) { const int key = q >> 3, e = q & 7; const int pos = c >= 256 ? PAST_POS + (key - 128) : row0 + key;
        float cs, sn; rope_cs(F, 64 + e, pos < 0 ? 0 : pos, cs, sn); *(LAS f32x2*)(L + AT_OFF_TBL + q * 8) = (f32x2){cs, sn}; }
    LBAR();
    for (int q = tid; q < 192 * 8; q += 512) { const int key = q >> 3, s8 = q & 7;
        float kx[8], vx[8];
        if (c >= 256 && key < 128) { ld8f(in_ptr(F, 6) + (((size_t)b * 128 + key) * 2 + kh) * 64 + 8 * s8, kx); ld8f(in_ptr(F, 7) + (((size_t)b * 128 + key) * 2 + kh) * 64 + 8 * s8, vx); }
        else if (key < kvalid0) {
#pragma unroll
            for (int e = 0; e < 8; ++e) { kx[e] = 0.f; vx[e] = 0.f; } }
        else { const int row = c >= 256 ? c * 64 + (key - 128) : row0 + key; const bf16* p = ((bf16*)(F.ws + WS_PROJ)) + (size_t)row * N_CD;
            ld8bf(p + 1536 + kh * 64 + 8 * s8, kx); ld8bf(p + 1664 + kh * 64 + 8 * s8, vx);
            if (s8 < 2) {
                float px[8]; ld8bf(p + 1536 + kh * 64 + 8 * (s8 ^ 1), px);
#pragma unroll
                for (int e = 0; e < 8; ++e) { const f32x2 t2 = *(const LAS f32x2*)(L + AT_OFF_TBL + (key * 8 + e) * 8); const float cs = t2[0], sn = t2[1]; kx[e] = s8 == 0 ? kx[e] * cs - px[e] * sn : px[e] * sn + kx[e] * cs; }
            } }
        *(LAS v4u*)(L + AT_OFF_K + key * AT_LDK + s8 * 16) = pack8(kx);
        *(LAS v4u*)(L + AT_OFF_V + key * AT_LDK + s8 * 16) = pack8(vx);
        if (last && key >= 64) { float* kd = (c == 255 ? (F.out + O_K_P) : (F.out + O_K_S) + (size_t)b * 16384) + ((size_t)(key - 64) * 2 + kh) * 64 + 8 * s8;
            float* vd = (c == 255 ? (F.out + O_V_P) : (F.out + O_V_S) + (size_t)b * 16384) + ((size_t)(key - 64) * 2 + kh) * 64 + 8 * s8; st8f(kd, kx); st8f(vd, vx); }
    }
    const int hq = 4 * kh + (w >> 1), qrow = c * 64 + 32 * (w & 1) + r32;
    bf16x8 qf[4];
    { const bf16* qp = ((bf16*)(F.ws + WS_PROJ)) + (size_t)qrow * N_CD + 1024 + hq * 64;
#pragma unroll
        for (int s = 0; s < 4; ++s) { float x[8]; ld8bf(qp + 16 * s + 8 * hh, x);
            if (s == 0) { float px[8]; ld8bf(qp + 8 * (hh ^ 1), px);
#pragma unroll
                for (int e = 0; e < 8; ++e) { const f32x2 t2 = *(const LAS f32x2*)(L + AT_OFF_TBL + ((128 + 32 * (w & 1) + r32) * 8 + e) * 8); const float cs = t2[0], sn = t2[1]; x[e] = hh == 0 ? x[e] * cs - px[e] * sn : px[e] * sn + x[e] * cs; } }
            const v4u pk = pack8(x); qf[s] = __builtin_bit_cast(bf16x8, pk); } }
    LBAR();
    f32x16 x[6];
#pragma unroll
    for (int kb = 0; kb < 6; ++kb) {
#pragma unroll
        for (int g = 0; g < 16; ++g) x[kb][g] = 0.f;
#pragma unroll
        for (int s = 0; s < 4; ++s) { const bf16x8 a = *(const LAS bf16x8*)(L + AT_OFF_K + (32 * kb + r32) * AT_LDK + (16 * s + 8 * hh) * 2);
            x[kb] = __builtin_amdgcn_mfma_f32_32x32x16_bf16(a, qf[s], x[kb], 0, 0, 0); }
        __builtin_amdgcn_sched_barrier(0); }
    const float sink = in_ptr(F, 31)[hq];
    float m = sink;
#pragma unroll
    for (int kb = 0; kb < 6; ++kb)
#pragma unroll
        for (int g = 0; g < 16; ++g) { float sv = x[kb][g] * 0.125f; if (32 * kb < kvalid0) sv = -1e30f; x[kb][g] = sv; m = fmaxf(m, sv); }
    m = fmaxf(m, __shfl_xor(m, 32));
    float den = 0.f;
#pragma unroll
    for (int kb = 0; kb < 6; ++kb)
#pragma unroll
        for (int g = 0; g < 16; ++g) { const float e = __expf(x[kb][g] - m); x[kb][g] = e; den += e; }
    den += __shfl_xor(den, 32);
    den += __expf(sink - m);
    const float rden = rcpf_(den);
#pragma unroll
    for (int kb = 0; kb < 6; ++kb)
#pragma unroll
        for (int g = 0; g < 16; ++g) x[kb][g] *= rden;
    bf16* op = ((bf16*)(F.ws + WS_MIX)) + (size_t)(c * 64 + 32 * (w & 1)) * 1024 + 512 + hq * 64;
#pragma unroll
    for (int db = 0; db < 2; ++db) {
        f32x16 o;
#pragma unroll
        for (int g = 0; g < 16; ++g) o[g] = 0.f;
#pragma unroll
        for (int kb = 0; kb < 6; ++kb)
#pragma unroll
            for (int s = 0; s < 2; ++s) {
                float pv[8];
#pragma unroll
                for (int j = 0; j < 8; ++j) pv[j] = x[kb][8 * s + j];
                const v4u pk = pack8(pv); const bf16x8 pa = __builtin_bit_cast(bf16x8, pk);
                const lptr vp = L + AT_OFF_V + (32 * kb + 16 * s + 4 * hh + ((lane & 15) >> 2)) * AT_LDK + (32 * db + 16 * ((lane >> 4) & 1) + 4 * (lane & 3)) * 2;
                const u32x2 lo = trd(vp), hi = trd(vp + 8 * AT_LDK);
                v4u bv; bv.x = lo.x; bv.y = lo.y; bv.z = hi.x; bv.w = hi.y;
                o = __builtin_amdgcn_mfma_f32_32x32x16_bf16(pa, __builtin_bit_cast(bf16x8, bv), o, 0, 0, 0);
                __builtin_amdgcn_sched_barrier(0); }
#pragma unroll
        for (int g = 0; g < 16; ++g) op[(size_t)crow32(g, hh) * 1024 + 32 * db + r32] = (bf16)f2bf(o[g]);
    }
    LBAR();
    STAMP(16);
}
DI float wave_sum(float v) {
#pragma unroll
    for (int o = 1; o < 64; o <<= 1) v += __shfl_xor(v, o);
    return v;
}
DI void p0_transpose_item(const float* W, int K, int N, bf16* WT, int k0, int n0, int dst_row0, const float* gk, LAS float* scr, int lane) {
    {   const int kr = lane >> 3, n4 = (lane & 7) * 4; f32x4 v[8];
#pragma unroll
        for (int i = 0; i < 8; ++i) v[i] = *(const GAS f32x4*)(W + (size_t)(k0 + kr + 8 * i) * N + n0 + n4);
#pragma unroll
        for (int i = 0; i < 8; ++i) { const int kk = kr + 8 * i; const float g = gk ? gk[k0 + kk] : 1.0f;
#pragma unroll
            for (int e = 0; e < 4; ++e) scr[kk * 33 + n4 + e] = v[i][e] * g; } }
    LDS_WAIT(); asm volatile("" ::: "memory");
    const int c = lane & 7;
#pragma unroll
    for (int j = 0; j < 4; ++j) { const int n = (lane >> 3) + 8 * j; const LAS float* s = scr + (8 * c) * 33 + n;
        v4u o; o.x = pk2(s[0 * 33], s[1 * 33]); o.y = pk2(s[2 * 33], s[3 * 33]); o.z = pk2(s[4 * 33], s[5 * 33]); o.w = pk2(s[6 * 33], s[7 * 33]);
        *(GAS v4u*)(WT + (size_t)(dst_row0 + n) * K + k0 + 8 * c) = o; }
    LDS_WAIT(); asm volatile("" ::: "memory");
}
DI void p0_prologue(const Ctx& F) {
    LAS float* scr = (LAS float*)(F.lds + F.wave * 16384);
    const int gw = F.vcu * NWAVES + F.wave, NGW = F.G * NWAVES, lane = F.lane;
    for (int q = F.vcu * 512 + F.tid; q < (256 + 64) * 72; q += F.G * 512) { const int r = q / 72, j = q % 72; const int pos = r < 256 ? 64 * r : r - 256;
        const double inv = j < 64 ? exp((double)j * (-2.0 * log(10000.0) / 128.0)) : exp((double)(j - 64) * (-2.0 * log(500000.0) / 16.0));
        const double a = (double)pos * inv, k = rint(a * 0.15915494309189535), rr = a - k * 6.283185307179586;
        ((f32x2*)(F.ws + WS_ROPE))[q] = (f32x2){(float)cos(rr), (float)sin(rr)}; }
    for (int q = F.vcu * 512 + F.tid; q < 17 * RWKV_PROJ; q += F.G * 512) ((bf16*)(F.ws + WS_SHB))[q] = q < 16 * RWKV_PROJ ? (bf16)f2bf(in_ptr(F, 4)[q]) : (bf16)0;
    constexpr int I_INAB = 16 * (N_AB / 32), I_SQ = 16 * 32, I_INCD = 16 * (N_CD / 32), I_GU = 16 * (D_FF / 32), I_DN = (D_FF / 64) * 32;
    constexpr int NITEMS = I_INAB + 2 * I_SQ + I_INCD + 4 * I_GU + 2 * I_DN;
    for (int it = gw; it < NITEMS; it += NGW) {
        int r = it;
        if (r < I_INAB) { const int nb = N_AB / 32; p0_transpose_item(in_ptr(F, 11), 1024, N_AB, ((bf16*)(F.ws + WS_W_INAB)), 64 * (r / nb), 32 * (r % nb), 32 * (r % nb), in_ptr(F, 8), scr, lane); continue; } r -= I_INAB;
        if (r < I_SQ) { p0_transpose_item(in_ptr(F, 12), 1024, 1024, ((bf16*)(F.ws + WS_W_OUTAB)), 64 * (r / 32), 32 * (r % 32), 32 * (r % 32), nullptr, scr, lane); continue; } r -= I_SQ;
        if (r < I_INCD) { const int nb = N_CD / 32; p0_transpose_item(in_ptr(F, 25), 1024, N_CD, ((bf16*)(F.ws + WS_W_INCD)), 64 * (r / nb), 32 * (r % nb), 32 * (r % nb), in_ptr(F, 8) + 1024, scr, lane); continue; } r -= I_INCD;
        if (r < I_SQ) { p0_transpose_item(in_ptr(F, 26), 1024, 1024, ((bf16*)(F.ws + WS_W_OUTCD)), 64 * (r / 32), 32 * (r % 32), 32 * (r % 32), nullptr, scr, lane); continue; } r -= I_SQ;
        if (r < 4 * I_GU) { const int which = r / I_GU, l = which >> 1, up = which & 1, q = r % I_GU, nb = D_FF / 32, n0 = 32 * (q % nb);
            p0_transpose_item((up ? in_ptr(F, 33) : in_ptr(F, 32)) + (size_t)l * 1024 * D_FF, 1024, D_FF, ((bf16*)(F.ws + WS_W_GU)) + (size_t)l * N_GU * 1024, 64 * (q / nb), n0, 256 * (n0 >> 7) + 128 * up + (n0 & 127), in_ptr(F, 9) + l * 1024, scr, lane); continue; } r -= 4 * I_GU;
        { const int l = r / I_DN, q = r % I_DN; p0_transpose_item(in_ptr(F, 34) + (size_t)l * D_FF * 1024, D_FF, 1024, ((bf16*)(F.ws + WS_W_DN)) + (size_t)l * 1024 * D_FF, 64 * (q / 32), 32 * (q % 32), 32 * (q % 32), nullptr, scr, lane); }
    }
    for (int m = gw; m < T_ALL; m += NGW) {
        const float* xrow = m < TP ? in_ptr(F, 0) + (size_t)m * 1024 : in_ptr(F, 1) + (size_t)(m - TP) * 1024;
        const GAS f32x4* xr = (const GAS f32x4*)xrow + lane; f32x4 v[4]; float s = 0.f;
#pragma unroll
        for (int j = 0; j < 4; ++j) { v[j] = xr[64 * j]; s += (v[j][0] * v[j][0] + v[j][1] * v[j][1]) + (v[j][2] * v[j][2] + v[j][3] * v[j][3]); }
        s = wave_sum(s);
        GAS unsigned long long* o8 = (GAS unsigned long long*)(((bf16*)(F.ws + WS_XB)) + (size_t)m * 1024) + lane;
#pragma unroll
        for (int j = 0; j < 4; ++j) o8[64 * j] = (unsigned long long)pk2(v[j][0], v[j][1]) | ((unsigned long long)pk2(v[j][2], v[j][3]) << 32);
        if (lane < 16) ((float*)(F.ws + WS_SS))[(size_t)m * 16 + lane] = lane == 0 ? s : 0.f;
    }
}
DI void final_norm(const Ctx& F) {
    const int gw = F.vcu * NWAVES + F.wave, NGW = F.G * NWAVES, lane = F.lane;
    for (int m = gw; m < T_ALL; m += NGW) {
        const float rs = pg8::row_rstd(((float*)(F.ws + WS_SS)), m);
        GAS f32x4* xr = (GAS f32x4*)((F.out + O_Y) + (size_t)m * 1024) + lane; const f32x4* gp = (const f32x4*)in_ptr(F, 10) + lane;
#pragma unroll
        for (int j = 0; j < 4; ++j) { const f32x4 v = xr[64 * j], g = gp[64 * j]; xr[64 * j] = v * rs * g; }
    }
}

constexpr int N_PHASES = 16;
struct Args { const float* in[35]; float* out; unsigned char* ws; int ph_lo, ph_hi, li, pad; };
__global__ void __launch_bounds__(NWAVES * 64, 2) hybrid_fwd(Args args) {
    extern __shared__ __attribute__((aligned(16))) unsigned char lds_raw[];
    Ctx F;
    F.lds = (lptr)lds_raw;
    volatile LAS unsigned* MISC = (volatile LAS unsigned*)(F.lds + MISC_OFF);
    F.tid = threadIdx.x; F.lane = F.tid & 63; F.wave = __builtin_amdgcn_readfirstlane(F.tid >> 6);
    F.G = gridDim.x; { const int bx = blockIdx.x; F.vcu = (F.G % 8 == 0) ? (bx % 8) * (F.G / 8) + bx / 8 : bx; }
    unsigned char* ws = args.ws;
    F.out = args.out; F.ws = args.ws;
    for (int u = F.tid; u < (LDS_BYTES - RING_BYTES) / 4; u += NWAVES * 64) ((LAS unsigned*)(F.lds + RING_BYTES))[u] = 0u;
    __syncthreads();
    XcdBarrier bar = xcd_barrier_post((unsigned*)(ws + WS_CTL) + 1024 + args.li * XCD_BAR_WORDS, MISC + 8);
    const int lo = args.ph_lo, hi = args.ph_hi, G = F.G, vcu = F.vcu;
#ifndef PH_MASK
#define PH_MASK 0xFFFF
#endif
#define IN(k) (((PH_MASK >> (k)) & 1) && lo <= (k) && (k) < hi)
#ifndef PROBE_LO
#define PROBE_LO -1
#define PROBE_HI -1
#endif
    unsigned long long pr_t0 = 0, pr_dt = 0; F.pr = &pr_dt;
#define SEAM(k) do { if (IN(k) && IN((k) + 1)) xcd_barrier(bar); \
        if ((k) + 1 == PROBE_LO) pr_t0 = __builtin_amdgcn_s_memrealtime(); if ((k) == PROBE_HI) pr_dt = __builtin_amdgcn_s_memrealtime() - pr_t0; } while (0)
    if (PROBE_LO == 0) pr_t0 = __builtin_amdgcn_s_memrealtime();
    typedef pg8::bf16_t gb;
    if (IN(0)) { p0_prologue(F); } SEAM(0);
    if (IN(1)) { pg8::Gemm g{(const gb*)((bf16*)(F.ws + WS_XB)), (const gb*)((bf16*)(F.ws + WS_W_INAB)), T_ALL, N_AB, 1024}; pg8::StaticOrder S; S.init(T_ALL, N_AB, G, (int)blockIdx.x);
        pg8::EpiNormBf16 E{(gb*)((bf16*)(F.ws + WS_PROJ)), N_AB, ((float*)(F.ws + WS_SS))}; pg8::gemm_phase<pg8::EpiNormBf16, pg8::StaticOrder, true, true>(F.lds, g, S, E); } SEAM(1);
    if (IN(2)) {
        for (int it = vcu; it < 320; it += G) { if (it < 256) ret_p1_item(F, 0, it >> 2, it & 3); else ret_p1_item(F, 1, (it - 256) >> 2, it & 3); }
        { RwPre R; int it = (vcu + G - (64 % G)) % G, hcur = -1;
            if (it < NCH * 8) rw_prefetch(F, it >> 3, it & 7, R);
            for (; it < NCH * 8; it += G) { const int h = it & 7, nx = it + G; if (h != hcur) { rw_load_params(F, h); hcur = h; }
                rwkv_p1_item(F, it >> 3, h, R, nx < NCH * 8, nx >> 3, nx & 7); } }
    } SEAM(2);
    if (IN(3)) { for (int it = vcu; it < 128; it += G) rwkv_l1_item(F, it & 15, it >> 4);
        ret_scan(F, (vcu + G - (128 % G)) % G); } SEAM(3);
    if (IN(4)) { for (int it = vcu; it < 8; it += G) rwkv_l2_item(F, it);
        for (int it = (vcu + G - (8 % G)) % G; it < 320; it += G) { if (it < 256) ret_p3_item(F, 0, it >> 2, it & 3); else ret_p3_item(F, 1, (it - 256) >> 2, it & 3); } } SEAM(4);
    if (IN(5)) { for (int it = vcu; it < 256; it += G) { if (it < 128) rwkv_l3_item(F, 0, it & 15, it >> 4); else rwkv_l3_item(F, 1, (it - 128) >> 3, it & 7); } } SEAM(5);
    if (IN(6)) { for (int it = vcu; it < NCH * 8; it += G) rwkv_p3_item(F, it >> 3, it & 7); } SEAM(6);
    if (IN(7)) {
        { const pg8::ResidOp<0, false> rs{in_ptr(F, 1), TP, nullptr, (gb*)((bf16*)(F.ws + WS_XB))}; for (int tl = vcu; tl < 256; tl += G) gemm_small64(F, ((bf16*)(F.ws + WS_MIX)), ((bf16*)(F.ws + WS_W_OUTAB)), 1024, tl, rs, ((float*)(F.ws + WS_SS))); }
        pg8::Gemm g{(const gb*)((bf16*)(F.ws + WS_MIX)), (const gb*)((bf16*)(F.ws + WS_W_OUTAB)), TP, 1024, 1024}; pg8::StaticOrder S; S.init(TP, 1024, G, (int)blockIdx.x);
        pg8::EpiResid<0, false> E{{in_ptr(F, 0), 0, nullptr, (gb*)((bf16*)(F.ws + WS_XB))}, ((float*)(F.ws + WS_SS))}; pg8::gemm_phase<pg8::EpiResid<0, false>, pg8::StaticOrder, true, true>(F.lds, g, S, E); } SEAM(7);
    if (IN(8)) { pg8::Gemm g{(const gb*)((bf16*)(F.ws + WS_XB)), (const gb*)((bf16*)(F.ws + WS_W_GU)), T_ALL, N_GU, 1024}; pg8::StaticOrder S; S.init(T_ALL, N_GU, G, (int)blockIdx.x);
        pg8::EpiSwiGLU E{(gb*)((bf16*)(F.ws + WS_PROJ)), D_FF, ((float*)(F.ws + WS_SS))}; pg8::gemm_phase<pg8::EpiSwiGLU, pg8::StaticOrder, true, true>(F.lds, g, S, E); } SEAM(8);
    if (IN(9)) {
        { const pg8::ResidOp<1, false> rs{nullptr, 0, nullptr, (gb*)((bf16*)(F.ws + WS_XB))}; for (int tl = vcu; tl < 256; tl += G) gemm_small64(F, ((bf16*)(F.ws + WS_PROJ)), ((bf16*)(F.ws + WS_W_DN)), D_FF, tl, rs, ((float*)(F.ws + WS_SS))); }
        pg8::Gemm g{(const gb*)((bf16*)(F.ws + WS_PROJ)), (const gb*)((bf16*)(F.ws + WS_W_DN)), TP, 1024, D_FF}; pg8::StaticOrder S; S.init(TP, 1024, G, (int)blockIdx.x);
        pg8::EpiResid<1, false> E{{nullptr, 0, nullptr, (gb*)((bf16*)(F.ws + WS_XB))}, ((float*)(F.ws + WS_SS))}; pg8::gemm_phase<pg8::EpiResid<1, false>, pg8::StaticOrder, true, true>(F.lds, g, S, E); } SEAM(9);
    if (IN(10)) { pg8::Gemm g{(const gb*)((bf16*)(F.ws + WS_XB)), (const gb*)((bf16*)(F.ws + WS_W_INCD)), T_ALL, N_CD, 1024}; pg8::StaticOrder S; S.init(T_ALL, N_CD, G, (int)blockIdx.x);
        pg8::EpiNormBf16 E{(gb*)((bf16*)(F.ws + WS_PROJ)), N_CD, ((float*)(F.ws + WS_SS))}; pg8::gemm_phase<pg8::EpiNormBf16, pg8::StaticOrder, true, true>(F.lds, g, S, E); } SEAM(10);
    if (IN(11)) {
        for (int it = vcu; it < 544; it += G) attn_item(F, it >> 1, it & 1);
        for (int it = (vcu + G - (32 % G)) % G; it < 544; it += G) conv_item(F, it);
    } SEAM(11);
    if (IN(12)) {
        { const pg8::ResidOp<1, false> rs{nullptr, 0, nullptr, (gb*)((bf16*)(F.ws + WS_XB))}; for (int tl = vcu; tl < 256; tl += G) gemm_small64(F, ((bf16*)(F.ws + WS_MIX)), ((bf16*)(F.ws + WS_W_OUTCD)), 1024, tl, rs, ((float*)(F.ws + WS_SS))); }
        pg8::Gemm g{(const gb*)((bf16*)(F.ws + WS_MIX)), (const gb*)((bf16*)(F.ws + WS_W_OUTCD)), TP, 1024, 1024}; pg8::StaticOrder S; S.init(TP, 1024, G, (int)blockIdx.x);
        pg8::EpiResid<1, false> E{{nullptr, 0, nullptr, (gb*)((bf16*)(F.ws + WS_XB))}, ((float*)(F.ws + WS_SS))}; pg8::gemm_phase<pg8::EpiResid<1, false>, pg8::StaticOrder, true, true>(F.lds, g, S, E); } SEAM(12);
    if (IN(13)) { pg8::Gemm g{(const gb*)((bf16*)(F.ws + WS_XB)), (const gb*)(((bf16*)(F.ws + WS_W_GU)) + (size_t)N_GU * 1024), T_ALL, N_GU, 1024}; pg8::StaticOrder S; S.init(T_ALL, N_GU, G, (int)blockIdx.x);
        pg8::EpiSwiGLU E{(gb*)((bf16*)(F.ws + WS_PROJ)), D_FF, ((float*)(F.ws + WS_SS))}; pg8::gemm_phase<pg8::EpiSwiGLU, pg8::StaticOrder, true, true>(F.lds, g, S, E); } SEAM(13);
    if (IN(14)) {
        { const pg8::ResidOp<1, true> rs{nullptr, 0, (F.out + O_Y), (gb*)((bf16*)(F.ws + WS_XB))}; for (int tl = vcu; tl < 256; tl += G) gemm_small64(F, ((bf16*)(F.ws + WS_PROJ)), (((bf16*)(F.ws + WS_W_DN)) + (size_t)1024 * D_FF), D_FF, tl, rs, ((float*)(F.ws + WS_SS))); }
        pg8::Gemm g{(const gb*)((bf16*)(F.ws + WS_PROJ)), (const gb*)(((bf16*)(F.ws + WS_W_DN)) + (size_t)1024 * D_FF), TP, 1024, D_FF}; pg8::StaticOrder S; S.init(TP, 1024, G, (int)blockIdx.x);
        pg8::EpiResid<1, true> E{{nullptr, 0, (F.out + O_Y), (gb*)((bf16*)(F.ws + WS_XB))}, ((float*)(F.ws + WS_SS))}; pg8::gemm_phase<pg8::EpiResid<1, true>, pg8::StaticOrder, true, true>(F.lds, g, S, E); } SEAM(14);
    if (IN(15)) final_norm(F);
    if (PROBE_HI == 15) { asm volatile("s_waitcnt vmcnt(0)" ::: "memory"); pr_dt = __builtin_amdgcn_s_memrealtime() - pr_t0; }
    if ((PROBE_LO >= 0 || PROBE_SUB >= 0) && blockIdx.x == 0) { const unsigned long long t1 = __builtin_amdgcn_s_memrealtime(); while (__builtin_amdgcn_s_memrealtime() - t1 < pr_dt) __builtin_amdgcn_s_sleep(8); }
#undef IN
#undef SEAM
}

#ifndef MK_SPLIT
#define MK_SPLIT 0
#endif
extern "C" void kernel_launch(void* const* d_in, const int* in_sizes, int n_in, void* d_out, int out_size, void* d_ws, size_t ws_size, hipStream_t stream) {
    static int grid = 0;
    if (grid == 0) {
        if (n_in != 35 || out_size != (int)O_END || ws_size < WS_END) { fprintf(stderr, "kernel_launch: unexpected shapes: n_in %d out %d ws %zu\n", n_in, out_size, ws_size); grid = -1; return; }
        int dev = 0, cus = 0, per_cu = 0;
        if (hipGetDevice(&dev) != hipSuccess || hipDeviceGetAttribute(&cus, hipDeviceAttributeMultiprocessorCount, dev) != hipSuccess) { grid = -1; return; }
        if (hipFuncSetAttribute((const void*)hybrid_fwd, hipFuncAttributeMaxDynamicSharedMemorySize, LDS_BYTES) != hipSuccess) { fprintf(stderr, "kernel_launch: hipFuncSetAttribute failed\n"); grid = -1; return; }
        if (hipOccupancyMaxActiveBlocksPerMultiprocessor(&per_cu, (const void*)hybrid_fwd, NWAVES * 64, LDS_BYTES) != hipSuccess || per_cu < 1) { fprintf(stderr, "kernel_launch: occupancy query says %d blocks per CU; nothing launched\n", per_cu); (void)hipGetLastError(); grid = -1; return; }
        grid = cus;
    }
    if (grid < 0) return;
    (void)hipMemsetAsync((char*)d_ws + WS_CTL, 0, CTL_ZERO_BYTES, stream);
    Args a{};
    for (int i = 0; i < 35; ++i) a.in[i] = (const float*)d_in[i];
    a.out = (float*)d_out; a.ws = (unsigned char*)d_ws;
#if MK_SPLIT
    for (int p = 0; p < N_PHASES; ++p) { a.ph_lo = p; a.ph_hi = p + 1; a.li = 0; hipLaunchKernelGGL(hybrid_fwd, dim3(grid), dim3(NWAVES * 64), LDS_BYTES, stream, a); }
#else
    a.ph_lo = 0; a.ph_hi = N_PHASES; a.li = 0;
    hipLaunchKernelGGL(hybrid_fwd, dim3(grid), dim3(NWAVES * 64), LDS_BYTES, stream, a);
#endif
}
```

```cpp
#include <hip/hip_runtime.h>
#include <cstdio>
#include <cstdint>
#include <cmath>

constexpr int D_MODEL = 1024, TP = 16384, NSAMP = 16, LS = 64, T_ALL = TP + NSAMP * LS;
constexpr int NCH = T_ALL / 64;
constexpr int N_AB = 3840, N_CD = 1792, D_FF = 2816, N_GU = 2 * D_FF;
constexpr int PAST_POS = 4096;
constexpr int RWKV_PROJ = 1792, RW_OFF = 2048;
constexpr float RMS_EPS = 1e-6f, LN_EPS = 1e-5f, RWKV_LN_EPS = 64e-5f;
namespace pg8 {
#define PG8_LAS __attribute__((address_space(3)))
typedef unsigned short bf16_t;
typedef short bf16x8 __attribute__((ext_vector_type(8)));
typedef float f32x4 __attribute__((ext_vector_type(4)));
typedef unsigned u32x4 __attribute__((ext_vector_type(4)));
constexpr int BM = 256, BK = 64, HALF = 128, HTB = HALF * BK * 2  , STAGE_BYTES = 8 * HTB, NXCD = 8, WGM = 8;

__host__ __device__ __forceinline__ int lds_byte(int r, int c) { const int st = (r >> 4) * 2 + (c >> 5), rr = r & 15, cc = c & 31, ob = rr * 64 + cc * 2; return st * 1024 + (ob ^ (((ob >> 9) & 1) << 5)); }
__host__ __device__ __forceinline__ void stage_rc(int b, int& R, int& C) { const int st = b / 1024, sb = b % 1024, swz = sb ^ (((sb >> 9) & 1) << 5); R = (st >> 1) * 16 + swz / 64; C = (st & 1) * 32 + (swz % 64) / 2; }
__host__ __device__ __forceinline__ int perm32(int rho) { const int n = rho >> 4, i = rho & 15; return 8 * (i >> 2) + 4 * n + (i & 3); }

struct Unit { int pm, pn; };
struct Gemm { const bf16_t* A; const bf16_t* Bt; int M, N, K; };

struct StaticOrder {
    int nM, nN, nwg, G, c;
    __host__ __device__ void init(int M, int N, int G_, int c_) { nM = M / BM; nN = N / BM; nwg = nM * nN; G = G_; c = c_; }
    __host__ __device__ bool next(int i, Unit& u) const {
        const long L = (long)i * G + c; if (L >= nwg) return false;
        int wgid = (int)L; { const int q = nwg / NXCD, r = nwg % NXCD, xcd = wgid % NXCD, off = wgid / NXCD; wgid = (xcd < r ? xcd * (q + 1) : r * (q + 1) + (xcd - r) * q) + off; }
        const int nig = WGM * nN, gid = wgid / nig, fm = gid * WGM, gsz = (nM - fm) < WGM ? (nM - fm) : WGM;
        u.pm = fm + ((wgid % nig) % gsz); u.pn = (wgid % nig) / gsz; return true;
    }
    __device__ __forceinline__ void a_ready(const Unit&) const {}
    __device__ __forceinline__ void done(const Unit&) const {}
};

__device__ __forceinline__ unsigned cvt_pk_bf16(float lo, float hi) { unsigned r; asm volatile("v_cvt_pk_bf16_f32 %0, %1, %2" : "=v"(r) : "v"(lo), "v"(hi)); return r; }
__device__ __forceinline__ float row_rstd(const float* SS, int row) {
    const f32x4* p = (const f32x4*)(SS + (size_t)row * 16);
    const f32x4 a = p[0], b = p[1], c = p[2], d = p[3];
    const float s = (((a[0] + a[1]) + (a[2] + a[3])) + ((b[0] + b[1]) + (b[2] + b[3]))) + (((c[0] + c[1]) + (c[2] + c[3])) + ((d[0] + d[1]) + (d[2] + d[3])));
    return __builtin_amdgcn_rsqf(s * (1.0f / 1024.0f) + 1e-6f);
}
struct EpiNormBf16 {
    static constexpr bool PERM = true, AFTER_DRAIN = false;
    bf16_t* O; int ldc; const float* SS;
    __device__ __forceinline__ void operator()(const f32x4 (&acc)[2][2][4][2], const Unit& u, int wr, int wc, int fr, int fq) const {
        const int row0 = u.pm * BM + wr * 64 + fr, col0 = u.pn * BM + wc * 32 + 8 * fq;
#pragma unroll
        for (int ai = 0; ai < 2; ++ai)
#pragma unroll
            for (int m = 0; m < 4; ++m) { const int row = row0 + ai * HALF + m * 16; const float rs = row_rstd(SS, row); bf16_t* rowp = O + (size_t)row * ldc + col0;
#pragma unroll
                for (int bj = 0; bj < 2; ++bj) { const f32x4 v0 = acc[ai][bj][m][0] * rs, v1 = acc[ai][bj][m][1] * rs;
                    u32x4 w; w.x = cvt_pk_bf16(v0[0], v0[1]); w.y = cvt_pk_bf16(v0[2], v0[3]); w.z = cvt_pk_bf16(v1[0], v1[1]); w.w = cvt_pk_bf16(v1[2], v1[3]);
                    *(u32x4*)(rowp + bj * HALF) = w; } }
    }
};
template <int RES, bool OUT32> struct ResidOp {
    const float* res32; int res_row0;
    float* X; bf16_t* XB;
    __device__ __forceinline__ float operator()(int row, int col, f32x4 v0, f32x4 v1) const {
        if (RES == 0) { const float* rp = res32 + (size_t)(row - res_row0) * 1024 + col; v0 = v0 + *(const f32x4*)rp; v1 = v1 + *(const f32x4*)(rp + 4); }
        else { const u32x4 w = *(const u32x4*)(XB + (size_t)row * 1024 + col);
            v0 = v0 + (f32x4){__builtin_bit_cast(float, w.x << 16), __builtin_bit_cast(float, w.x & 0xffff0000u), __builtin_bit_cast(float, w.y << 16), __builtin_bit_cast(float, w.y & 0xffff0000u)};
            v1 = v1 + (f32x4){__builtin_bit_cast(float, w.z << 16), __builtin_bit_cast(float, w.z & 0xffff0000u), __builtin_bit_cast(float, w.w << 16), __builtin_bit_cast(float, w.w & 0xffff0000u)}; }
        if (OUT32) { float* xp = X + (size_t)row * 1024 + col; *(f32x4*)xp = v0; *(f32x4*)(xp + 4) = v1; }
        else { u32x4 w; w.x = cvt_pk_bf16(v0[0], v0[1]); w.y = cvt_pk_bf16(v0[2], v0[3]); w.z = cvt_pk_bf16(v1[0], v1[1]); w.w = cvt_pk_bf16(v1[2], v1[3]); *(u32x4*)(XB + (size_t)row * 1024 + col) = w; }
        return ((v0[0] * v0[0] + v0[1] * v0[1]) + (v0[2] * v0[2] + v0[3] * v0[3])) + ((v1[0] * v1[0] + v1[1] * v1[1]) + (v1[2] * v1[2] + v1[3] * v1[3]));
    }
};
template <int RES, bool OUT32> struct EpiResid {
    static constexpr bool PERM = true, AFTER_DRAIN = false;
    ResidOp<RES, OUT32> op; float* SS;
    __device__ __forceinline__ void operator()(const f32x4 (&acc)[2][2][4][2], const Unit& u, int wr, int wc, int fr, int fq) const {
        const int row0 = u.pm * BM + wr * 64 + fr, col0 = u.pn * BM + wc * 32 + 8 * fq;
#pragma unroll
        for (int ai = 0; ai < 2; ++ai)
#pragma unroll
            for (int m = 0; m < 4; ++m) { const int row = row0 + ai * HALF + m * 16; float ssq = 0.f;
#pragma unroll
                for (int bj = 0; bj < 2; ++bj) ssq += op(row, col0 + bj * HALF, acc[ai][bj][m][0], acc[ai][bj][m][1]);
                ssq += __shfl_xor(ssq, 16); ssq += __shfl_xor(ssq, 32);
                if (fq == 0) SS[(size_t)row * 16 + u.pn * 4 + wc] = ssq; }
    }
};
struct EpiSwiGLU {
    static constexpr bool PERM = true, AFTER_DRAIN = false;
    bf16_t* O; int ldc; const float* SS;
    __device__ __forceinline__ void operator()(const f32x4 (&acc)[2][2][4][2], const Unit& u, int wr, int wc, int fr, int fq) const {
        const int row0 = u.pm * BM + wr * 64 + fr, col0 = u.pn * HALF + wc * 32 + 8 * fq;
#pragma unroll
        for (int ai = 0; ai < 2; ++ai)
#pragma unroll
            for (int m = 0; m < 4; ++m) { const int row = row0 + ai * HALF + m * 16; const float rs = row_rstd(SS, row);
                float o[8];
#pragma unroll
                for (int n = 0; n < 2; ++n)
#pragma unroll
                    for (int e = 0; e < 4; ++e) { const float g = acc[ai][0][m][n][e] * rs, up = acc[ai][1][m][n][e] * rs; o[4 * n + e] = g * __builtin_amdgcn_rcpf(1.0f + __expf(-g)) * up; }
                u32x4 w; w.x = cvt_pk_bf16(o[0], o[1]); w.y = cvt_pk_bf16(o[2], o[3]); w.z = cvt_pk_bf16(o[4], o[5]); w.w = cvt_pk_bf16(o[6], o[7]);
                *(u32x4*)(O + (size_t)row * ldc + col0) = w; }
    }
};
template <class Epi, class Sched, bool ALIGN_EPI = false, bool SP2 = false>
__device__ __forceinline__ void gemm_phase(PG8_LAS unsigned char* lds, const Gemm g, const Sched& S, const Epi& E) {
    const int tid = threadIdx.x, wid = __builtin_amdgcn_readfirstlane(tid >> 6), lane = tid & 63, wr = wid >> 2, wc = wid & 3, fr = lane & 15, fq = lane >> 4;
    const int K = g.K, nt = K / BK;
    unsigned voffA[2], voffB[2];
#pragma unroll
    for (int i = 0; i < 2; ++i) { int R, C; stage_rc(tid * 16 + i * 8192, R, C); const int Rb = Epi::PERM ? ((R & ~31) + perm32(R & 31)) : R;
        voffA[i] = (unsigned)(R * K + C) * 2u; voffB[i] = (unsigned)(Rb * K + C) * 2u; }
    const size_t kstep = (size_t)(BK * 2);
    const size_t hstep = (size_t)HALF * K * 2;
    const size_t tstep = 2 * hstep;
    const unsigned ldsw = (unsigned)wid * 1024u;
    const int aoff = lds_byte(wr * 64 + fr, fq * 8), boff = lds_byte(wc * 32 + fr, fq * 8);
#define PG8_SA(b, h) (((b) * 2 + (h)) * HTB)
#define PG8_SB(b, h) ((4 + (b) * 2 + (h)) * HTB)
#define PG8_STAGE(bufoff, gbase, voff) do { _Pragma("unroll") for (int _i = 0; _i < 2; ++_i) \
        __builtin_amdgcn_global_load_lds((const unsigned*)((const char*)(gbase) + (voff)[_i]), (PG8_LAS unsigned*)(lds + (bufoff) + ldsw + _i * 8192), 16, 0, 0); } while (0)
#define PG8_LDA(dst, b, h) do { _Pragma("unroll") for (int m = 0; m < 4; ++m) _Pragma("unroll") for (int k = 0; k < 2; ++k) dst[m][k] = *(const PG8_LAS bf16x8*)(lds + PG8_SA(b, h) + aoff + m * 2048 + k * 1024); } while (0)
#define PG8_LDB(dst, b, h) do { _Pragma("unroll") for (int n = 0; n < 2; ++n) _Pragma("unroll") for (int k = 0; k < 2; ++k) dst[n][k] = *(const PG8_LAS bf16x8*)(lds + PG8_SB(b, h) + boff + n * 2048 + k * 1024); } while (0)
#define PG8_MMA(ai, bj, At, Bt) do { __builtin_amdgcn_s_setprio(1); _Pragma("unroll") for (int m = 0; m < 4; ++m) _Pragma("unroll") for (int n = 0; n < 2; ++n) _Pragma("unroll") for (int k = 0; k < 2; ++k) \
        acc[ai][bj][m][n] = __builtin_amdgcn_mfma_f32_16x16x32_bf16(Bt[n][k], At[m][k], acc[ai][bj][m][n], 0, 0, 0); __builtin_amdgcn_s_setprio(0); } while (0)
#define PG8_WAIT_V(n) asm volatile("s_waitcnt vmcnt(" #n ")" ::: "memory")
#define PG8_WAIT_L(n) asm volatile("s_waitcnt lgkmcnt(" #n ")" ::: "memory")
#define PG8_BAR __builtin_amdgcn_s_barrier()
#define PG8_SCHED __builtin_amdgcn_sched_barrier(0)
    Unit cur, nxt; int ui = 0;
    if (!S.next(0, cur)) return;
    f32x4 acc[2][2][4][2];
#pragma unroll
    for (int a = 0; a < 2; ++a)
#pragma unroll
        for (int b = 0; b < 2; ++b)
#pragma unroll
            for (int m = 0; m < 4; ++m)
#pragma unroll
                for (int n = 0; n < 2; ++n) acc[a][b][m][n] = (f32x4){0.f, 0.f, 0.f, 0.f};
    bf16x8 At[4][2], B0[2][2], B1[2][2];
    const char* cA = (const char*)g.A + (size_t)cur.pm * tstep; const char* cB = (const char*)g.Bt + (size_t)cur.pn * tstep;
    S.a_ready(cur);
    if constexpr (SP2) {
        PG8_STAGE(PG8_SB(0, 0), cB, voffB); PG8_STAGE(PG8_SB(0, 1), cB + hstep, voffB); PG8_STAGE(PG8_SA(0, 0), cA, voffA); PG8_STAGE(PG8_SA(0, 1), cA + hstep, voffA);
        if (wr == 1) PG8_BAR;
        PG8_WAIT_V(2); PG8_BAR;
        PG8_STAGE(PG8_SB(1, 0), cB + kstep, voffB); PG8_STAGE(PG8_SA(1, 0), cA + kstep, voffA); PG8_STAGE(PG8_SB(1, 1), cB + hstep + kstep, voffB);
        PG8_WAIT_V(6); PG8_BAR;
    } else {
        PG8_STAGE(PG8_SB(0, 0), cB, voffB); PG8_STAGE(PG8_SA(0, 0), cA, voffA); PG8_STAGE(PG8_SB(0, 1), cB + hstep, voffB); PG8_STAGE(PG8_SA(0, 1), cA + hstep, voffA);
        if (wr == 1) PG8_BAR;
        PG8_WAIT_V(4); PG8_BAR;
        PG8_STAGE(PG8_SB(1, 0), cB + kstep, voffB); PG8_STAGE(PG8_SA(1, 0), cA + kstep, voffA); PG8_STAGE(PG8_SB(1, 1), cB + hstep + kstep, voffB);
        PG8_WAIT_V(6); PG8_BAR;
    }
    for (;;) {
        const bool has_next = S.next(ui + 1, nxt);
        const char* nA = has_next ? (const char*)g.A + (size_t)nxt.pm * tstep : cA; const char* nB = has_next ? (const char*)g.Bt + (size_t)nxt.pn * tstep : cB;
        for (int t = 0; t < nt; t += 2) {
            const bool last = (t == nt - 2);
            const char* a1 = cA + (size_t)(t + 1) * kstep;
            const char* a2 = last ? nA : cA + (size_t)(t + 2) * kstep; const char* b2 = last ? nB : cB + (size_t)(t + 2) * kstep;
            const char* a3 = a2 + kstep; const char* b3 = b2 + kstep;
            if (last && has_next) S.a_ready(nxt);
            if constexpr (SP2) {
            PG8_LDB(B0, 0, 0); PG8_LDB(B1, 0, 1); PG8_SCHED; PG8_LDA(At, 0, 0); PG8_STAGE(PG8_SA(1, 1), a1 + hstep, voffA);
            PG8_WAIT_V(8); PG8_WAIT_L(0); PG8_BAR; PG8_MMA(0, 0, At, B0); PG8_MMA(0, 1, At, B1); PG8_BAR; PG8_SCHED;
            PG8_LDA(At, 0, 1); PG8_STAGE(PG8_SB(0, 0), b2, voffB); PG8_STAGE(PG8_SB(0, 1), b2 + hstep, voffB); PG8_STAGE(PG8_SA(0, 0), a2, voffA);
            PG8_WAIT_V(8); PG8_WAIT_L(0); PG8_BAR; PG8_MMA(1, 0, At, B0); PG8_MMA(1, 1, At, B1); PG8_BAR; PG8_SCHED;
            PG8_LDB(B0, 1, 0); PG8_LDB(B1, 1, 1); PG8_SCHED; PG8_LDA(At, 1, 0); PG8_STAGE(PG8_SA(0, 1), a2 + hstep, voffA);
            PG8_WAIT_V(8); PG8_WAIT_L(0); PG8_BAR; PG8_MMA(0, 0, At, B0); PG8_MMA(0, 1, At, B1); PG8_BAR; PG8_SCHED;
            PG8_LDA(At, 1, 1); PG8_STAGE(PG8_SB(1, 0), b3, voffB); PG8_STAGE(PG8_SB(1, 1), b3 + hstep, voffB); PG8_STAGE(PG8_SA(1, 0), a3, voffA);
            PG8_WAIT_V(8); PG8_WAIT_L(0); PG8_BAR; PG8_MMA(1, 0, At, B0); PG8_MMA(1, 1, At, B1); PG8_BAR; PG8_SCHED;
            } else {
            PG8_LDB(B0, 0, 0); PG8_SCHED; PG8_LDA(At, 0, 0); PG8_STAGE(PG8_SA(1, 1), a1 + hstep, voffA);
            PG8_WAIT_L(8); PG8_BAR; PG8_WAIT_L(0); PG8_MMA(0, 0, At, B0); PG8_BAR; PG8_SCHED;
            PG8_LDB(B1, 0, 1); PG8_STAGE(PG8_SB(0, 0), b2, voffB);
            PG8_BAR; PG8_WAIT_L(0); PG8_MMA(0, 1, At, B1); PG8_BAR;
            PG8_LDA(At, 0, 1); PG8_STAGE(PG8_SA(0, 0), a2, voffA);
            PG8_BAR; PG8_WAIT_L(0); PG8_MMA(1, 0, At, B0); PG8_BAR; PG8_SCHED;
            PG8_STAGE(PG8_SB(0, 1), b2 + hstep, voffB);
            PG8_WAIT_V(6); PG8_BAR; PG8_MMA(1, 1, At, B1); PG8_BAR;
            PG8_LDB(B0, 1, 0); PG8_SCHED; PG8_LDA(At, 1, 0); PG8_STAGE(PG8_SA(0, 1), a2 + hstep, voffA);
            PG8_WAIT_L(8); PG8_BAR; PG8_WAIT_L(0); PG8_MMA(0, 0, At, B0); PG8_BAR; PG8_SCHED;
            PG8_LDB(B1, 1, 1); PG8_STAGE(PG8_SB(1, 0), b3, voffB);
            PG8_BAR; PG8_WAIT_L(0); PG8_MMA(0, 1, At, B1); PG8_BAR;
            PG8_LDA(At, 1, 1); PG8_STAGE(PG8_SA(1, 0), a3, voffA);
            PG8_BAR; PG8_WAIT_L(0); PG8_MMA(1, 0, At, B0); PG8_BAR; PG8_SCHED;
            PG8_STAGE(PG8_SB(1, 1), b3 + hstep, voffB);
            PG8_WAIT_V(6); PG8_BAR; PG8_MMA(1, 1, At, B1); PG8_BAR;
            }
        }
        if constexpr (ALIGN_EPI) { if (wr == 0) PG8_BAR; }
        if constexpr (!Epi::AFTER_DRAIN) { E(acc, cur, wr, wc, fr, fq); S.done(cur); }
        if (!has_next) break;
#pragma unroll
        for (int a = 0; a < 2; ++a)
#pragma unroll
            for (int b = 0; b < 2; ++b)
#pragma unroll
                for (int m = 0; m < 4; ++m)
#pragma unroll
                    for (int n = 0; n < 2; ++n) acc[a][b][m][n] = (f32x4){0.f, 0.f, 0.f, 0.f};
        cur = nxt; cA = nA; cB = nB; ++ui;
        if constexpr (ALIGN_EPI) { if (wr == 1) PG8_BAR; }
    }
    PG8_WAIT_V(0);
    if constexpr (!ALIGN_EPI) { if (wr == 0) PG8_BAR; }
    PG8_BAR;
    if constexpr (Epi::AFTER_DRAIN) { E.fused(acc, cur, wr, wc, fr, fq, lds, wid, lane); S.done(cur); }
#undef PG8_SA
#undef PG8_SB
#undef PG8_STAGE
#undef PG8_LDA
#undef PG8_LDB
#undef PG8_MMA
#undef PG8_WAIT_V
#undef PG8_WAIT_L
#undef PG8_BAR
#undef PG8_SCHED
}
}
#define GAS __attribute__((address_space(1)))
#define LAS __attribute__((address_space(3)))
typedef unsigned short bf16;
typedef unsigned v4u __attribute__((ext_vector_type(4)));
typedef float f32x4 __attribute__((ext_vector_type(4)));
typedef short bf16x8 __attribute__((ext_vector_type(8)));
typedef GAS unsigned gu32;
typedef GAS unsigned long long gu64;
#define RLX_AGENT __ATOMIC_RELAXED, __HIP_MEMORY_SCOPE_AGENT
#define LDS_WAIT() asm volatile("s_waitcnt lgkmcnt(0)" ::: "memory")
#define VM_WAIT() asm volatile("s_waitcnt vmcnt(0)" ::: "memory")
__device__ __forceinline__ unsigned long long rt() { return __builtin_amdgcn_s_memrealtime(); }
typedef float f32x2_cv __attribute__((ext_vector_type(2))); typedef __bf16 bf16x2_cv __attribute__((ext_vector_type(2)));
__device__ __forceinline__ unsigned pk2(float lo, float hi) { f32x2_cv v = {lo, hi}; bf16x2_cv b = __builtin_convertvector(v, bf16x2_cv); return __builtin_bit_cast(unsigned, b); }
__device__ __forceinline__ unsigned f2bf(float f) { return pk2(f, f) & 0xffffu; }
#define XB_TMO      128
#define XB_XCNT(j)  (256  + 64 * (j))
#define XB_XSUB(j)  (1280 + 64 * (j))
#define XB_XGEN(j)  (2304 + 64 * (j))
#define XB_TOP      3328
#define XB_TOPGEN   3392
#define XCD_BAR_WORDS 3456
#define XB_SPIN_CAP (1u << 18)

__device__ __forceinline__ unsigned xb_ld(unsigned* p)              { return __hip_atomic_load(p, __ATOMIC_RELAXED, __HIP_MEMORY_SCOPE_AGENT); }
__device__ __forceinline__ unsigned xb_add(unsigned* p, unsigned v) { return __hip_atomic_fetch_add(p, v, __ATOMIC_RELAXED, __HIP_MEMORY_SCOPE_AGENT); }
__device__ __forceinline__ unsigned xb_xcc_id() { return (unsigned)__builtin_amdgcn_s_getreg((3 << 11) | 20) & 0xFu; }
#define XB_SPIN(cond, bar) do { unsigned _sp = 0; while (cond) { __builtin_amdgcn_s_sleep(1); \
    if ((++_sp & 255u) == 0u) { if (xb_ld(&(bar)[XB_TMO])) break; if (_sp > XB_SPIN_CAP) { atomicAdd(&(bar)[XB_TMO], 1u); break; } } } } while (0)

struct XcdBarrier {
    unsigned* bar; unsigned x;
    volatile LAS unsigned* st;
};

__device__ __forceinline__ XcdBarrier xcd_barrier_post(unsigned* bar, volatile LAS unsigned* st) {
    XcdBarrier b; b.bar = bar; b.x = xb_xcc_id(); b.st = st;
    if (threadIdx.x == 0) (void)xb_add(&bar[XB_XCNT(b.x)], 1u);
    return b;
}
__device__ __forceinline__ void xcd_barrier_complete(unsigned* bar, unsigned x, unsigned& nloc, unsigned& nx) {
    const unsigned G = gridDim.x * gridDim.y * gridDim.z;
    unsigned sum, cnt, mine, sp = 0u;
    for (;;) {
        sum = 0u; cnt = 0u; mine = 0u;
#pragma unroll
        for (unsigned j = 0; j < 16; ++j) { const unsigned c = xb_ld(&bar[XB_XCNT(j)]); sum += c; cnt += (c > 0u) ? 1u : 0u; mine = (j == x) ? c : mine; }
        if (sum == G) break;
        __builtin_amdgcn_s_sleep(1);
        if ((++sp & 255u) == 0u) { if (xb_ld(&bar[XB_TMO])) break; if (sp > XB_SPIN_CAP) { atomicAdd(&bar[XB_TMO], 1u); break; } }
    }
    nloc = mine > 0u ? mine : 1u; nx = cnt > 0u ? cnt : 1u;
}

__device__ __forceinline__ void xcd_barrier(const XcdBarrier& b) {
    asm volatile("s_waitcnt vmcnt(0)" ::: "memory");
    __syncthreads();
    if (threadIdx.x == 0) {
        unsigned* bar = b.bar;
        __builtin_amdgcn_s_waitcnt(0);
        unsigned nloc = b.st[0], nx = b.st[1];
        if (nloc == 0u) { xcd_barrier_complete(bar, b.x, nloc, nx); b.st[0] = nloc; b.st[1] = nx; }
        const unsigned old = xb_add(&bar[XB_XSUB(b.x)], 1u);
        const unsigned gen = old / nloc;
        if (old + 1u == (gen + 1u) * nloc) {
            __builtin_amdgcn_fence(__ATOMIC_RELEASE, "agent");
            asm volatile("s_waitcnt vmcnt(0)" ::: "memory");
            const unsigned og = xb_add(&bar[XB_TOP], 1u);
            const unsigned tg = og / nx;
            if (og + 1u == (tg + 1u) * nx) xb_add(&bar[XB_TOPGEN], 1u);
            else XB_SPIN(xb_ld(&bar[XB_TOPGEN]) == tg, bar);
            __builtin_amdgcn_fence(__ATOMIC_ACQUIRE, "agent");
            xb_add(&bar[XB_XGEN(b.x)], 1u);
            asm volatile("s_waitcnt vmcnt(0)" ::: "memory");
        } else {
            XB_SPIN(xb_ld(&bar[XB_XGEN(b.x)]) == gen, bar);
            __builtin_amdgcn_fence(__ATOMIC_ACQUIRE, "agent");
            asm volatile("s_waitcnt vmcnt(0)" ::: "memory");
        }
    }
    __syncthreads();
}
constexpr size_t MiB = 1u << 20;
constexpr size_t WS_CTL = 0, CTL_ZERO_BYTES = 64 * 1024;
constexpr size_t WS_ROPE = 1 * MiB, WS_SHB = 1 * MiB + 512 * 1024, WS_SS = 2 * MiB;
constexpr size_t WS_W_INAB = 4 * MiB, WS_W_OUTAB = WS_W_INAB + (size_t)N_AB * 1024 * 2, WS_W_INCD = WS_W_OUTAB + 2 * MiB, WS_W_OUTCD = WS_W_INCD + (size_t)N_CD * 1024 * 2,
                 WS_W_GU = WS_W_OUTCD + 2 * MiB, WS_W_DN = WS_W_GU + 2 * (size_t)N_GU * 1024 * 2, WS_W_END = WS_W_DN + 2 * (size_t)D_FF * 1024 * 2;
constexpr size_t WS_XB = 52 * MiB, WS_MIX = 86 * MiB, WS_PROJ = 120 * MiB, WS_PROJ_END = WS_PROJ + (size_t)T_ALL * N_AB * 2;
constexpr size_t WS_COMP = WS_PROJ_END, WS_ENT = WS_COMP + 3 * MiB, WS_RK = WS_ENT + 2 * MiB, WS_END = WS_RK + 1 * MiB;
static_assert(WS_W_END <= WS_XB && WS_XB + (size_t)T_ALL * 1024 * 2 <= WS_MIX && WS_MIX + (size_t)T_ALL * 1024 * 2 <= WS_PROJ && WS_END <= 256 * MiB, "d_ws map");
static_assert((size_t)NCH * 8 * 4096 * 2 + (size_t)64 * 4 * 16384 * 4 <= (size_t)T_ALL * 1024 * 2, "rwkv states + retention group states fit the XB region");
static_assert(128 * 24576 <= 3 * MiB && 128 * 16384 <= 2 * MiB && NCH * 8 * 64 * 4 <= 1 * MiB, "scan scratch");
constexpr size_t O_Y = 0, O_RET_P = (size_t)T_ALL * 1024, O_WKV_P = O_RET_P + 65536, O_SHIFT_P = O_WKV_P + 32768, O_CONV_P = O_SHIFT_P + 1792, O_K_P = O_CONV_P + 15360, O_V_P = O_K_P + 16384,
                 O_RET_S = O_V_P + 16384, O_WKV_S = O_RET_S + 16 * 65536, O_SHIFT_S = O_WKV_S + 16 * 32768, O_CONV_S = O_SHIFT_S + 16 * 1792, O_K_S = O_CONV_S + 16 * 15360, O_V_S = O_K_S + 16 * 16384,
                 O_END = O_V_S + 16 * 16384;
static_assert(O_END == 20345600, "output size");
constexpr int RING_BYTES = 131072, MISC_OFF = RING_BYTES + 320, LDS_BYTES = 147456, NWAVES = 8;

#define LBAR() do { asm volatile("s_waitcnt lgkmcnt(0)" ::: "memory"); __builtin_amdgcn_s_barrier(); asm volatile("" ::: "memory"); } while (0)
#define DI __device__ __forceinline__
typedef LAS unsigned char* lptr;
typedef unsigned u32x2 __attribute__((ext_vector_type(2)));
typedef float f32x16 __attribute__((ext_vector_type(16)));
typedef float f32x2 __attribute__((ext_vector_type(2)));
DI float bf2f(unsigned h) { return __builtin_bit_cast(float, h << 16); }
DI void unpack8(const v4u w, float* o) {
    o[0] = bf2f(w.x & 0xffffu); o[1] = bf2f(w.x >> 16); o[2] = bf2f(w.y & 0xffffu); o[3] = bf2f(w.y >> 16);
    o[4] = bf2f(w.z & 0xffffu); o[5] = bf2f(w.z >> 16); o[6] = bf2f(w.w & 0xffffu); o[7] = bf2f(w.w >> 16);
}
DI v4u pack8(const float* o) { v4u w; w.x = pk2(o[0], o[1]); w.y = pk2(o[2], o[3]); w.z = pk2(o[4], o[5]); w.w = pk2(o[6], o[7]); return w; }
DI void ld8f(const float* p, float* o) { const f32x4 a = *(const f32x4*)p, b = *(const f32x4*)(p + 4); o[0] = a[0]; o[1] = a[1]; o[2] = a[2]; o[3] = a[3]; o[4] = b[0]; o[5] = b[1]; o[6] = b[2]; o[7] = b[3]; }
DI void st8f(float* p, const float* o) { *(f32x4*)p = (f32x4){o[0], o[1], o[2], o[3]}; *(f32x4*)(p + 4) = (f32x4){o[4], o[5], o[6], o[7]}; }
DI void ld8bf(const bf16* p, float* o) { unpack8(*(const v4u*)p, o); }
DI float rcpf_(float x) { return __builtin_amdgcn_rcpf(x); }
DI float rsqf_(float x) { return __builtin_amdgcn_rsqf(x); }
DI float sigmoidf_(float x) { return rcpf_(1.0f + __expf(-x)); }

template <int K> DI void mma16(f32x4& acc, lptr A, int lda, lptr Bt, int ldb, int fr, int fq) {
#pragma unroll
    for (int k0 = 0; k0 < K; k0 += 32) {
        const bf16x8 a = *(const LAS bf16x8*)(A + fr * lda + (k0 + 8 * fq) * 2);
        const bf16x8 b = *(const LAS bf16x8*)(Bt + fr * ldb + (k0 + 8 * fq) * 2);
        acc = __builtin_amdgcn_mfma_f32_16x16x32_bf16(a, b, acc, 0, 0, 0);
    }
}
DI void st_rm(lptr M, int ld, int r0, int c0, const f32x4 v, int fr, int fq) {
#pragma unroll
    for (int i = 0; i < 4; ++i) *(LAS bf16*)(M + (r0 + 4 * fq + i) * ld + (c0 + fr) * 2) = (bf16)f2bf(v[i]);
}
DI void st_tr(lptr MT, int ld, int r0, int c0, const f32x4 v, int fr, int fq) {
    u32x2 w; w.x = pk2(v[0], v[1]); w.y = pk2(v[2], v[3]);
    *(LAS u32x2*)(MT + (c0 + fr) * ld + (r0 + 4 * fq) * 2) = w;
}
DI u32x2 pack4(const f32x4 v) { u32x2 w; w.x = pk2(v[0], v[1]); w.y = pk2(v[2], v[3]); return w; }
DI f32x4 unpack4(const u32x2 w) { return (f32x4){bf2f(w.x & 0xffffu), bf2f(w.x >> 16), bf2f(w.y & 0xffffu), bf2f(w.y >> 16)}; }

typedef short v4i16_t __attribute__((ext_vector_type(4)));
DI u32x2 trd(lptr p) { return __builtin_bit_cast(u32x2, __builtin_amdgcn_ds_read_tr16_b64_v4i16((LAS v4i16_t*)p)); }
template <int MODE> DI bf16x8 frag16(lptr img, int ld, int r0, int k0, int fr, int fq) {
    if (MODE == 0) return *(const LAS bf16x8*)(img + (r0 + fr) * ld + (k0 + 8 * fq) * 2);
    const lptr p = img + (k0 + 8 * fq + (fr >> 2)) * ld + (r0 + 4 * (fr & 3)) * 2;
    const u32x2 lo = trd(p), hi = trd(p + 4 * ld); v4u w; w.x = lo.x; w.y = lo.y; w.z = hi.x; w.w = hi.y; return __builtin_bit_cast(bf16x8, w);
}
template <int K, int MA, int MB> DI void mmaX(f32x4& acc, lptr A, int lda, int ar0, lptr B, int ldb, int br0, int fr, int fq) {
#pragma unroll
    for (int k0 = 0; k0 < K; k0 += 32) acc = __builtin_amdgcn_mfma_f32_16x16x32_bf16(frag16<MA>(A, lda, ar0, k0, fr, fq), frag16<MB>(B, ldb, br0, k0, fr, fq), acc, 0, 0, 0);
}
DI void g2l_64x64(lptr dst, const bf16* src, int tid) { const int r = tid >> 3, s = tid & 7; *(LAS v4u*)(dst + r * 144 + s * 16) = *(const v4u*)(src + r * 64 + s * 8); }
DI void l2g_64x64(bf16* dst, lptr src, int tid) { const int r = tid >> 3, s = tid & 7; *(v4u*)(dst + r * 64 + s * 8) = *(const LAS v4u*)(src + r * 144 + s * 16); }

struct Ctx {
    float* out; unsigned char* ws;
    int tid, lane, wave, vcu, G;
    lptr lds;
    unsigned long long* pr;
};
#define CAS __attribute__((address_space(4)))
DI const float* in_ptr(const Ctx&, int i) { const CAS char* p = (const CAS char*)__builtin_amdgcn_kernarg_segment_ptr(); asm volatile("" : "+s"(p)); return *(const float* const CAS*)(p + 8 * i); }
#ifndef PROBE_SUB
#define PROBE_SUB -1
#endif
#ifndef PROBE_SUB_HI
#define PROBE_SUB_HI PROBE_SUB
#endif
#define STAMP_BEGIN() unsigned long long st_last_ = (PROBE_SUB >= 0) ? __builtin_amdgcn_s_memrealtime() : 0ull
#define STAMP(k) do { if (PROBE_SUB >= 0) { const unsigned long long n_ = __builtin_amdgcn_s_memrealtime(); if ((k) >= PROBE_SUB && (k) <= PROBE_SUB_HI) *F.pr += n_ - st_last_; st_last_ = n_; } } while (0)

template <class RF> DI void gemm_small64(const Ctx& F, const bf16* A, const bf16* Bt, int K, int tile, const RF& rf, float* SS) {
    const int tid = F.tid, lane = F.lane, w = F.wave, fr = lane & 15, fq = lane >> 4; const lptr L = F.lds;
    const int row0 = TP + 64 * (tile >> 4), c0 = 64 * (tile & 15);
    const int kw = K >> 3, nst = kw >> 5;
    const bf16* ap = A + (size_t)(row0 + fr) * K + w * kw + 8 * fq; const bf16* bp = Bt + (size_t)(c0 + fr) * K + w * kw + 8 * fq;
    f32x4 acc[4][4];
#pragma unroll
    for (int m = 0; m < 4; ++m)
#pragma unroll
        for (int n = 0; n < 4; ++n) acc[m][n] = (f32x4){0.f, 0.f, 0.f, 0.f};
    bf16x8 a[4], b[4], an[4], bn[4];
#pragma unroll
    for (int i = 0; i < 4; ++i) { a[i] = *(const bf16x8*)(ap + (size_t)16 * i * K); b[i] = *(const bf16x8*)(bp + (size_t)16 * i * K); }
    for (int st = 0; st < nst; ++st) {
        const int kn = (st + 1 < nst) ? 32 * (st + 1) : 32 * st;
#pragma unroll
        for (int i = 0; i < 4; ++i) { an[i] = *(const bf16x8*)(ap + (size_t)16 * i * K + kn); bn[i] = *(const bf16x8*)(bp + (size_t)16 * i * K + kn); }
#pragma unroll
        for (int m = 0; m < 4; ++m)
#pragma unroll
            for (int n = 0; n < 4; ++n) acc[m][n] = __builtin_amdgcn_mfma_f32_16x16x32_bf16(b[n], a[m], acc[m][n], 0, 0, 0);
#pragma unroll
        for (int i = 0; i < 4; ++i) { a[i] = an[i]; b[i] = bn[i]; }
    }
#pragma unroll
    for (int m = 0; m < 4; ++m)
#pragma unroll
        for (int n = 0; n < 4; ++n) { const int row = 16 * m + fr, g4 = 4 * n + fq; *(LAS f32x4*)(L + w * 16384 + row * 256 + ((g4 ^ (row & 15)) << 4)) = acc[m][n]; }
    LBAR();
    {   const int row = tid >> 3, g = tid & 7; f32x4 v0 = (f32x4){0.f, 0.f, 0.f, 0.f}, v1 = v0;
#pragma unroll
        for (int ww = 0; ww < 8; ++ww) { v0 = v0 + *(const LAS f32x4*)(L + ww * 16384 + row * 256 + (((2 * g) ^ (row & 15)) << 4)); v1 = v1 + *(const LAS f32x4*)(L + ww * 16384 + row * 256 + (((2 * g + 1) ^ (row & 15)) << 4)); }
        float ssq = rf(row0 + row, c0 + 8 * g, v0, v1);
        ssq += __shfl_xor(ssq, 1); ssq += __shfl_xor(ssq, 2); ssq += __shfl_xor(ssq, 4);
        if (g == 0) SS[(size_t)(row0 + row) * 16 + (tile & 15)] = ssq; }
    LBAR();
}
constexpr int RW_LD = 144, RW_SLOT = 9216;
constexpr int RW_LDF = 272;
DI lptr rw_slot(lptr lds, int i) { return lds + i * RW_SLOT; }

DI void rw_load_p(const Ctx& F, int c, int t, int col, float* p, float* pp) {
    ld8bf(((bf16*)(F.ws + WS_PROJ)) + (size_t)(c * 64 + t) * N_AB + RW_OFF + col, p);
    if (t == 0 && c >= 256) ld8f(in_ptr(F, 4) + (size_t)(c - 256) * RWKV_PROJ + col, pp);
    else if (t == 0 && c == 0) {
#pragma unroll
        for (int e = 0; e < 8; ++e) pp[e] = 0.f; }
    else ld8bf(((bf16*)(F.ws + WS_PROJ)) + (size_t)(c * 64 + t - 1) * N_AB + RW_OFF + col, pp);
}
DI void rw_shift(const Ctx& F, int c, int t, int col, float* xs) {
    float p[8], pp[8], mu[8]; rw_load_p(F, c, t, col, p, pp); ld8f(in_ptr(F, 14) + col, mu);
#pragma unroll
    for (int e = 0; e < 8; ++e) xs[e] = p[e] + (pp[e] - p[e]) * mu[e];
}

constexpr int RW_PAR_OFF = RING_BYTES + 1024;
enum { PAR_MU_WL = 0, PAR_MU_AL = 64, PAR_MU_GL = 128, PAR_MU_R = 256, PAR_MU_K = 320, PAR_MU_V = 384, PAR_KK = 448, PAR_KA = 512, PAR_RK = 576, PAR_W0 = 640, PAR_A0 = 704, PAR_N = 768 };
DI void rw_load_params(const Ctx& F, int h) {
    LAS float* P = (LAS float*)(F.lds + RW_PAR_OFF);
    for (int i = F.tid; i < PAR_N; i += 512) { float v;
        if (i < 256) v = in_ptr(F, 14)[1536 + i];
        else { const int k = (i - 256) >> 6, j = h * 64 + (i & 63);
            v = k == 0 ? in_ptr(F, 14)[j] : k == 1 ? in_ptr(F, 14)[512 + j] : k == 2 ? in_ptr(F, 14)[1024 + j] : k == 3 ? in_ptr(F, 20)[j] : k == 4 ? in_ptr(F, 21)[j] : k == 5 ? in_ptr(F, 22)[j] : k == 6 ? in_ptr(F, 15)[j] : in_ptr(F, 17)[j]; }
        P[i] = v; }
    LBAR();
}
struct RwPre { v4u pa[4], qa[4]; f32x4 w2[2]; };
DI v4u rw_prev16(const Ctx& F, int c, int t, int col) {
    const bf16* shb = (const bf16*)(F.ws + WS_SHB) + (size_t)(c >= 256 ? c - 256 : 16) * RWKV_PROJ;
    const bf16* prj = ((bf16*)(F.ws + WS_PROJ)) + (size_t)(c * 64 + t - 1) * N_AB + RW_OFF;
    const bf16* src = (t == 0 && (c >= 256 || c == 0)) ? shb : prj;
    return *(const v4u*)(src + col);
}
DI void rw_prefetch(const Ctx& F, int c, int h, RwPre& R) {
    const int t = F.tid >> 3, s8 = F.tid & 7; const bf16* row = ((bf16*)(F.ws + WS_PROJ)) + (size_t)(c * 64 + t) * N_AB + RW_OFF;
#pragma unroll
    for (int q = 0; q < 4; ++q) { const int col = 1536 + 64 * q + 8 * s8; R.pa[q] = *(const v4u*)(row + col); R.qa[q] = rw_prev16(F, c, t, col); }
#pragma unroll
    for (int q = 0; q < 2; ++q) { R.w2[q] = *(const f32x4*)(in_ptr(F, 16) + (size_t)t * 512 + h * 64 + 8 * s8 + 4 * q);
 }
}
DI void rw_mix8(const v4u p, const v4u pp, const LAS float* mu, float* xs) {
    float a[8], b[8]; unpack8(p, a); unpack8(pp, b);
#pragma unroll
    for (int e = 0; e < 8; ++e) xs[e] = a[e] + (b[e] - a[e]) * mu[e];
}
DI void rwkv_p1_item(const Ctx& F, int c, int h, RwPre& R, bool has_next, int nc, int nh) {
    const int tid = F.tid, lane = F.lane, w = F.wave, fr = lane & 15, fq = lane >> 4, tr = w >> 1, tc0 = 2 * (w & 1);
    const lptr L = F.lds;
    const int t = tid >> 3, s8 = tid & 7;
    const lptr TW = L, AL = L + 9216, SG = L + 18432, W2 = L + 35840, A2 = L + 45056, G2 = L + 54272;
    const lptr LG = L + 8 * RW_SLOT, A32 = LG + 17408;
    LAS float* GAMC = (LAS float*)(L + 14 * RW_SLOT);
    STAMP_BEGIN();
    v4u pc[3], qc[3];
    f32x4 g2r[4], a2r[2];
#pragma unroll
    for (int q = 0; q < 2; ++q) a2r[q] = *(const f32x4*)(in_ptr(F, 18) + (size_t)t * 512 + h * 64 + 8 * s8 + 4 * q);
#pragma unroll
    for (int q = 0; q < 2; ++q) { g2r[q] = *(const f32x4*)(in_ptr(F, 19) + (size_t)t * 512 + h * 64 + 8 * s8 + 4 * q); g2r[2 + q] = *(const f32x4*)(in_ptr(F, 19) + (size_t)(t + 64) * 512 + h * 64 + 8 * s8 + 4 * q); }
    const LAS float* PAR = (const LAS float*)(L + RW_PAR_OFF);
    {
        float xs[8], o[8];
        rw_mix8(R.pa[0], R.qa[0], PAR + PAR_MU_WL + 8 * s8, xs);
#pragma unroll
        for (int e = 0; e < 8; ++e) o[e] = 1.0f - 2.0f * rcpf_(1.0f + __expf(2.0f * xs[e]));
        *(LAS v4u*)(TW + t * RW_LD + s8 * 16) = pack8(o);
        rw_mix8(R.pa[1], R.qa[1], PAR + PAR_MU_AL + 8 * s8, xs);
        *(LAS v4u*)(AL + t * RW_LD + s8 * 16) = pack8(xs);
#pragma unroll
        for (int q = 0; q < 2; ++q) { rw_mix8(R.pa[2 + q], R.qa[2 + q], PAR + PAR_MU_GL + 64 * q + 8 * s8, xs);
#pragma unroll
            for (int e = 0; e < 8; ++e) o[e] = sigmoidf_(xs[e]);
            *(LAS v4u*)(SG + t * 272 + (64 * q + 8 * s8) * 2) = pack8(o); }
        {   float v8[8];
#pragma unroll
            for (int e = 0; e < 4; ++e) { v8[e] = R.w2[0][e]; v8[4 + e] = R.w2[1][e]; }
            *(LAS v4u*)(W2 + t * RW_LD + s8 * 16) = pack8(v8);
#pragma unroll
            for (int e = 0; e < 4; ++e) { v8[e] = a2r[0][e]; v8[4 + e] = a2r[1][e]; }
            *(LAS v4u*)(A2 + t * RW_LD + s8 * 16) = pack8(v8);
#pragma unroll
            for (int e = 0; e < 4; ++e) { v8[e] = g2r[0][e]; v8[4 + e] = g2r[1][e]; }
            *(LAS v4u*)(G2 + t * RW_LD + s8 * 16) = pack8(v8);
#pragma unroll
            for (int e = 0; e < 4; ++e) { v8[e] = g2r[2][e]; v8[4 + e] = g2r[3][e]; }
            *(LAS v4u*)(G2 + (t + 64) * RW_LD + s8 * 16) = pack8(v8); }
    }
    LBAR(); STAMP(0);
    { const bf16* row = ((bf16*)(F.ws + WS_PROJ)) + (size_t)(c * 64 + t) * N_AB + RW_OFF;
#pragma unroll
        for (int q = 0; q < 3; ++q) { const int col = 512 * q + h * 64 + 8 * s8; pc[q] = *(const v4u*)(row + col); qc[q] = rw_prev16(F, c, t, col); } }
    {
        f32x4 aw[2], aa[2], ag[2];
#pragma unroll
        for (int i = 0; i < 2; ++i) { aw[i] = (f32x4){0.f, 0.f, 0.f, 0.f}; aa[i] = aw[i]; ag[i] = aw[i];
            mmaX<64, 0, 1>(aw[i], TW, RW_LD, 16 * tr, W2, RW_LD, 16 * (tc0 + i), fr, fq);
            mmaX<64, 0, 1>(aa[i], AL, RW_LD, 16 * tr, A2, RW_LD, 16 * (tc0 + i), fr, fq);
            mmaX<128, 0, 1>(ag[i], SG, 272, 16 * tr, G2, RW_LD, 16 * (tc0 + i), fr, fq); }
        LBAR();
#pragma unroll
        for (int i = 0; i < 2; ++i) { const int j = 16 * (tc0 + i) + fr; const float w0 = PAR[PAR_W0 + j], a0 = PAR[PAR_A0 + j];
#pragma unroll
            for (int r = 0; r < 4; ++r) { const int tt = 16 * tr + 4 * fq + r;
                const float z = -(w0 + aw[i][r]); const float sp = fmaxf(z, 0.f) + __logf(1.0f + __expf(-fabsf(z)));
                *(LAS float*)(LG + tt * RW_LDF + j * 4) = -__expf(-sp - 0.5f);
                *(LAS float*)(A32 + tt * RW_LDF + j * 4) = sigmoidf_(a0 + aa[i][r]);
            }
            st_rm(rw_slot(L, 12), RW_LD, 16 * tr, 16 * (tc0 + i), ag[i], fr, fq); }
    }
    LBAR(); STAMP(1);
    {   { const int r = tid >> 3, sg = tid & 7; *(v4u*)(((bf16*)(F.ws + WS_MIX)) + (size_t)(c * 64 + r) * 1024 + 512 + h * 64 + sg * 8) = *(const LAS v4u*)(rw_slot(L, 12) + r * RW_LD + sg * 16); }
        const int j = tid & 63, tb = tid >> 6; LAS float* TOT = (LAS float*)rw_slot(L, 13); float v[8];
#pragma unroll
        for (int i = 0; i < 8; ++i) v[i] = *(LAS float*)(LG + (8 * tb + i) * RW_LDF + j * 4);
#pragma unroll
        for (int i = 1; i < 8; ++i) v[i] += v[i - 1];
        TOT[tb * 64 + j] = v[7];
        LBAR();
        float off = 0.f;
#pragma unroll
        for (int bb = 0; bb < 7; ++bb) off += bb < tb ? TOT[bb * 64 + j] : 0.f;
#pragma unroll
        for (int i = 0; i < 8; ++i) *(LAS float*)(LG + (8 * tb + i) * RW_LDF + j * 4) = v[i] + off;
    }
    LBAR(); STAMP(2);
    const lptr KG = rw_slot(L, 0), RG = rw_slot(L, 1), BI = rw_slot(L, 2), KI = rw_slot(L, 3), VV = rw_slot(L, 4), BT = rw_slot(L, 5), KT = rw_slot(L, 6);
    {
        const int j0 = 8 * s8;
        float kk[8], k2[8], b[8];
        {   float xk[8], a[8]; rw_mix8(pc[1], qc[1], PAR + PAR_MU_K + j0, xk); const LAS float* w8 = PAR + PAR_KK + j0; float ss = 0.f;
#pragma unroll
            for (int e = 0; e < 8; ++e) { kk[e] = xk[e] * w8[e]; ss += kk[e] * kk[e]; }
            ss += __shfl_xor(ss, 1); ss += __shfl_xor(ss, 2); ss += __shfl_xor(ss, 4);
            const float inv = ss > 1e-24f ? rsqf_(ss) : 1e12f;
            const LAS float* w9 = PAR + PAR_KA + j0;
#pragma unroll
            for (int e = 0; e < 8; ++e) { a[e] = *(LAS float*)(A32 + t * RW_LDF + (j0 + e) * 4); kk[e] *= inv; k2[e] = xk[e] * (1.0f + (a[e] - 1.0f) * w9[e]); b[e] = kk[e] * a[e]; } }
        asm volatile("" ::: "memory");
        float lg[8];
#pragma unroll
        for (int e = 0; e < 8; ++e) lg[e] = *(LAS float*)(LG + t * RW_LDF + (j0 + e) * 4);
        {   float xr[8], o[8]; rw_mix8(pc[0], qc[0], PAR + PAR_MU_R + j0, xr); const LAS float* w8 = PAR + PAR_RK + j0; float rks = 0.f;
#pragma unroll
            for (int e = 0; e < 8; ++e) { rks += xr[e] * k2[e] * w8[e]; o[e] = xr[e] * __expf(lg[e]); }
            rks += __shfl_xor(rks, 1); rks += __shfl_xor(rks, 2); rks += __shfl_xor(rks, 4);
            if (s8 == 0) ((float*)(F.ws + WS_RK))[(size_t)(c * 8 + h) * 64 + t] = rks;
            *(LAS v4u*)(RG + t * RW_LD + s8 * 16) = pack8(o); }
        asm volatile("" ::: "memory");
        {   float o[8];
#pragma unroll
            for (int e = 0; e < 8; ++e) { const float lgm = t > 0 ? *(LAS float*)(LG + (t - 1) * RW_LDF + (j0 + e) * 4) : 0.f; o[e] = kk[e] * __expf(lgm); }
            *(LAS v4u*)(KG + t * RW_LD + s8 * 16) = pack8(o); }
        asm volatile("" ::: "memory");
        {   float o1[8], o2[8];
#pragma unroll
            for (int e = 0; e < 8; ++e) { const float ei = __expf(-lg[e]); o1[e] = b[e] * ei; o2[e] = k2[e] * ei; }
            *(LAS v4u*)(BI + t * RW_LD + s8 * 16) = pack8(o1);
            *(LAS v4u*)(KI + t * RW_LD + s8 * 16) = pack8(o2); }
        asm volatile("" ::: "memory");
        {   float o1[8], o2[8];
#pragma unroll
            for (int e = 0; e < 8; ++e) { const float lgc = *(LAS float*)(LG + 63 * RW_LDF + (j0 + e) * 4); const float ec = __expf(lgc - lg[e]);
                if (t == 63) GAMC[j0 + e] = __expf(lgc);
                o1[e] = b[e] * ec; o2[e] = k2[e] * ec; }
            *(LAS v4u*)(BT + t * RW_LD + s8 * 16) = pack8(o1);
            *(LAS v4u*)(KT + t * RW_LD + s8 * 16) = pack8(o2); }
        asm volatile("" ::: "memory");
        {   float xv[8]; rw_mix8(pc[2], qc[2], PAR + PAR_MU_V + j0, xv); *(LAS v4u*)(VV + t * RW_LD + s8 * 16) = pack8(xv); }
    }
    if (has_next) rw_prefetch(F, nc, nh, R);
    LBAR(); STAMP(3);
    const lptr BMT = rw_slot(L, 7), PBT = rw_slot(L, 8), PKT = rw_slot(L, 9), XT0 = rw_slot(L, 10), XT1 = rw_slot(L, 2), PT0 = rw_slot(L, 11), PT1 = rw_slot(L, 3);
    f32x4 P[2];
    {
        f32x4 aA[2], aB[2], aPb[2], aPk[2];
#pragma unroll
        for (int i = 0; i < 2; ++i) { aA[i] = (f32x4){0.f, 0.f, 0.f, 0.f}; aB[i] = aA[i]; aPb[i] = aA[i]; aPk[i] = aA[i];
            mmaX<64, 0, 0>(aA[i], KG, RW_LD, 16 * tr, BI, RW_LD, 16 * (tc0 + i), fr, fq);
            mmaX<64, 0, 0>(aB[i], KG, RW_LD, 16 * tr, KI, RW_LD, 16 * (tc0 + i), fr, fq);
            mmaX<64, 0, 0>(aPb[i], RG, RW_LD, 16 * tr, BI, RW_LD, 16 * (tc0 + i), fr, fq);
            mmaX<64, 0, 0>(aPk[i], RG, RW_LD, 16 * tr, KI, RW_LD, 16 * (tc0 + i), fr, fq); }
        LBAR();
#pragma unroll
        for (int i = 0; i < 2; ++i) { const int s = 16 * (tc0 + i) + fr; f32x4 x, p1, bm, pb, pk;
#pragma unroll
            for (int r = 0; r < 4; ++r) { const int tt = 16 * tr + 4 * fq + r;
                x[r] = tt > s ? -aA[i][r] : 0.f; p1[r] = x[r] + (tt == s ? 1.f : 0.f); bm[r] = tt > s ? aB[i][r] : 0.f; pb[r] = tt >= s ? aPb[i][r] : 0.f; pk[r] = tt >= s ? aPk[i][r] : 0.f; }
            P[i] = p1;
            st_tr(XT0, RW_LD, 16 * tr, 16 * (tc0 + i), x, fr, fq); st_tr(PT0, RW_LD, 16 * tr, 16 * (tc0 + i), p1, fr, fq);
            st_tr(BMT, RW_LD, 16 * tr, 16 * (tc0 + i), bm, fr, fq); st_tr(PBT, RW_LD, 16 * tr, 16 * (tc0 + i), pb, fr, fq); st_tr(PKT, RW_LD, 16 * tr, 16 * (tc0 + i), pk, fr, fq); }
    }
    LBAR(); STAMP(4);
#pragma unroll
    for (int st = 1; st <= 6; ++st) {
        const lptr XTc = (st & 1) ? XT0 : XT1, XTn = (st & 1) ? XT1 : XT0;
        const lptr PTc = (st & 1) ? PT1 : PT0, PTn = (st & 1) ? PT0 : PT1;
        f32x4 xn[2];
#pragma unroll
        for (int i = 0; i < 2; ++i) {
            if (st < 6) { xn[i] = (f32x4){0.f, 0.f, 0.f, 0.f}; mmaX<64, 1, 0>(xn[i], XTc, RW_LD, 16 * tr, XTc, RW_LD, 16 * (tc0 + i), fr, fq); }
            if (st > 1) mmaX<64, 1, 0>(P[i], PTc, RW_LD, 16 * tr, XTc, RW_LD, 16 * (tc0 + i), fr, fq);
        }
#pragma unroll
        for (int i = 0; i < 2; ++i) {
            if (st < 6) st_tr(XTn, RW_LD, 16 * tr, 16 * (tc0 + i), xn[i], fr, fq);
            if (st > 1) st_tr(PTn, RW_LD, 16 * tr, 16 * (tc0 + i), P[i], fr, fq);
        }
        LBAR();
    }
    STAMP(5);
    const lptr TT = PT1, WT = rw_slot(L, 10), BVT = rw_slot(L, 11), UVT = rw_slot(L, 12), MS = rw_slot(L, 13), QS = rw_slot(L, 2);
    {
#pragma unroll
        for (int i = 0; i < 2; ++i) { f32x4 aw = (f32x4){0.f, 0.f, 0.f, 0.f}, ab = aw;
            mmaX<64, 1, 1>(aw, TT, RW_LD, 16 * tr, KG, RW_LD, 16 * (tc0 + i), fr, fq);
            mmaX<64, 1, 1>(ab, BMT, RW_LD, 16 * tr, VV, RW_LD, 16 * (tc0 + i), fr, fq);
            st_tr(WT, RW_LD, 16 * tr, 16 * (tc0 + i), aw, fr, fq); st_tr(BVT, RW_LD, 16 * tr, 16 * (tc0 + i), ab, fr, fq); }
    }
    LBAR();
    {
#pragma unroll
        for (int i = 0; i < 2; ++i) { f32x4 au = (f32x4){0.f, 0.f, 0.f, 0.f};
            mmaX<64, 1, 0>(au, TT, RW_LD, 16 * tr, BVT, RW_LD, 16 * (tc0 + i), fr, fq);
            st_tr(UVT, RW_LD, 16 * tr, 16 * (tc0 + i), au, fr, fq); }
    }
    LBAR();
    unsigned char* item = ((unsigned char*)F.out) + (size_t)(c * 8 + h) * 32768;
    {
#pragma unroll
        for (int i = 0; i < 2; ++i) { const int cb = 16 * (tc0 + i);
            f32x4 am = (f32x4){0.f, 0.f, 0.f, 0.f};
            mmaX<64, 0, 1>(am, WT, RW_LD, 16 * tr, BT, RW_LD, cb, fr, fq);
            { const int j = cb + fr; const float gc = GAMC[j]; f32x4 mv;
#pragma unroll
                for (int r = 0; r < 4; ++r) { const int jp = 16 * tr + 4 * fq + r; mv[r] = (jp == j ? gc : 0.f) - am[r]; }
                st_tr(MS, RW_LD, 16 * tr, cb, mv, fr, fq); }
            f32x4 aq = (f32x4){0.f, 0.f, 0.f, 0.f};
            mmaX<64, 0, 1>(aq, WT, RW_LD, 16 * tr, PBT, RW_LD, cb, fr, fq);
            { const f32x4 rgv = unpack4(*(const LAS u32x2*)(RG + (cb + fr) * RW_LD + (16 * tr + 4 * fq) * 2)); const f32x4 qv = rgv - aq; st_tr(QS, RW_LD, 16 * tr, cb, qv, fr, fq); }
            f32x4 g1 = (f32x4){0.f, 0.f, 0.f, 0.f}, g2 = g1, y1 = g1, y2 = g1;
            mmaX<64, 1, 1>(g1, KT, RW_LD, 16 * tr, VV, RW_LD, cb, fr, fq);
            mmaX<64, 1, 0>(g2, BT, RW_LD, 16 * tr, UVT, RW_LD, cb, fr, fq);
            mmaX<64, 1, 1>(y1, PKT, RW_LD, 16 * tr, VV, RW_LD, cb, fr, fq);
            mmaX<64, 1, 0>(y2, PBT, RW_LD, 16 * tr, UVT, RW_LD, cb, fr, fq);
            *(u32x2*)(item + 16384 + ((w * 2 + i) * 64 + lane) * 8) = pack4(g1 - g2);
            *(u32x2*)(item + 24576 + ((w * 2 + i) * 64 + lane) * 8) = pack4(y1 - y2); }
    }
    LBAR();
    l2g_64x64((bf16*)item, MS, tid); l2g_64x64((bf16*)(item + 8192), QS, tid);
    if (h == 0 && c >= 255) { float* dst = c == 255 ? (F.out + O_SHIFT_P) : (F.out + O_SHIFT_S) + (size_t)(c - 256) * RWKV_PROJ; const bf16* src = ((bf16*)(F.ws + WS_PROJ)) + (size_t)(c * 64 + 63) * N_AB + RW_OFF;
        for (int col = tid; col < RWKV_PROJ; col += 512) dst[col] = bf2f(src[col]); }
    LBAR(); STAMP(6);
}

DI void rw_ld_frag_bf16(const unsigned char* p, int w, int lane, f32x4* a) { a[0] = unpack4(*(const u32x2*)(p + ((w * 2) * 64 + lane) * 8)); a[1] = unpack4(*(const u32x2*)(p + ((w * 2 + 1) * 64 + lane) * 8)); }

DI void rwkv_l1_item(const Ctx& F, int g, int h) { STAMP_BEGIN();
    const int tid = F.tid, lane = F.lane, w = F.wave, fr = lane & 15, fq = lane >> 4, tr = w >> 1, tc0 = 2 * (w & 1);
    const lptr L = F.lds, OS = rw_slot(L, 6);
    const int c0 = g * 16;
    f32x4 am[2], ag[2];
    { const unsigned char* item = ((unsigned char*)F.out) + (size_t)(c0 * 8 + h) * 32768; const bf16* M = (const bf16*)item;
#pragma unroll
        for (int i = 0; i < 2; ++i)
#pragma unroll
            for (int r = 0; r < 4; ++r) am[i][r] = bf2f(M[(16 * tr + 4 * fq + r) * 64 + 16 * (tc0 + i) + fr]);
        rw_ld_frag_bf16(item + 16384, w, lane, ag); }
    const int pr_ = tid >> 3, ps_ = tid & 7;
    v4u mreg; u32x2 gq0, gq1;
    { const unsigned char* item = ((unsigned char*)F.out) + (size_t)((c0 + 1) * 8 + h) * 32768; mreg = *(const v4u*)((const bf16*)item + pr_ * 64 + ps_ * 8);
        gq0 = *(const u32x2*)(item + 16384 + ((w * 2) * 64 + lane) * 8); gq1 = *(const u32x2*)(item + 16384 + ((w * 2 + 1) * 64 + lane) * 8); }
    for (int c = c0 + 1; c < c0 + 16; ++c) {
        const lptr MA = rw_slot(L, 3 * (c & 1)), MHT = rw_slot(L, 3 * (c & 1) + 1), GHT = rw_slot(L, 3 * (c & 1) + 2);
        *(LAS v4u*)(MA + pr_ * 144 + ps_ * 16) = mreg;
#pragma unroll
        for (int i = 0; i < 2; ++i) { st_tr(MHT, RW_LD, 16 * tr, 16 * (tc0 + i), am[i], fr, fq); st_tr(GHT, RW_LD, 16 * tr, 16 * (tc0 + i), ag[i], fr, fq); }
        f32x4 gc[2]; gc[0] = unpack4(gq0); gc[1] = unpack4(gq1);
        if (c + 1 < c0 + 16) { const unsigned char* item = ((unsigned char*)F.out) + (size_t)((c + 1) * 8 + h) * 32768; mreg = *(const v4u*)((const bf16*)item + pr_ * 64 + ps_ * 8);
            gq0 = *(const u32x2*)(item + 16384 + ((w * 2) * 64 + lane) * 8); gq1 = *(const u32x2*)(item + 16384 + ((w * 2 + 1) * 64 + lane) * 8); }
        LBAR();
#pragma unroll
        for (int i = 0; i < 2; ++i) { am[i] = (f32x4){0.f, 0.f, 0.f, 0.f}; ag[i] = gc[i];
            mma16<64>(am[i], MA + 16 * tr * RW_LD, RW_LD, MHT + 16 * (tc0 + i) * RW_LD, RW_LD, fr, fq);
            mma16<64>(ag[i], MA + 16 * tr * RW_LD, RW_LD, GHT + 16 * (tc0 + i) * RW_LD, RW_LD, fr, fq); }
    }
    unsigned char* comp = (F.ws + WS_COMP) + (size_t)(h * 16 + g) * 24576;
#pragma unroll
    for (int i = 0; i < 2; ++i) { st_rm(OS, RW_LD, 16 * tr, 16 * (tc0 + i), am[i], fr, fq); *(f32x4*)(comp + 8192 + ((w * 2 + i) * 64 + lane) * 16) = ag[i]; }
    LBAR();
    l2g_64x64((bf16*)comp, OS, tid);
    LBAR();
    STAMP(12);
}
DI void rwkv_l2_item(const Ctx& F, int h) { STAMP_BEGIN();
    const int tid = F.tid, lane = F.lane, w = F.wave, fr = lane & 15, fq = lane >> 4, tr = w >> 1, tc0 = 2 * (w & 1);
    const lptr L = F.lds;
    f32x4 e[2]; e[0] = (f32x4){0.f, 0.f, 0.f, 0.f}; e[1] = e[0];
    const int pr_ = tid >> 3, ps_ = tid & 7;
    v4u mreg; f32x4 gh[2];
    { const unsigned char* comp = (F.ws + WS_COMP) + (size_t)(h * 16) * 24576; mreg = *(const v4u*)((const bf16*)comp + pr_ * 64 + ps_ * 8);
#pragma unroll
        for (int i = 0; i < 2; ++i) gh[i] = *(const f32x4*)(comp + 8192 + ((w * 2 + i) * 64 + lane) * 16); }
    for (int g = 0; g < 16; ++g) {
        float* ent = ((float*)(F.ws + WS_ENT)) + (size_t)(h * 16 + g) * 4096;
#pragma unroll
        for (int i = 0; i < 2; ++i) *(f32x4*)(ent + ((w * 2 + i) * 64 + lane) * 4) = e[i];
        if (g == 15) break;
        const lptr MA = rw_slot(L, 2 * (g & 1)), EHT = rw_slot(L, 2 * (g & 1) + 1);
        *(LAS v4u*)(MA + pr_ * 144 + ps_ * 16) = mreg;
#pragma unroll
        for (int i = 0; i < 2; ++i) st_tr(EHT, RW_LD, 16 * tr, 16 * (tc0 + i), e[i], fr, fq);
        f32x4 gcur[2]; gcur[0] = gh[0]; gcur[1] = gh[1];
        if (g + 1 < 15) { const unsigned char* comp = (F.ws + WS_COMP) + (size_t)(h * 16 + g + 1) * 24576; mreg = *(const v4u*)((const bf16*)comp + pr_ * 64 + ps_ * 8);
#pragma unroll
            for (int i = 0; i < 2; ++i) gh[i] = *(const f32x4*)(comp + 8192 + ((w * 2 + i) * 64 + lane) * 16); }
        LBAR();
#pragma unroll
        for (int i = 0; i < 2; ++i) { e[i] = gcur[i]; mma16<64>(e[i], MA + 16 * tr * RW_LD, RW_LD, EHT + 16 * (tc0 + i) * RW_LD, RW_LD, fr, fq); }
    }
    LBAR();
    STAMP(13);
}
DI void rwkv_l3_item(const Ctx& F, int kind, int g, int h) { STAMP_BEGIN();
    const int tid = F.tid, lane = F.lane, w = F.wave, fr = lane & 15, fq = lane >> 4, tr = w >> 1, tc0 = 2 * (w & 1);
    const lptr L = F.lds;
    f32x4 s[2];
    int c0, nc;
    if (kind == 0) { c0 = g * 16; nc = 16; const float* ent = ((float*)(F.ws + WS_ENT)) + (size_t)(h * 16 + g) * 4096;
#pragma unroll
        for (int i = 0; i < 2; ++i) s[i] = *(const f32x4*)(ent + ((w * 2 + i) * 64 + lane) * 4); }
    else { c0 = 256 + g; nc = 1; const float* S = in_ptr(F, 3) + (size_t)(g * 8 + h) * 4096;
#pragma unroll
        for (int i = 0; i < 2; ++i) s[i] = *(const f32x4*)(S + (16 * (tc0 + i) + fr) * 64 + 16 * tr + 4 * fq); }
    const int pr_ = tid >> 3, ps_ = tid & 7;
    v4u mreg; u32x2 gq0, gq1;
    { const unsigned char* item = ((unsigned char*)F.out) + (size_t)(c0 * 8 + h) * 32768; mreg = *(const v4u*)((const bf16*)item + pr_ * 64 + ps_ * 8);
        gq0 = *(const u32x2*)(item + 16384 + ((w * 2) * 64 + lane) * 8); gq1 = *(const u32x2*)(item + 16384 + ((w * 2 + 1) * 64 + lane) * 8); }
    for (int c = c0; c < c0 + nc; ++c) {
        bf16* stg = ((bf16*)(F.ws + WS_XB)) + (size_t)(c * 8 + h) * 4096;
        const lptr MA = rw_slot(L, 2 * (c & 1)), SHT = rw_slot(L, 2 * (c & 1) + 1);
        *(LAS v4u*)(MA + pr_ * 144 + ps_ * 16) = mreg;
#pragma unroll
        for (int i = 0; i < 2; ++i) { st_tr(SHT, RW_LD, 16 * tr, 16 * (tc0 + i), s[i], fr, fq);
            *(u32x2*)(stg + (16 * (tc0 + i) + fr) * 64 + 16 * tr + 4 * fq) = pack4(s[i]); }
        f32x4 gc[2]; gc[0] = unpack4(gq0); gc[1] = unpack4(gq1);
        if (c + 1 < c0 + nc) { const unsigned char* item = ((unsigned char*)F.out) + (size_t)((c + 1) * 8 + h) * 32768; mreg = *(const v4u*)((const bf16*)item + pr_ * 64 + ps_ * 8);
            gq0 = *(const u32x2*)(item + 16384 + ((w * 2) * 64 + lane) * 8); gq1 = *(const u32x2*)(item + 16384 + ((w * 2 + 1) * 64 + lane) * 8); }
        LBAR();
#pragma unroll
        for (int i = 0; i < 2; ++i) { s[i] = gc[i]; mma16<64>(s[i], MA + 16 * tr * RW_LD, RW_LD, SHT + 16 * (tc0 + i) * RW_LD, RW_LD, fr, fq); }
    }
    LBAR();
    if (kind == 1 || g == 15) { float* out = kind == 1 ? (F.out + O_WKV_S) + (size_t)(g * 8 + h) * 4096 : (F.out + O_WKV_P) + (size_t)h * 4096;
#pragma unroll
        for (int i = 0; i < 2; ++i) *(f32x4*)(out + (16 * (tc0 + i) + fr) * 64 + 16 * tr + 4 * fq) = s[i]; }
    STAMP(14);
}
struct P3Pre { v4u q, st, vp, vpp, g; u32x2 y0, y1; float rk; };
struct P3Const { float mu[8], lg[8], lb[8]; };
DI void rwkv_p3_const(const Ctx& F, int h, P3Const& K) { const int hi0 = h * 64 + 8 * (F.tid & 7); ld8f(in_ptr(F, 14) + 1024 + hi0, K.mu); ld8f(in_ptr(F, 23) + hi0, K.lg); ld8f(in_ptr(F, 24) + hi0, K.lb); }
DI void rwkv_p3_fetch(const Ctx& F, int c, int h, P3Pre& R) {
    const int tid = F.tid, lane = F.lane, w = F.wave, t = tid >> 3, s8 = tid & 7, hi0 = h * 64 + 8 * s8;
    const unsigned char* item = ((unsigned char*)F.out) + (size_t)(c * 8 + h) * 32768;
    R.q = *(const v4u*)((const bf16*)(item + 8192) + t * 64 + s8 * 8);
    R.st = *(const v4u*)(((bf16*)(F.ws + WS_XB)) + (size_t)(c * 8 + h) * 4096 + t * 64 + s8 * 8);
    R.y0 = *(const u32x2*)(item + 24576 + ((w * 2) * 64 + lane) * 8); R.y1 = *(const u32x2*)(item + 24576 + ((w * 2 + 1) * 64 + lane) * 8);
    R.vp = *(const v4u*)(((bf16*)(F.ws + WS_PROJ)) + (size_t)(c * 64 + t) * N_AB + RW_OFF + 1024 + hi0); R.vpp = rw_prev16(F, c, t, 1024 + hi0);
    R.g = *(const v4u*)(((bf16*)(F.ws + WS_MIX)) + (size_t)(c * 64 + t) * 1024 + 512 + hi0);
    R.rk = ((float*)(F.ws + WS_RK))[(size_t)(c * 8 + h) * 64 + t];
}
DI void rwkv_p3_item(const Ctx& F, int c, int h, const P3Pre& R, const P3Const& K) { STAMP_BEGIN();
    const int tid = F.tid, lane = F.lane, w = F.wave, fr = lane & 15, fq = lane >> 4, tr = w >> 1, tc0 = 2 * (w & 1);
    const lptr L = F.lds, QA = rw_slot(L, 0), SB = rw_slot(L, 1), YS = rw_slot(L, 2);
    const int t = tid >> 3, s8 = tid & 7, i0 = 8 * s8, hi0 = h * 64 + i0;
    *(LAS v4u*)(QA + t * 144 + s8 * 16) = R.q; *(LAS v4u*)(SB + t * 144 + s8 * 16) = R.st;
    f32x4 y[2]; y[0] = unpack4(R.y0); y[1] = unpack4(R.y1);
    float xv[8], gt[8]; { float a[8], b[8]; unpack8(R.vp, a); unpack8(R.vpp, b);
#pragma unroll
        for (int e = 0; e < 8; ++e) xv[e] = (a[e] + (b[e] - a[e]) * K.mu[e]) * R.rk; }
    unpack8(R.g, gt);
    LBAR();
#pragma unroll
    for (int i = 0; i < 2; ++i) { mma16<64>(y[i], QA + 16 * tr * RW_LD, RW_LD, SB + 16 * (tc0 + i) * RW_LD, RW_LD, fr, fq);
#pragma unroll
        for (int r = 0; r < 4; ++r) *(LAS float*)(YS + (16 * tr + 4 * fq + r) * RW_LDF + (16 * (tc0 + i) + fr) * 4) = y[i][r]; }
    LBAR();
    {
        float yv[8], s = 0.f;
#pragma unroll
        for (int e = 0; e < 8; ++e) { yv[e] = *(LAS float*)(YS + t * RW_LDF + (i0 + e) * 4); s += yv[e]; }
        s += __shfl_xor(s, 1); s += __shfl_xor(s, 2); s += __shfl_xor(s, 4);
        const float mean = s * (1.0f / 64.0f); float q = 0.f;
#pragma unroll
        for (int e = 0; e < 8; ++e) { yv[e] -= mean; q += yv[e] * yv[e]; }
        q += __shfl_xor(q, 1); q += __shfl_xor(q, 2); q += __shfl_xor(q, 4);
        const float rstd = rsqf_(q * (1.0f / 64.0f) + RWKV_LN_EPS);
        float o[8];
#pragma unroll
        for (int e = 0; e < 8; ++e) o[e] = (yv[e] * rstd * K.lg[e] + K.lb[e] + xv[e]) * gt[e];
        *(v4u*)(((bf16*)(F.ws + WS_MIX)) + (size_t)(c * 64 + t) * 1024 + 512 + hi0) = pack8(o);
    }
    LBAR();
    STAMP(15);
}
constexpr int RT_G = 4, RT_NG = 256 / RT_G;
constexpr int RT_LDQ = 272;
constexpr int RT_LDT = 144;
constexpr int RT_LDR = 272;
constexpr int RT_OFF_Q = 0, RT_OFF_K = 17408, RT_OFF_KD = 34816, RT_OFF_V = 52224, RT_OFF_RT = 71680, RT_OFF_P = 106496, RT_OFF_OS = 0;
DI float ret_lg(int h) { return log1pf(-exp2f(-5.0f - (float)h)); }
DI int crow32(int reg, int hh) { return (reg & 3) + 8 * (reg >> 2) + 4 * hh; }
template <int MODE> DI bf16x8 frag32(lptr img, int ld, int r0, int s, int lane) {
    const int r32 = lane & 31, hh = lane >> 5;
    if (MODE == 0) return *(const LAS bf16x8*)(img + (r0 + r32) * ld + (16 * s + 8 * hh) * 2);
    const lptr p = img + (16 * s + 8 * hh + ((lane & 15) >> 2)) * ld + (r0 + 16 * ((lane >> 4) & 1) + 4 * (lane & 3)) * 2;
    const u32x2 lo = trd(p), hi = trd(p + 4 * ld); v4u w; w.x = lo.x; w.y = lo.y; w.z = hi.x; w.w = hi.y; return __builtin_bit_cast(bf16x8, w);
}
template <int KS, int MA, int MB> DI void mma32(f32x16& acc, lptr A, int lda, int ar0, lptr B, int ldb, int br0, int lane) {
#pragma unroll
    for (int s = 0; s < KS; ++s) acc = __builtin_amdgcn_mfma_f32_32x32x16_bf16(frag32<MA>(A, lda, ar0, s, lane), frag32<MB>(B, ldb, br0, s, lane), acc, 0, 0, 0);
}
DI void rope_cs(const Ctx& F, int j, int pos, float& cs, float& sn) {
    const f32x2* T = (const f32x2*)(F.ws + WS_ROPE); const f32x2 a = T[(pos >> 6) * 72 + j], b = T[(256 + (pos & 63)) * 72 + j];
    cs = a[0] * b[0] - a[1] * b[1]; sn = a[1] * b[0] + a[0] * b[1];
}
struct RetPre { v4u k1, k2, q1, q2, v1, v2, g1, g2; };
constexpr int RT_OFF_RA = 115712;
DI void ret_fetch(const Ctx& F, int c, int h, bool need_qk, RetPre& R) {
    const int t = F.tid >> 3, s8 = F.tid & 7;
    const bf16* row = ((bf16*)(F.ws + WS_PROJ)) + (size_t)(c * 64 + t) * N_AB;
    R.k1 = *(const v4u*)(row + 512 + h * 128 + 8 * s8); R.k2 = *(const v4u*)(row + 512 + h * 128 + 64 + 8 * s8);
    if (need_qk) { R.q1 = *(const v4u*)(row + h * 128 + 8 * s8); R.q2 = *(const v4u*)(row + h * 128 + 64 + 8 * s8); R.g1 = *(const v4u*)(row + 1536 + h * 128 + 16 * s8); R.g2 = *(const v4u*)(row + 1536 + h * 128 + 16 * s8 + 8); }
    R.v1 = *(const v4u*)(row + 1024 + h * 128 + 8 * s8); R.v2 = *(const v4u*)(row + 1024 + h * 128 + 64 + 8 * s8);
}
DI void ret_ra_load(const Ctx& F, int c0, int nc) { if (F.tid < 64 * nc) { const int ci = F.tid >> 6, j = F.tid & 63, c = c0 + ci;
    *(LAS f32x2*)(F.lds + RT_OFF_RA + F.tid * 8) = ((const f32x2*)(F.ws + WS_ROPE))[(c < 256 ? c : PAST_POS / 64) * 72 + j]; } }
DI void ret_stage(const Ctx& F, const RetPre& R, const f32x2* rb, int h, bool need_qk, int ci) {
    const int tid = F.tid, t = tid >> 3, s8 = tid & 7; const lptr L = F.lds;
    const float lg = ret_lg(h), qd = __expf(lg * (float)(t + 1)), kd = __expf(lg * (float)(63 - t));
    float cs[8], sn[8];
#pragma unroll
    for (int e = 0; e < 8; ++e) { const f32x2 ra = *(const LAS f32x2*)(L + RT_OFF_RA + (ci * 64 + 8 * s8 + e) * 8); cs[e] = ra[0] * rb[e][0] - ra[1] * rb[e][1]; sn[e] = ra[1] * rb[e][0] + ra[0] * rb[e][1]; }
    float x1[8], x2[8], o1[8], o2[8];
    unpack8(R.k1, x1); unpack8(R.k2, x2);
#pragma unroll
    for (int e = 0; e < 8; ++e) { o1[e] = (x1[e] * cs[e] - x2[e] * sn[e]) * 0.08838834764831845f; o2[e] = (x1[e] * sn[e] + x2[e] * cs[e]) * 0.08838834764831845f; }
    if (need_qk) { *(LAS v4u*)(L + RT_OFF_K + t * RT_LDQ + s8 * 16) = pack8(o1); *(LAS v4u*)(L + RT_OFF_K + t * RT_LDQ + 128 + s8 * 16) = pack8(o2); }
#pragma unroll
    for (int e = 0; e < 8; ++e) { o1[e] *= kd; o2[e] *= kd; }
    *(LAS v4u*)(L + RT_OFF_KD + t * RT_LDQ + s8 * 16) = pack8(o1); *(LAS v4u*)(L + RT_OFF_KD + t * RT_LDQ + 128 + s8 * 16) = pack8(o2);
    if (need_qk) {
        unpack8(R.q1, x1); unpack8(R.q2, x2);
#pragma unroll
        for (int e = 0; e < 8; ++e) { o1[e] = (x1[e] * cs[e] - x2[e] * sn[e]) * qd; o2[e] = (x1[e] * sn[e] + x2[e] * cs[e]) * qd; }
        *(LAS v4u*)(L + RT_OFF_Q + t * RT_LDQ + s8 * 16) = pack8(o1); *(LAS v4u*)(L + RT_OFF_Q + t * RT_LDQ + 128 + s8 * 16) = pack8(o2);
    }
    *(LAS v4u*)(L + RT_OFF_V + t * RT_LDQ + s8 * 16) = R.v1; *(LAS v4u*)(L + RT_OFF_V + t * RT_LDQ + 128 + s8 * 16) = R.v2;
}
DI void ret_rb(const Ctx& F, f32x2* rb) { const f32x2* T = (const f32x2*)(F.ws + WS_ROPE) + (256 + (F.tid >> 3)) * 72 + 8 * (F.tid & 7);
#pragma unroll
    for (int e = 0; e < 8; ++e) rb[e] = T[e]; }
DI void ret_kv_update(lptr L, f32x16* r, float cdec, int w, int r32, int hh) {
#pragma unroll
    for (int i = 0; i < 2; ++i) { r[i] = r[i] * cdec; mma32<4, 1, 1>(r[i], L + RT_OFF_KD, RT_LDQ, 32 * (w >> 1), L + RT_OFF_V, RT_LDQ, 32 * (2 * (w & 1) + i), hh * 32 + r32); }
}
DI void ret_ld_state(const float* S, f32x16* r, int w, int r32, int hh) {
#pragma unroll
    for (int i = 0; i < 2; ++i)
#pragma unroll
        for (int g = 0; g < 16; ++g) r[i][g] = S[(32 * (w >> 1) + crow32(g, hh)) * 128 + 32 * (2 * (w & 1) + i) + r32];
}
DI void ret_st_state(float* S, const f32x16* r, int w, int r32, int hh) {
#pragma unroll
    for (int i = 0; i < 2; ++i)
#pragma unroll
        for (int g = 0; g < 16; ++g) S[(32 * (w >> 1) + crow32(g, hh)) * 128 + 32 * (2 * (w & 1) + i) + r32] = r[i][g];
}
DI void ret_p1_item(const Ctx& F, int kind, int gi, int h) { STAMP_BEGIN();
    const int lane = F.lane, w = F.wave, r32 = lane & 31, hh = lane >> 5;
    const float cdec = __expf(ret_lg(h) * 64.0f);
    f32x16 r[2];
    int c0, nc;
    if (kind == 0) { c0 = gi * RT_G; nc = RT_G;
#pragma unroll
        for (int i = 0; i < 2; ++i)
#pragma unroll
            for (int g = 0; g < 16; ++g) r[i][g] = 0.f; }
    else { c0 = 256 + gi; nc = 1; ret_ld_state(in_ptr(F, 2) + (size_t)(gi * 4 + h) * 16384, r, w, r32, hh); }
    f32x2 rb[8]; ret_rb(F, rb); RetPre R; ret_fetch(F, c0, h, false, R); ret_ra_load(F, c0, nc); LBAR();
    for (int c = c0; c < c0 + nc; ++c) {
        ret_stage(F, R, rb, h, false, c - c0);
        if (c + 1 < c0 + nc) ret_fetch(F, c + 1, h, false, R);
        LBAR();
        ret_kv_update(F.lds, r, cdec, w, r32, hh);
        LBAR();
    }
    ret_st_state(kind == 0 ? ((float*)(F.ws + WS_XB + (size_t)NCH * 8 * 4096 * 2)) + (size_t)(gi * 4 + h) * 16384 : (F.out + O_RET_S) + (size_t)(gi * 4 + h) * 16384, r, w, r32, hh);
    STAMP(10);
}
DI void ret_scan(const Ctx& F, int vidx) {
    const int n = 4 * 16384;
    for (int e = vidx * 512 + F.tid; e < n; e += F.G * 512) {
        const int h = e >> 14; const float c4 = __expf(ret_lg(h) * 64.0f * (float)RT_G);
        float acc = 0.f;
#pragma unroll 4
        for (int g = 0; g < RT_NG; ++g) { float* p = ((float*)(F.ws + WS_XB + (size_t)NCH * 8 * 4096 * 2)) + (size_t)g * 65536 + e; acc = acc * c4 + *p; *p = acc; }
        (F.out + O_RET_P)[e] = acc;
    }
}
DI void ret_p3_item(const Ctx& F, int kind, int gi, int h) { STAMP_BEGIN();
    const int tid = F.tid, lane = F.lane, w = F.wave, r32 = lane & 31, hh = lane >> 5; const lptr L = F.lds;
    const float lg = ret_lg(h), cdec = __expf(lg * 64.0f);
    f32x16 r[2];
    int c0, nc;
    if (kind == 0) { c0 = gi * RT_G; nc = RT_G;
        if (gi == 0) {
#pragma unroll
            for (int i = 0; i < 2; ++i)
#pragma unroll
                for (int g = 0; g < 16; ++g) r[i][g] = 0.f; }
        else ret_ld_state(((float*)(F.ws + WS_XB + (size_t)NCH * 8 * 4096 * 2)) + (size_t)((gi - 1) * 4 + h) * 16384, r, w, r32, hh); }
    else { c0 = 256 + gi; nc = 1; ret_ld_state(in_ptr(F, 2) + (size_t)(gi * 4 + h) * 16384, r, w, r32, hh); }
    f32x2 rb[8]; ret_rb(F, rb); RetPre R; ret_fetch(F, c0, h, true, R); ret_ra_load(F, c0, nc); LBAR();
    for (int c = c0; c < c0 + nc; ++c) {
        ret_stage(F, R, rb, h, true, c - c0);
        const v4u gA = R.g1, gB = R.g2;
        if (c + 1 < c0 + nc) ret_fetch(F, c + 1, h, true, R);
#pragma unroll
        for (int i = 0; i < 2; ++i)
#pragma unroll
            for (int g4 = 0; g4 < 4; ++g4) { u32x2 v; v.x = pk2(r[i][4 * g4], r[i][4 * g4 + 1]); v.y = pk2(r[i][4 * g4 + 2], r[i][4 * g4 + 3]);
                *(LAS u32x2*)(L + RT_OFF_RT + (32 * (2 * (w & 1) + i) + r32) * RT_LDR + (32 * (w >> 1) + 8 * g4 + 4 * hh) * 2) = v; }
        LBAR();
        if (w < 4) { const int tb = w & 1, kb = w >> 1;
            f32x16 s;
#pragma unroll
            for (int g = 0; g < 16; ++g) s[g] = 0.f;
            if (kb <= tb) mma32<8, 0, 0>(s, L + RT_OFF_Q, RT_LDQ, 32 * tb, L + RT_OFF_K, RT_LDQ, 32 * kb, lane);
            const int tp = 32 * kb + r32; const float f = __expf(-lg * (float)(tp + 1));
#pragma unroll
            for (int g = 0; g < 16; ++g) { const int tq = 32 * tb + crow32(g, hh); const float pv = tq >= tp ? s[g] * f : 0.f;
                *(LAS bf16*)(L + RT_OFF_P + tq * 144 + tp * 2) = (bf16)f2bf(pv); } }
        LBAR();
        const int tb = w & 1, db = w >> 1;
        f32x16 o;
#pragma unroll
        for (int g = 0; g < 16; ++g) o[g] = 0.f;
        mma32<4, 0, 1>(o, L + RT_OFF_P, 144, 32 * tb, L + RT_OFF_V, RT_LDQ, 32 * db, lane);
        mma32<8, 0, 0>(o, L + RT_OFF_Q, RT_LDQ, 32 * tb, L + RT_OFF_RT, RT_LDR, 32 * db, lane);
        ret_kv_update(L, r, cdec, w, r32, hh);
        LBAR();
#pragma unroll
        for (int g = 0; g < 16; ++g) *(LAS float*)(L + RT_OFF_OS + (32 * tb + crow32(g, hh)) * 528 + (32 * db + r32) * 4) = o[g];
        LBAR();
        {
            const int t = tid >> 3, s8 = tid & 7;
            float v[16], s = 0.f;
#pragma unroll
            for (int e = 0; e < 16; ++e) { v[e] = *(LAS float*)(L + RT_OFF_OS + t * 528 + (16 * s8 + e) * 4); s += v[e]; }
            s += __shfl_xor(s, 1); s += __shfl_xor(s, 2); s += __shfl_xor(s, 4);
            const float mean = s * (1.0f / 128.0f); float q = 0.f;
#pragma unroll
            for (int e = 0; e < 16; ++e) { v[e] -= mean; q += v[e] * v[e]; }
            q += __shfl_xor(q, 1); q += __shfl_xor(q, 2); q += __shfl_xor(q, 4);
            const float rstd = rsqf_(q * (1.0f / 128.0f) + LN_EPS);
            bf16* op = ((bf16*)(F.ws + WS_MIX)) + (size_t)(c * 64 + t) * 1024 + h * 128 + 16 * s8;
#pragma unroll
            for (int q2 = 0; q2 < 2; ++q2) { float gt[8], gn[8], o8[8]; unpack8(q2 ? gB : gA, gt); ld8f(in_ptr(F, 13) + h * 128 + 16 * s8 + 8 * q2, gn);
#pragma unroll
                for (int e = 0; e < 8; ++e) o8[e] = gt[e] * rcpf_(1.0f + __expf(-gt[e])) * (v[8 * q2 + e] * rstd * gn[e]);
                *(v4u*)(op + 8 * q2) = pack8(o8); }
        }
        LBAR();
    }
    STAMP(11);
}
constexpr int CV_OFF_U = 0, CV_OFF_Y = 63488;
DI void conv_item(const Ctx& F, int it) { STAMP_BEGIN();
    const int tid = F.tid; const lptr L = F.lds;
    const int c = it >> 1, half = it & 1;
    const int seq_t0 = c < 256 ? 0 : c * 64;
    const int ta = c * 64 + 32 * half;
    const int b = c - 256;
    float wgt[31];
#pragma unroll
    for (int k = 0; k < 31; ++k) wgt[k] = in_ptr(F, 27)[k * 512 + tid];
    const float bias = in_ptr(F, 28)[tid];
    const int seq_last = c < 256 ? TP - 1 : c * 64 + 63;
    const bool emit = (c == 255 && half == 1) || (c >= 256 && half == 1);
#pragma unroll
    for (int bt = 0; bt < 2; ++bt) {
        v4u va[4], vg[4]; f32x4 h0[4], h1[4];
#pragma unroll
        for (int k = 0; k < 4; ++k) { const int q = tid + 512 * (4 * bt + k), rr = q >> 6, cg = q & 63, row = ta - 30 + rr;
            va[k] = (v4u){0u, 0u, 0u, 0u}; vg[k] = va[k]; h0[k] = (f32x4){0.f, 0.f, 0.f, 0.f}; h1[k] = h0[k];
            if (rr < 62) {
                if (row >= seq_t0) { const bf16* p = ((bf16*)(F.ws + WS_PROJ)) + (size_t)row * N_CD + 8 * cg; va[k] = *(const v4u*)p; vg[k] = *(const v4u*)(p + 512); }
                else if (c >= 256) { const float* hp = in_ptr(F, 5) + ((size_t)b * 30 + (30 + row - seq_t0)) * 512 + 8 * cg; h0[k] = *(const f32x4*)hp; h1[k] = *(const f32x4*)(hp + 4); } } }
#pragma unroll
        for (int k = 0; k < 4; ++k) { const int q = tid + 512 * (4 * bt + k), rr = q >> 6, cg = q & 63, row = ta - 30 + rr;
            if (rr < 62) { float u[8];
                if (row >= seq_t0) { float a[8], g[8]; unpack8(va[k], a); unpack8(vg[k], g);
#pragma unroll
                    for (int e = 0; e < 8; ++e) u[e] = a[e] * sigmoidf_(g[e]); }
                else {
#pragma unroll
                    for (int e = 0; e < 4; ++e) { u[e] = h0[k][e]; u[4 + e] = h1[k][e]; } }
                *(LAS v4u*)(L + CV_OFF_U + rr * 1024 + cg * 16) = pack8(u);
                if (emit && row > seq_last - 30 && row >= seq_t0) {
                    float* dst = (c < 256 ? (F.out + O_CONV_P) : (F.out + O_CONV_S) + (size_t)b * 30 * 512) + (size_t)(row - (seq_last - 29)) * 512 + 8 * cg; st8f(dst, u); } } }
    }
    LBAR(); STAMP(20);
    {
        const int ch = tid;
        float uv[62];
#pragma unroll
        for (int r = 0; r < 62; ++r) uv[r] = bf2f(*(LAS bf16*)(L + CV_OFF_U + r * 1024 + ch * 2));
#pragma unroll
        for (int t = 0; t < 32; ++t) { float acc = bias;
#pragma unroll
            for (int k = 0; k < 31; ++k) acc += wgt[k] * uv[t + k];
            *(LAS float*)(L + CV_OFF_Y + t * 2048 + ch * 4) = acc; }
    }
    LBAR(); STAMP(21);
    {
        const int t = tid >> 4, sub = tid & 15; f32x4 v[8]; float s = 0.f;
#pragma unroll
        for (int k = 0; k < 8; ++k) { v[k] = *(LAS f32x4*)(L + CV_OFF_Y + t * 2048 + (64 * k + 4 * sub) * 4); s += (v[k][0] + v[k][1]) + (v[k][2] + v[k][3]); }
        s += __shfl_xor(s, 1); s += __shfl_xor(s, 2); s += __shfl_xor(s, 4); s += __shfl_xor(s, 8);
        const float mean = s * (1.0f / 512.0f); float q = 0.f;
#pragma unroll
        for (int k = 0; k < 8; ++k) { v[k] = v[k] - mean; q += (v[k][0] * v[k][0] + v[k][1] * v[k][1]) + (v[k][2] * v[k][2] + v[k][3] * v[k][3]); }
        q += __shfl_xor(q, 1); q += __shfl_xor(q, 2); q += __shfl_xor(q, 4); q += __shfl_xor(q, 8);
        const float rstd = rsqf_(q * (1.0f / 512.0f) + LN_EPS);
        bf16* op = ((bf16*)(F.ws + WS_MIX)) + (size_t)(ta + t) * 1024;
#pragma unroll
        for (int k = 0; k < 8; ++k) { const int ch = 64 * k + 4 * sub; const f32x4 g = *(const f32x4*)(in_ptr(F, 29) + ch), bb = *(const f32x4*)(in_ptr(F, 30) + ch);
            f32x4 o;
#pragma unroll
            for (int e = 0; e < 4; ++e) { const float z = v[k][e] * rstd * g[e] + bb[e]; o[e] = z * rcpf_(1.0f + __expf(-z)); }
            *(u32x2*)(op + ch) = pack4(o); }
    }
    LBAR();
    STAMP(17);
}

constexpr int AT_OFF_K = 0, AT_OFF_V = 27648, AT_OFF_TBL = 55296, AT_LDK = 144;
DI void attn_item(const Ctx& F, int c, int kh) { STAMP_BEGIN();
    const int tid = F.tid, lane = F.lane, w = F.wave, r32 = lane & 31, hh = lane >> 5; const lptr L = F.lds;
    const int b = c - 256;
    const int row0 = c * 64 - 128;
    const int kvalid0 = c >= 256 ? 0 : (c == 0 ? 128 : (c == 1 ? 64 : 0));
    const bool last = (c == 255) || (c >= 256);
    const int hq = 4 * kh + (w >> 1), qrow = c * 64 + 32 * (w & 1) + r32;
    v4u qraw[4], qpx;
    { const bf16* qp = ((bf16*)(F.ws + WS_PROJ)) + (size_t)qrow * N_CD + 1024 + hq * 64;
#pragma unroll
        for (int s = 0; s < 4; ++s) qraw[s] = *(const v4u*)(qp + 16 * s + 8 * hh);
        qpx = *(const v4u*)(qp + 8 * (hh ^ 1)); }
        v4u kq[3], vq[3], pq[3]; f32x4 kc0[3], kc1[3], vc0[3], vc1[3];
#pragma unroll
        for (int k = 0; k < 3; ++k) { const int q = tid + 512 * k, key = q >> 3, s8 = q & 7;
            kq[k] = (v4u){0u, 0u, 0u, 0u}; vq[k] = kq[k]; pq[k] = kq[k]; kc0[k] = (f32x4){0.f, 0.f, 0.f, 0.f}; kc1[k] = kc0[k]; vc0[k] = kc0[k]; vc1[k] = kc0[k];
            if (c >= 256 && key < 128) { const float* kp = in_ptr(F, 6) + (((size_t)b * 128 + key) * 2 + kh) * 64 + 8 * s8; const float* vp = in_ptr(F, 7) + (((size_t)b * 128 + key) * 2 + kh) * 64 + 8 * s8;
                kc0[k] = *(const f32x4*)kp; kc1[k] = *(const f32x4*)(kp + 4); vc0[k] = *(const f32x4*)vp; vc1[k] = *(const f32x4*)(vp + 4); }
            else if (key >= kvalid0) { const int row = c >= 256 ? c * 64 + (key - 128) : row0 + key; const bf16* p = ((bf16*)(F.ws + WS_PROJ)) + (size_t)row * N_CD;
                kq[k] = *(const v4u*)(p + 1536 + kh * 64 + 8 * s8); vq[k] = *(const v4u*)(p + 1664 + kh * 64 + 8 * s8);
                if (s8 < 2) pq[k] = *(const v4u*)(p + 1536 + kh * 64 + 8 * (s8 ^ 1)); } }
    for (int q = tid; q < 192 * 8; q += 512) { const int key = q >> 3, e = q & 7; const int pos = c >= 256 ? PAST_POS + (key - 128) : row0 + key;
        float cs, sn; rope_cs(F, 64 + e, pos < 0 ? 0 : pos, cs, sn); *(LAS f32x2*)(L + AT_OFF_TBL + q * 8) = (f32x2){cs, sn}; }
    LBAR();
    {
#pragma unroll
        for (int k = 0; k < 3; ++k) { const int q = tid + 512 * k, key = q >> 3, s8 = q & 7;
            float kx[8], vx[8];
            if (c >= 256 && key < 128) {
#pragma unroll
                for (int e = 0; e < 4; ++e) { kx[e] = kc0[k][e]; kx[4 + e] = kc1[k][e]; vx[e] = vc0[k][e]; vx[4 + e] = vc1[k][e]; } }
            else { unpack8(kq[k], kx); unpack8(vq[k], vx);
                if (s8 < 2 && key >= kvalid0) {
                    float px[8]; unpack8(pq[k], px);
#pragma unroll
                    for (int e = 0; e < 8; ++e) { const f32x2 t2 = *(const LAS f32x2*)(L + AT_OFF_TBL + (key * 8 + e) * 8); const float cs = t2[0], sn = t2[1]; kx[e] = s8 == 0 ? kx[e] * cs - px[e] * sn : px[e] * sn + kx[e] * cs; } } }
            *(LAS v4u*)(L + AT_OFF_K + key * AT_LDK + s8 * 16) = pack8(kx);
            *(LAS v4u*)(L + AT_OFF_V + key * AT_LDK + s8 * 16) = pack8(vx);
            if (last && key >= 64) { float* kd = (c == 255 ? (F.out + O_K_P) : (F.out + O_K_S) + (size_t)b * 16384) + ((size_t)(key - 64) * 2 + kh) * 64 + 8 * s8;
                float* vd = (c == 255 ? (F.out + O_V_P) : (F.out + O_V_S) + (size_t)b * 16384) + ((size_t)(key - 64) * 2 + kh) * 64 + 8 * s8; st8f(kd, kx); st8f(vd, vx); } }
    }
    bf16x8 qf[4];
    {
#pragma unroll
        for (int s = 0; s < 4; ++s) { float x[8]; unpack8(qraw[s], x);
            if (s == 0) { float px[8]; unpack8(qpx, px);
#pragma unroll
                for (int e = 0; e < 8; ++e) { const f32x2 t2 = *(const LAS f32x2*)(L + AT_OFF_TBL + ((128 + 32 * (w & 1) + r32) * 8 + e) * 8); const float cs = t2[0], sn = t2[1]; x[e] = hh == 0 ? x[e] * cs - px[e] * sn : px[e] * sn + x[e] * cs; } }
            const v4u pk = pack8(x); qf[s] = __builtin_bit_cast(bf16x8, pk); } }
    LBAR();
    STAMP(23);
    f32x16 x[6];
#pragma unroll
    for (int kb = 0; kb < 6; ++kb) {
#pragma unroll
        for (int g = 0; g < 16; ++g) x[kb][g] = 0.f;
#pragma unroll
        for (int s = 0; s < 4; ++s) { const bf16x8 a = *(const LAS bf16x8*)(L + AT_OFF_K + (32 * kb + r32) * AT_LDK + (16 * s + 8 * hh) * 2);
            x[kb] = __builtin_amdgcn_mfma_f32_32x32x16_bf16(a, qf[s], x[kb], 0, 0, 0); }
        __builtin_amdgcn_sched_barrier(0); }
    const float sink = in_ptr(F, 31)[hq];
    float m = sink;
#pragma unroll
    for (int kb = 0; kb < 6; ++kb)
#pragma unroll
        for (int g = 0; g < 16; ++g) { float sv = x[kb][g] * 0.125f; if (32 * kb < kvalid0) sv = -1e30f; x[kb][g] = sv; m = fmaxf(m, sv); }
    m = fmaxf(m, __shfl_xor(m, 32));
    float den = 0.f;
#pragma unroll
    for (int kb = 0; kb < 6; ++kb)
#pragma unroll
        for (int g = 0; g < 16; ++g) { const float e = __expf(x[kb][g] - m); x[kb][g] = e; den += e; }
    den += __shfl_xor(den, 32);
    den += __expf(sink - m);
    const float rden = rcpf_(den);
#pragma unroll
    for (int kb = 0; kb < 6; ++kb)
#pragma unroll
        for (int g = 0; g < 16; ++g) x[kb][g] *= rden;
    STAMP(24);
    bf16* op = ((bf16*)(F.ws + WS_MIX)) + (size_t)(c * 64 + 32 * (w & 1)) * 1024 + 512 + hq * 64;
#pragma unroll
    for (int db = 0; db < 2; ++db) {
        f32x16 o;
#pragma unroll
        for (int g = 0; g < 16; ++g) o[g] = 0.f;
#pragma unroll
        for (int kb = 0; kb < 6; ++kb)
#pragma unroll
            for (int s = 0; s < 2; ++s) {
                float pv[8];
#pragma unroll
                for (int j = 0; j < 8; ++j) pv[j] = x[kb][8 * s + j];
                const v4u pk = pack8(pv); const bf16x8 pa = __builtin_bit_cast(bf16x8, pk);
                const lptr vp = L + AT_OFF_V + (32 * kb + 16 * s + 4 * hh + ((lane & 15) >> 2)) * AT_LDK + (32 * db + 16 * ((lane >> 4) & 1) + 4 * (lane & 3)) * 2;
                const u32x2 lo = trd(vp), hi = trd(vp + 8 * AT_LDK);
                v4u bv; bv.x = lo.x; bv.y = lo.y; bv.z = hi.x; bv.w = hi.y;
                o = __builtin_amdgcn_mfma_f32_32x32x16_bf16(pa, __builtin_bit_cast(bf16x8, bv), o, 0, 0, 0);
                __builtin_amdgcn_sched_barrier(0); }
#pragma unroll
        for (int g = 0; g < 16; ++g) op[(size_t)crow32(g, hh) * 1024 + 32 * db + r32] = (bf16)f2bf(o[g]);
    }
    LBAR();
    STAMP(16);
}
DI float wave_sum(float v) {
#pragma unroll
    for (int o = 1; o < 64; o <<= 1) v += __shfl_xor(v, o);
    return v;
}
DI void p0_transpose_item(const float* W, int K, int N, bf16* WT, int k0, int n0, int dst_row0, const float* gk, LAS float* scr, int lane) {
    {   const int kr = lane >> 3, n4 = (lane & 7) * 4; f32x4 v[8];
#pragma unroll
        for (int i = 0; i < 8; ++i) v[i] = *(const GAS f32x4*)(W + (size_t)(k0 + kr + 8 * i) * N + n0 + n4);
#pragma unroll
        for (int i = 0; i < 8; ++i) { const int kk = kr + 8 * i; const float g = gk ? gk[k0 + kk] : 1.0f;
#pragma unroll
            for (int e = 0; e < 4; ++e) scr[kk * 33 + n4 + e] = v[i][e] * g; } }
    LDS_WAIT(); asm volatile("" ::: "memory");
    const int c = lane & 7;
#pragma unroll
    for (int j = 0; j < 4; ++j) { const int n = (lane >> 3) + 8 * j; const LAS float* s = scr + (8 * c) * 33 + n;
        v4u o; o.x = pk2(s[0 * 33], s[1 * 33]); o.y = pk2(s[2 * 33], s[3 * 33]); o.z = pk2(s[4 * 33], s[5 * 33]); o.w = pk2(s[6 * 33], s[7 * 33]);
        *(GAS v4u*)(WT + (size_t)(dst_row0 + n) * K + k0 + 8 * c) = o; }
    LDS_WAIT(); asm volatile("" ::: "memory");
}
DI void p0_prologue(const Ctx& F) {
    LAS float* scr = (LAS float*)(F.lds + F.wave * 16384);
    const int gw = F.vcu * NWAVES + F.wave, NGW = F.G * NWAVES, lane = F.lane;
    for (int q = F.vcu * 512 + F.tid; q < (256 + 64) * 72; q += F.G * 512) { const int r = q / 72, j = q % 72; const int pos = r < 256 ? 64 * r : r - 256;
        const double inv = j < 64 ? exp((double)j * (-2.0 * log(10000.0) / 128.0)) : exp((double)(j - 64) * (-2.0 * log(500000.0) / 16.0));
        const double a = (double)pos * inv, k = rint(a * 0.15915494309189535), rr = a - k * 6.283185307179586;
        ((f32x2*)(F.ws + WS_ROPE))[q] = (f32x2){(float)cos(rr), (float)sin(rr)}; }
    for (int q = F.vcu * 512 + F.tid; q < 17 * RWKV_PROJ; q += F.G * 512) ((bf16*)(F.ws + WS_SHB))[q] = q < 16 * RWKV_PROJ ? (bf16)f2bf(in_ptr(F, 4)[q]) : (bf16)0;
    constexpr int I_INAB = 16 * (N_AB / 32), I_SQ = 16 * 32, I_INCD = 16 * (N_CD / 32), I_GU = 16 * (D_FF / 32), I_DN = (D_FF / 64) * 32;
    constexpr int NITEMS = I_INAB + 2 * I_SQ + I_INCD + 4 * I_GU + 2 * I_DN;
    for (int it = gw; it < NITEMS; it += NGW) {
        int r = it;
        if (r < I_INAB) { const int nb = N_AB / 32; p0_transpose_item(in_ptr(F, 11), 1024, N_AB, ((bf16*)(F.ws + WS_W_INAB)), 64 * (r / nb), 32 * (r % nb), 32 * (r % nb), in_ptr(F, 8), scr, lane); continue; } r -= I_INAB;
        if (r < I_SQ) { p0_transpose_item(in_ptr(F, 12), 1024, 1024, ((bf16*)(F.ws + WS_W_OUTAB)), 64 * (r / 32), 32 * (r % 32), 32 * (r % 32), nullptr, scr, lane); continue; } r -= I_SQ;
        if (r < I_INCD) { const int nb = N_CD / 32; p0_transpose_item(in_ptr(F, 25), 1024, N_CD, ((bf16*)(F.ws + WS_W_INCD)), 64 * (r / nb), 32 * (r % nb), 32 * (r % nb), in_ptr(F, 8) + 1024, scr, lane); continue; } r -= I_INCD;
        if (r < I_SQ) { p0_transpose_item(in_ptr(F, 26), 1024, 1024, ((bf16*)(F.ws + WS_W_OUTCD)), 64 * (r / 32), 32 * (r % 32), 32 * (r % 32), nullptr, scr, lane); continue; } r -= I_SQ;
        if (r < 4 * I_GU) { const int which = r / I_GU, l = which >> 1, up = which & 1, q = r % I_GU, nb = D_FF / 32, n0 = 32 * (q % nb);
            p0_transpose_item((up ? in_ptr(F, 33) : in_ptr(F, 32)) + (size_t)l * 1024 * D_FF, 1024, D_FF, ((bf16*)(F.ws + WS_W_GU)) + (size_t)l * N_GU * 1024, 64 * (q / nb), n0, 256 * (n0 >> 7) + 128 * up + (n0 & 127), in_ptr(F, 9) + l * 1024, scr, lane); continue; } r -= 4 * I_GU;
        { const int l = r / I_DN, q = r % I_DN; p0_transpose_item(in_ptr(F, 34) + (size_t)l * D_FF * 1024, D_FF, 1024, ((bf16*)(F.ws + WS_W_DN)) + (size_t)l * 1024 * D_FF, 64 * (q / 32), 32 * (q % 32), 32 * (q % 32), nullptr, scr, lane); }
    }
    for (int m0 = gw; m0 < T_ALL; m0 += 2 * NGW) {
        f32x4 v[2][4]; const int m1 = m0 + NGW; const bool has1 = m1 < T_ALL;
#pragma unroll
        for (int u = 0; u < 2; ++u) { const int m = u ? (has1 ? m1 : m0) : m0; const float* xrow = m < TP ? in_ptr(F, 0) + (size_t)m * 1024 : in_ptr(F, 1) + (size_t)(m - TP) * 1024;
            const GAS f32x4* xr = (const GAS f32x4*)xrow + lane;
#pragma unroll
            for (int j = 0; j < 4; ++j) v[u][j] = xr[64 * j]; }
#pragma unroll
        for (int u = 0; u < 2; ++u) { if (u == 1 && !has1) break; const int m = u ? m1 : m0; float s = 0.f;
#pragma unroll
            for (int j = 0; j < 4; ++j) s += (v[u][j][0] * v[u][j][0] + v[u][j][1] * v[u][j][1]) + (v[u][j][2] * v[u][j][2] + v[u][j][3] * v[u][j][3]);
            s = wave_sum(s);
            GAS unsigned long long* o8 = (GAS unsigned long long*)(((bf16*)(F.ws + WS_XB)) + (size_t)m * 1024) + lane;
#pragma unroll
            for (int j = 0; j < 4; ++j) o8[64 * j] = (unsigned long long)pk2(v[u][j][0], v[u][j][1]) | ((unsigned long long)pk2(v[u][j][2], v[u][j][3]) << 32);
            if (lane < 16) ((float*)(F.ws + WS_SS))[(size_t)m * 16 + lane] = lane == 0 ? s : 0.f; }
    }
}
DI void final_norm(const Ctx& F) {
    const int gw = F.vcu * NWAVES + F.wave, NGW = F.G * NWAVES, lane = F.lane;
    const f32x4* gp = (const f32x4*)in_ptr(F, 10); f32x4 gg[2][2];
#pragma unroll
    for (int j = 0; j < 2; ++j) { gg[j][0] = gp[(64 * j + lane) * 2]; gg[j][1] = gp[(64 * j + lane) * 2 + 1]; }
    for (int m0 = gw; m0 < T_ALL; m0 += 2 * NGW) {
        const int m1 = m0 + NGW; const bool has1 = m1 < T_ALL; v4u xv[2][2]; float rs[2];
#pragma unroll
        for (int u = 0; u < 2; ++u) { const int m = u ? (has1 ? m1 : m0) : m0; const v4u* xr = (const v4u*)(((bf16*)(F.ws + WS_XB)) + (size_t)m * 1024) + lane;
            xv[u][0] = xr[0]; xv[u][1] = xr[64]; rs[u] = pg8::row_rstd(((float*)(F.ws + WS_SS)), m); }
#pragma unroll
        for (int u = 0; u < 2; ++u) { if (u == 1 && !has1) break; const int m = u ? m1 : m0; GAS f32x4* yr = (GAS f32x4*)((F.out + O_Y) + (size_t)m * 1024);
#pragma unroll
            for (int j = 0; j < 2; ++j) { float x[8]; unpack8(xv[u][j], x); const int c4 = (64 * j + lane) * 2; const f32x4 g0 = gg[j][0], g1 = gg[j][1]; const float r = rs[u];
                yr[c4] = (f32x4){x[0] * r * g0[0], x[1] * r * g0[1], x[2] * r * g0[2], x[3] * r * g0[3]}; yr[c4 + 1] = (f32x4){x[4] * r * g1[0], x[5] * r * g1[1], x[6] * r * g1[2], x[7] * r * g1[3]}; } }
    }
}

constexpr int N_PHASES = 16;
struct Args { const float* in[35]; float* out; unsigned char* ws; int ph_lo, ph_hi, li, pad; };
__global__ void __launch_bounds__(NWAVES * 64, 2) hybrid_fwd(Args args) {
    extern __shared__ __attribute__((aligned(16))) unsigned char lds_raw[];
    Ctx F;
    F.lds = (lptr)lds_raw;
    volatile LAS unsigned* MISC = (volatile LAS unsigned*)(F.lds + MISC_OFF);
    F.tid = threadIdx.x; F.lane = F.tid & 63; F.wave = __builtin_amdgcn_readfirstlane(F.tid >> 6);
    F.G = gridDim.x; { const int bx = blockIdx.x; F.vcu = (F.G % 8 == 0) ? (bx % 8) * (F.G / 8) + bx / 8 : bx; }
    unsigned char* ws = args.ws;
    F.out = args.out; F.ws = args.ws;
    for (int u = F.tid; u < (LDS_BYTES - RING_BYTES) / 4; u += NWAVES * 64) ((LAS unsigned*)(F.lds + RING_BYTES))[u] = 0u;
    __syncthreads();
    XcdBarrier bar = xcd_barrier_post((unsigned*)(ws + WS_CTL) + 1024 + args.li * XCD_BAR_WORDS, MISC + 8);
    const int lo = args.ph_lo, hi = args.ph_hi, G = F.G, vcu = F.vcu;
#ifndef PH_MASK
#define PH_MASK 0xFFFF
#endif
#define IN(k) (((PH_MASK >> (k)) & 1) && lo <= (k) && (k) < hi)
#ifndef PROBE_LO
#define PROBE_LO -1
#define PROBE_HI -1
#endif
    unsigned long long pr_t0 = 0, pr_dt = 0; F.pr = &pr_dt;
#define SEAM(k) do { if (IN(k) && IN((k) + 1)) xcd_barrier(bar); \
        if ((k) + 1 == PROBE_LO) pr_t0 = __builtin_amdgcn_s_memrealtime(); if ((k) == PROBE_HI) pr_dt = __builtin_amdgcn_s_memrealtime() - pr_t0; } while (0)
    if (PROBE_LO == 0) pr_t0 = __builtin_amdgcn_s_memrealtime();
    typedef pg8::bf16_t gb;
    if (IN(0)) { p0_prologue(F); } SEAM(0);
    if (IN(1)) { pg8::Gemm g{(const gb*)((bf16*)(F.ws + WS_XB)), (const gb*)((bf16*)(F.ws + WS_W_INAB)), T_ALL, N_AB, 1024}; pg8::StaticOrder S; S.init(T_ALL, N_AB, G, (int)blockIdx.x);
        pg8::EpiNormBf16 E{(gb*)((bf16*)(F.ws + WS_PROJ)), N_AB, ((float*)(F.ws + WS_SS))}; pg8::gemm_phase<pg8::EpiNormBf16, pg8::StaticOrder, true, true>(F.lds, g, S, E); } SEAM(1);
    if (IN(2)) {
        for (int it = vcu; it < 320; it += G) { if (it < 256) ret_p1_item(F, 0, it >> 2, it & 3); else ret_p1_item(F, 1, (it - 256) >> 2, it & 3); }
        { RwPre R; int it = (vcu + G - (64 % G)) % G, hcur = -1;
            if (it < NCH * 8) rw_prefetch(F, it >> 3, it & 7, R);
            for (; it < NCH * 8; it += G) { const int h = it & 7, nx = it + G; if (h != hcur) { rw_load_params(F, h); hcur = h; }
                rwkv_p1_item(F, it >> 3, h, R, nx < NCH * 8, nx >> 3, nx & 7); } }
    } SEAM(2);
    if (IN(3)) { for (int it = vcu; it < 128; it += G) rwkv_l1_item(F, it & 15, it >> 4);
        ret_scan(F, (vcu + G - (128 % G)) % G); } SEAM(3);
    if (IN(4)) { for (int it = vcu; it < 8; it += G) rwkv_l2_item(F, it);
        for (int it = (vcu + G - (8 % G)) % G; it < 320; it += G) { if (it < 256) ret_p3_item(F, 0, it >> 2, it & 3); else ret_p3_item(F, 1, (it - 256) >> 2, it & 3); } } SEAM(4);
    if (IN(5)) { for (int it = vcu; it < 256; it += G) { if (it < 128) rwkv_l3_item(F, 0, it & 15, it >> 4); else rwkv_l3_item(F, 1, (it - 128) >> 3, it & 7); } } SEAM(5);
    if (IN(6)) { P3Pre R, Rn; P3Const K; int it = vcu, hcur = -1;
        if (it < NCH * 8) rwkv_p3_fetch(F, it >> 3, it & 7, Rn);
        for (; it < NCH * 8; it += G) { const int h = it & 7, nx = it + G; if (h != hcur) { rwkv_p3_const(F, h, K); hcur = h; }
            R = Rn; if (nx < NCH * 8) rwkv_p3_fetch(F, nx >> 3, nx & 7, Rn);
            rwkv_p3_item(F, it >> 3, h, R, K); } } SEAM(6);
    if (IN(7)) {
        { const pg8::ResidOp<0, false> rs{in_ptr(F, 1), TP, nullptr, (gb*)((bf16*)(F.ws + WS_XB))}; for (int tl = vcu; tl < 256; tl += G) gemm_small64(F, ((bf16*)(F.ws + WS_MIX)), ((bf16*)(F.ws + WS_W_OUTAB)), 1024, tl, rs, ((float*)(F.ws + WS_SS))); }
        pg8::Gemm g{(const gb*)((bf16*)(F.ws + WS_MIX)), (const gb*)((bf16*)(F.ws + WS_W_OUTAB)), TP, 1024, 1024}; pg8::StaticOrder S; S.init(TP, 1024, G, (int)blockIdx.x);
        pg8::EpiResid<0, false> E{{in_ptr(F, 0), 0, nullptr, (gb*)((bf16*)(F.ws + WS_XB))}, ((float*)(F.ws + WS_SS))}; pg8::gemm_phase<pg8::EpiResid<0, false>, pg8::StaticOrder, true, true>(F.lds, g, S, E); } SEAM(7);
    if (IN(8)) { pg8::Gemm g{(const gb*)((bf16*)(F.ws + WS_XB)), (const gb*)((bf16*)(F.ws + WS_W_GU)), T_ALL, N_GU, 1024}; pg8::StaticOrder S; S.init(T_ALL, N_GU, G, (int)blockIdx.x);
        pg8::EpiSwiGLU E{(gb*)((bf16*)(F.ws + WS_PROJ)), D_FF, ((float*)(F.ws + WS_SS))}; pg8::gemm_phase<pg8::EpiSwiGLU, pg8::StaticOrder, true, true>(F.lds, g, S, E); } SEAM(8);
    if (IN(9)) {
        { const pg8::ResidOp<1, false> rs{nullptr, 0, nullptr, (gb*)((bf16*)(F.ws + WS_XB))}; for (int tl = vcu; tl < 256; tl += G) gemm_small64(F, ((bf16*)(F.ws + WS_PROJ)), ((bf16*)(F.ws + WS_W_DN)), D_FF, tl, rs, ((float*)(F.ws + WS_SS))); }
        pg8::Gemm g{(const gb*)((bf16*)(F.ws + WS_PROJ)), (const gb*)((bf16*)(F.ws + WS_W_DN)), TP, 1024, D_FF}; pg8::StaticOrder S; S.init(TP, 1024, G, (int)blockIdx.x);
        pg8::EpiResid<1, false> E{{nullptr, 0, nullptr, (gb*)((bf16*)(F.ws + WS_XB))}, ((float*)(F.ws + WS_SS))}; pg8::gemm_phase<pg8::EpiResid<1, false>, pg8::StaticOrder, true, true>(F.lds, g, S, E); } SEAM(9);
    if (IN(10)) { pg8::Gemm g{(const gb*)((bf16*)(F.ws + WS_XB)), (const gb*)((bf16*)(F.ws + WS_W_INCD)), T_ALL, N_CD, 1024}; pg8::StaticOrder S; S.init(T_ALL, N_CD, G, (int)blockIdx.x);
        pg8::EpiNormBf16 E{(gb*)((bf16*)(F.ws + WS_PROJ)), N_CD, ((float*)(F.ws + WS_SS))}; pg8::gemm_phase<pg8::EpiNormBf16, pg8::StaticOrder, true, true>(F.lds, g, S, E); } SEAM(10);
    if (IN(11)) {
        for (int it = vcu; it < 544; it += G) attn_item(F, it >> 1, it & 1);
        for (int it = (vcu + G - (32 % G)) % G; it < 544; it += G) conv_item(F, it);
    } SEAM(11);
    if (IN(12)) {
        { const pg8::ResidOp<1, false> rs{nullptr, 0, nullptr, (gb*)((bf16*)(F.ws + WS_XB))}; for (int tl = vcu; tl < 256; tl += G) gemm_small64(F, ((bf16*)(F.ws + WS_MIX)), ((bf16*)(F.ws + WS_W_OUTCD)), 1024, tl, rs, ((float*)(F.ws + WS_SS))); }
        pg8::Gemm g{(const gb*)((bf16*)(F.ws + WS_MIX)), (const gb*)((bf16*)(F.ws + WS_W_OUTCD)), TP, 1024, 1024}; pg8::StaticOrder S; S.init(TP, 1024, G, (int)blockIdx.x);
        pg8::EpiResid<1, false> E{{nullptr, 0, nullptr, (gb*)((bf16*)(F.ws + WS_XB))}, ((float*)(F.ws + WS_SS))}; pg8::gemm_phase<pg8::EpiResid<1, false>, pg8::StaticOrder, true, true>(F.lds, g, S, E); } SEAM(12);
    if (IN(13)) { pg8::Gemm g{(const gb*)((bf16*)(F.ws + WS_XB)), (const gb*)(((bf16*)(F.ws + WS_W_GU)) + (size_t)N_GU * 1024), T_ALL, N_GU, 1024}; pg8::StaticOrder S; S.init(T_ALL, N_GU, G, (int)blockIdx.x);
        pg8::EpiSwiGLU E{(gb*)((bf16*)(F.ws + WS_PROJ)), D_FF, ((float*)(F.ws + WS_SS))}; pg8::gemm_phase<pg8::EpiSwiGLU, pg8::StaticOrder, true, true>(F.lds, g, S, E); } SEAM(13);
    if (IN(14)) {
        { const pg8::ResidOp<1, false> rs{nullptr, 0, nullptr, (gb*)((bf16*)(F.ws + WS_XB))}; for (int tl = vcu; tl < 256; tl += G) gemm_small64(F, ((bf16*)(F.ws + WS_PROJ)), (((bf16*)(F.ws + WS_W_DN)) + (size_t)1024 * D_FF), D_FF, tl, rs, ((float*)(F.ws + WS_SS))); }
        pg8::Gemm g{(const gb*)((bf16*)(F.ws + WS_PROJ)), (const gb*)(((bf16*)(F.ws + WS_W_DN)) + (size_t)1024 * D_FF), TP, 1024, D_FF}; pg8::StaticOrder S; S.init(TP, 1024, G, (int)blockIdx.x);
        pg8::EpiResid<1, false> E{{nullptr, 0, nullptr, (gb*)((bf16*)(F.ws + WS_XB))}, ((float*)(F.ws + WS_SS))}; pg8::gemm_phase<pg8::EpiResid<1, false>, pg8::StaticOrder, true, true>(F.lds, g, S, E); } SEAM(14);
    if (IN(15)) final_norm(F);
    if (PROBE_HI == 15) { asm volatile("s_waitcnt vmcnt(0)" ::: "memory"); pr_dt = __builtin_amdgcn_s_memrealtime() - pr_t0; }
    if ((PROBE_LO >= 0 || PROBE_SUB >= 0) && blockIdx.x == 0) { const unsigned long long t1 = __builtin_amdgcn_s_memrealtime(); while (__builtin_amdgcn_s_memrealtime() - t1 < pr_dt) __builtin_amdgcn_s_sleep(8); }
#undef IN
#undef SEAM
}

#ifndef MK_SPLIT
#define MK_SPLIT 0
#endif
extern "C" void kernel_launch(void* const* d_in, const int* in_sizes, int n_in, void* d_out, int out_size, void* d_ws, size_t ws_size, hipStream_t stream) {
    static int grid = 0;
    if (grid == 0) {
        if (n_in != 35 || out_size != (int)O_END || ws_size < WS_END) { fprintf(stderr, "kernel_launch: unexpected shapes: n_in %d out %d ws %zu\n", n_in, out_size, ws_size); grid = -1; return; }
        int dev = 0, cus = 0, per_cu = 0;
        if (hipGetDevice(&dev) != hipSuccess || hipDeviceGetAttribute(&cus, hipDeviceAttributeMultiprocessorCount, dev) != hipSuccess) { grid = -1; return; }
        if (hipFuncSetAttribute((const void*)hybrid_fwd, hipFuncAttributeMaxDynamicSharedMemorySize, LDS_BYTES) != hipSuccess) { fprintf(stderr, "kernel_launch: hipFuncSetAttribute failed\n"); grid = -1; return; }
        if (hipOccupancyMaxActiveBlocksPerMultiprocessor(&per_cu, (const void*)hybrid_fwd, NWAVES * 64, LDS_BYTES) != hipSuccess || per_cu < 1) { fprintf(stderr, "kernel_launch: occupancy query says %d blocks per CU; nothing launched\n", per_cu); (void)hipGetLastError(); grid = -1; return; }
        grid = cus;
    }
    if (grid < 0) return;
    (void)hipMemsetAsync((char*)d_ws + WS_CTL, 0, CTL_ZERO_BYTES, stream);
    Args a{};
    for (int i = 0; i < 35; ++i) a.in[i] = (const float*)d_in[i];
    a.out = (float*)d_out; a.ws = (unsigned char*)d_ws;
#if MK_SPLIT
    for (int p = 0; p < N_PHASES; ++p) { a.ph_lo = p; a.ph_hi = p + 1; a.li = 0; hipLaunchKernelGGL(hybrid_fwd, dim3(grid), dim3(NWAVES * 64), LDS_BYTES, stream, a); }
#else
    a.ph_lo = 0; a.ph_hi = N_PHASES; a.li = 0;
    hipLaunchKernelGGL(hybrid_fwd, dim3(grid), dim3(NWAVES * 64), LDS_BYTES, stream, a);
#endif
}
```
